# Optimizing an MI355X kernel written in HIP

```python
import math
import jax, jax.numpy as jnp
from jax import lax
import numpy as np

D_MODEL = 1024
BATCH = 16
SEQ = 4096
DEPTH = 4

CTX_LEN = 256
GRID_W = 64
HEAD_DIM = 64
EPS = 1e-6

MLSTM_HEADS = 4
MLSTM_WIDTH = MLSTM_HEADS * HEAD_DIM
MLSTM_CHUNK = 64
GMLP_GROUPS = 4
GMLP_WIDTH = GMLP_GROUPS * HEAD_DIM
GMLP_CHUNK = 128
ATTN_HEADS = 8
ATTN_KV_HEADS = 2
GQA_GROUP = ATTN_HEADS // ATTN_KV_HEADS
ATTN_WIDTH = ATTN_HEADS * HEAD_DIM
KV_WIDTH = ATTN_KV_HEADS * HEAD_DIM
Q_BLOCK = 128
ROPE_THETA = 10000.0
ROPE_PAIRS_PER_AXIS = HEAD_DIM // 4

D_MIX = MLSTM_WIDTH + GMLP_WIDTH + ATTN_WIDTH

COL_MQ = 0
COL_MK = COL_MQ + MLSTM_WIDTH
COL_MV = COL_MK + MLSTM_WIDTH
COL_MO = COL_MV + MLSTM_WIDTH
COL_GATES = COL_MO + MLSTM_WIDTH
N_GATE_COLS = 4 * MLSTM_HEADS
COL_GU = COL_GATES + N_GATE_COLS
COL_GV = COL_GU + GMLP_WIDTH
COL_AQ = COL_GV + GMLP_WIDTH
COL_AK = COL_AQ + ATTN_WIDTH
COL_AV = COL_AK + KV_WIDTH
D_IN = COL_AV + KV_WIDTH
SPLIT_IDX = (COL_MK, COL_MV, COL_MO, COL_GATES, COL_GU, COL_GV, COL_AQ, COL_AK, COL_AV)

N_EXPERTS = 32
TOP_K = 4
D_FF_EXPERT = 1024
SWIGLU_LIMIT = 7.0
SWIGLU_ALPHA = 1.702
MOE_BLOCK = 128

kernel_name = "hymba_style_mlstm_gmlp_gqa_moe_dit"


def rms_norm(x, gain=None):
    xf = x.astype(jnp.float32)
    y = xf * lax.rsqrt(jnp.mean(xf * xf, axis=-1, keepdims=True) + EPS)
    if gain is not None:
        y = y * gain.astype(jnp.float32)
    return y.astype(x.dtype)


def modulate(x, shift, scale):
    return rms_norm(x) * (1 + scale) + shift


def axial_rope(rows):
    row = jnp.repeat(jnp.arange(rows, dtype=jnp.float32), GRID_W)
    col = jnp.tile(jnp.arange(GRID_W, dtype=jnp.float32), rows)
    inv_freq = ROPE_THETA ** (-jnp.arange(ROPE_PAIRS_PER_AXIS, dtype=jnp.float32) / ROPE_PAIRS_PER_AXIS)
    ang = jnp.concatenate([row[:, None] * inv_freq, col[:, None] * inv_freq], axis=-1)
    return jnp.cos(ang), jnp.sin(ang)


def apply_rope(x, cos, sin):
    c = cos[None, :, None, :].astype(x.dtype)
    s = sin[None, :, None, :].astype(x.dtype)
    x1, x2 = x[..., :HEAD_DIM // 2], x[..., HEAD_DIM // 2:]
    return jnp.concatenate([x1 * c - x2 * s, x2 * c + x1 * s], axis=-1)


def mlstm_scan(q, k, v, log_i, log_f, state):
    B, H, T, dh = q.shape
    L = MLSTM_CHUNK
    nc = T // L

    def to_chunks(a):
        return jnp.moveaxis(a.reshape(B, H, nc, L, *a.shape[3:]), 2, 0)

    xs = (to_chunks(q), to_chunks(k), to_chunks(v), to_chunks(log_i), to_chunks(log_f))
    lower = jnp.tril(jnp.ones((L, L), dtype=bool))

    def step(carry, inp):
        C, n, m = carry
        qc, kc, vc, ic, fc = inp
        qf, kf, vf = qc.astype(jnp.float32), kc.astype(jnp.float32), vc.astype(jnp.float32)
        b = jnp.cumsum(fc, axis=-1)
        dmat = jnp.where(lower, b[..., :, None] - b[..., None, :] + ic[..., None, :], -jnp.inf)
        inter = b + m[..., None]
        m_t = jnp.maximum(inter, jnp.max(dmat, axis=-1))
        s = jnp.einsum('bhtd,bhsd->bhts', qf, kf) * jnp.exp(dmat - m_t[..., None])
        w_inter = jnp.exp(inter - m_t)
        num = jnp.einsum('bhts,bhse->bhte', s, vf) + w_inter[..., None] * jnp.einsum('bhtd,bhde->bhte', qf, C)
        den = jnp.sum(s, axis=-1) + w_inter * jnp.einsum('bhtd,bhd->bht', qf, n)
        h = num / jnp.maximum(jnp.abs(den), jnp.exp(-m_t))[..., None]
        b_end = b[..., -1]
        dec = b_end[..., None] - b + ic
        m_new = jnp.maximum(b_end + m, jnp.max(dec, axis=-1))
        ws = jnp.exp(dec - m_new[..., None])
        w_prev = jnp.exp(b_end + m - m_new)
        C_new = w_prev[..., None, None] * C + jnp.einsum('bhs,bhsd,bhse->bhde', ws, kf, vf)
        n_new = w_prev[..., None] * n + jnp.einsum('bhs,bhsd->bhd', ws, kf)
        return (C_new, n_new, m_new), h.astype(q.dtype)

    state, hs = lax.scan(step, state, xs)
    return jnp.moveaxis(hs, 0, 2).reshape(B, H, T, dh), state


def mlstm_prep(q, k, v, g):
    B, T, _ = q.shape

    def heads(a):
        return a.reshape(B, T, MLSTM_HEADS, HEAD_DIM).transpose(0, 2, 1, 3)

    g = g.astype(jnp.float32).reshape(B, T, 4, MLSTM_HEADS).transpose(2, 0, 3, 1)
    return (heads(q), heads(k) * HEAD_DIM ** -0.5, heads(v),
            g[0], jax.nn.log_sigmoid(g[1]), g[2], jax.nn.log_sigmoid(g[3]))


def mlstm_mixer(pc, pl):
    qc, kc, vc, icf, fcf, icb, fcb = mlstm_prep(pc[0], pc[1], pc[2], pc[4])
    ql, kl, vl, ilf, flf, ilb, flb = mlstm_prep(pl[0], pl[1], pl[2], pl[4])
    B = qc.shape[0]
    zero = (jnp.zeros((B, MLSTM_HEADS, HEAD_DIM, HEAD_DIM), jnp.float32),
            jnp.zeros((B, MLSTM_HEADS, HEAD_DIM), jnp.float32),
            jnp.zeros((B, MLSTM_HEADS), jnp.float32))

    def flip(a):
        return jnp.flip(a, axis=2)

    h_cf, s_f = mlstm_scan(qc, kc, vc, icf, fcf, zero)
    h_lf, _ = mlstm_scan(ql, kl, vl, ilf, flf, s_f)
    h_cb, s_b = mlstm_scan(flip(qc), flip(kc), flip(vc), flip(icb), flip(fcb), zero)
    h_lb, _ = mlstm_scan(flip(ql), flip(kl), flip(vl), flip(ilb), flip(flb), s_b)

    def out(h_f, h_b, o):
        h = h_f + flip(h_b)
        Bh, H, T, dh = h.shape
        return jax.nn.sigmoid(o) * h.transpose(0, 2, 1, 3).reshape(Bh, T, H * dh)

    return out(h_cf, h_cb, pc[3]), out(h_lf, h_lb, pl[3])


def chunk_mlp(u, v, gmlp_norm, ws, bias):
    B, T, _ = u.shape
    u = jax.nn.gelu(u)
    v = rms_norm(jax.nn.gelu(v), gmlp_norm)
    vc = v.reshape(B, T // GMLP_CHUNK, GMLP_CHUNK, GMLP_GROUPS, HEAD_DIM)
    mixed = jnp.einsum('gpr,bnrgc->bnpgc', ws, vc) + bias.T[:, :, None]
    return u * mixed.reshape(B, T, GMLP_WIDTH)


def attn_qkv(q, k, v, q_norm, k_norm, cos, sin):
    B, T, _ = q.shape
    q = rms_norm(q.reshape(B, T, ATTN_HEADS, HEAD_DIM), q_norm)
    k = rms_norm(k.reshape(B, T, ATTN_KV_HEADS, HEAD_DIM), k_norm)
    if cos is not None:
        q = apply_rope(q, cos, sin)
        k = apply_rope(k, cos, sin)
    return (q.reshape(B, T, ATTN_KV_HEADS, GQA_GROUP, HEAD_DIM), k,
            v.reshape(B, T, ATTN_KV_HEADS, HEAD_DIM))


def gqa_block(q, k, v):
    s = jnp.einsum('bqkgd,bskd->bkgqs', q, k).astype(jnp.float32) * HEAD_DIM ** -0.5
    p = jax.nn.softmax(s, axis=-1).astype(v.dtype)
    o = jnp.einsum('bkgqs,bskd->bqkgd', p, v)
    return o.reshape(o.shape[0], o.shape[1], ATTN_WIDTH)


def latent_attention(q, k_all, v_all):
    B, T = q.shape[:2]
    nb = T // Q_BLOCK
    qb = jnp.swapaxes(q.reshape(B, nb, Q_BLOCK, ATTN_KV_HEADS, GQA_GROUP, HEAD_DIM), 0, 1)
    out = lax.map(lambda qq: gqa_block(qq, k_all, v_all), qb)
    return jnp.swapaxes(out, 0, 1).reshape(B, T, ATTN_WIDTH)


def merge_heads(y, mix_norm):
    B, T, _ = y.shape
    y = rms_norm(y.reshape(B, T, D_MIX // HEAD_DIM, HEAD_DIM)).reshape(B, T, D_MIX)
    return y * mix_norm


def token_mixers(hc, hl, cos, sin, w_in, b_in, q_norm, k_norm, gmlp_norm, gmlp_ws, gmlp_b, mix_norm, ctx_out):
    pc = jnp.split(hc @ w_in + b_in, SPLIT_IDX, axis=-1)
    pl = jnp.split(hl @ w_in + b_in, SPLIT_IDX, axis=-1)
    m_c, m_l = mlstm_mixer(pc, pl)
    g_l = chunk_mlp(pl[5], pl[6], gmlp_norm, gmlp_ws, gmlp_b)
    qc, kc, vc = attn_qkv(pc[7], pc[8], pc[9], q_norm, k_norm, None, None)
    ql, kl, vl = attn_qkv(pl[7], pl[8], pl[9], q_norm, k_norm, cos, sin)
    a_l = latent_attention(ql, jnp.concatenate([kc, kl], axis=1), jnp.concatenate([vc, vl], axis=1))
    y_l = merge_heads(jnp.concatenate([m_l, g_l, a_l], axis=-1), mix_norm)
    if not ctx_out:
        return None, y_l
    g_c = chunk_mlp(pc[5], pc[6], gmlp_norm, gmlp_ws, gmlp_b)
    a_c = gqa_block(qc, kc, vc)
    y_c = merge_heads(jnp.concatenate([m_c, g_c, a_c], axis=-1), mix_norm)
    return y_c, y_l


def moe_ffn(h, router_w, router_b, w_gate_up, b_gate_up, w_down, b_down):
    n_tok, d = h.shape
    logits = (h @ router_w + router_b).astype(jnp.float32)
    top_val, top_idx = lax.top_k(logits, TOP_K)
    gates = jax.nn.softmax(top_val, axis=-1).astype(h.dtype)
    flat_e = top_idx.reshape(-1)
    n_assign = n_tok * TOP_K
    order = jnp.argsort(flat_e, stable=True)
    sorted_e = flat_e[order]
    sorted_tok = (order // TOP_K).astype(jnp.int32)
    sorted_gate = gates.reshape(-1)[order]
    counts = jnp.bincount(flat_e, length=N_EXPERTS)
    padded = (counts + MOE_BLOCK - 1) // MOE_BLOCK * MOE_BLOCK
    ends_padded = jnp.cumsum(padded)
    start_padded = ends_padded - padded
    start = jnp.cumsum(counts) - counts
    dest = start_padded[sorted_e] + jnp.arange(n_assign) - start[sorted_e]
    n_blocks = -(-n_assign // MOE_BLOCK) + N_EXPERTS
    n_slots = n_blocks * MOE_BLOCK
    slot_tok = jnp.full((n_slots,), n_tok, jnp.int32).at[dest].set(sorted_tok)
    slot_gate = jnp.zeros((n_slots,), h.dtype).at[dest].set(sorted_gate)
    block_expert = jnp.minimum(
        jnp.searchsorted(ends_padded, jnp.arange(n_blocks) * MOE_BLOCK, side='right'), N_EXPERTS - 1)
    h_pad = jnp.concatenate([h, jnp.zeros((1, d), h.dtype)], axis=0)

    def expert_block(args):
        tok_idx, e = args
        gu = h_pad[tok_idx] @ w_gate_up[e] + b_gate_up[e]
        x_glu = jnp.minimum(gu[:, 0::2], SWIGLU_LIMIT)
        x_lin = jnp.clip(gu[:, 1::2], -SWIGLU_LIMIT, SWIGLU_LIMIT)
        act = x_glu * jax.nn.sigmoid(SWIGLU_ALPHA * x_glu) * (x_lin + 1)
        return act @ w_down[e] + b_down[e]

    y_slots = lax.map(expert_block, (slot_tok.reshape(n_blocks, MOE_BLOCK), block_expert))
    y = jnp.zeros((n_tok + 1, d), h.dtype).at[slot_tok].add(y_slots.reshape(n_slots, d) * slot_gate[:, None])
    return y[:n_tok]


def setup_inputs(seed: int = 0) -> dict:
    key = jax.random.key(seed)
    ks = jax.random.split(key, 22)
    f32 = jnp.float32
    nrm = lambda k, shape, s: jax.random.normal(k, shape, f32) * s
    b_in = nrm(ks[7], (DEPTH, D_IN), 0.02)
    forget_bias = jnp.linspace(3.0, 6.0, MLSTM_HEADS, dtype=f32)
    b_in = b_in.at[:, COL_GATES + MLSTM_HEADS:COL_GATES + 2 * MLSTM_HEADS].add(forget_bias)
    b_in = b_in.at[:, COL_GATES + 3 * MLSTM_HEADS:COL_GATES + 4 * MLSTM_HEADS].add(forget_bias)
    return {
        "x": nrm(ks[0], (BATCH, SEQ, D_MODEL), 1.0),
        "c": nrm(ks[1], (BATCH, D_MODEL), 1.0),
        "ctx": nrm(ks[2], (BATCH, CTX_LEN, D_MODEL), 1.0),
        "c_ctx": nrm(ks[3], (D_MODEL,), 1.0),
        "w_ada": nrm(ks[4], (DEPTH, D_MODEL, 6 * D_MODEL), 0.2 * D_MODEL ** -0.5),
        "b_ada": nrm(ks[5], (DEPTH, 6 * D_MODEL), 0.02),
        "w_in": nrm(ks[6], (DEPTH, D_MODEL, D_IN), D_MODEL ** -0.5),
        "b_in": b_in,
        "q_norm": 1.0 + nrm(ks[8], (DEPTH, HEAD_DIM), 0.02),
        "k_norm": 1.0 + nrm(ks[9], (DEPTH, HEAD_DIM), 0.02),
        "gmlp_norm": 1.0 + nrm(ks[10], (DEPTH, GMLP_WIDTH), 0.02),
        "gmlp_ws": nrm(ks[11], (DEPTH, GMLP_GROUPS, GMLP_CHUNK, GMLP_CHUNK), GMLP_CHUNK ** -0.5),
        "gmlp_b": 1.0 + nrm(ks[12], (DEPTH, GMLP_GROUPS, GMLP_CHUNK), 0.1),
        "mix_norm": 1.0 + nrm(ks[13], (DEPTH, D_MIX), 0.02),
        "w_out": nrm(ks[14], (DEPTH, D_MIX, D_MODEL), D_MIX ** -0.5),
        "router_w": nrm(ks[15], (DEPTH, D_MODEL, N_EXPERTS), D_MODEL ** -0.5),
        "router_b": nrm(ks[16], (DEPTH, N_EXPERTS), 0.01),
        "w_gate_up": nrm(ks[17], (DEPTH, N_EXPERTS, D_MODEL, 2 * D_FF_EXPERT), D_MODEL ** -0.5),
        "b_gate_up": nrm(ks[18], (DEPTH, N_EXPERTS, 2 * D_FF_EXPERT), 0.02),
        "w_down": nrm(ks[19], (DEPTH, N_EXPERTS, D_FF_EXPERT, D_MODEL), D_FF_EXPERT ** -0.5),
        "b_down": nrm(ks[20], (DEPTH, N_EXPERTS, D_MODEL), 0.02),
        "final_norm": 1.0 + nrm(ks[21], (D_MODEL,), 0.02),
    }


def reference(x, c, ctx, c_ctx, w_ada, b_ada, w_in, b_in, q_norm, k_norm, gmlp_norm, gmlp_ws, gmlp_b,
              mix_norm, w_out, router_w, router_b, w_gate_up, b_gate_up, w_down, b_down, final_norm):
    B, T, D = x.shape
    rows = T // GRID_W
    cos, sin = axial_rope(rows)
    xl, xc = x, ctx
    Bc, Tc = xc.shape[0], xc.shape[1]
    for l in range(DEPTH):
        ctx_out = l < DEPTH - 1
        mod_l = jax.nn.silu(c) @ w_ada[l] + b_ada[l]
        mod_c = jax.nn.silu(c_ctx) @ w_ada[l] + b_ada[l]
        sh1, sc1, g1, sh2, sc2, g2 = jnp.split(mod_l[:, None, :], 6, axis=-1)
        csh1, csc1, cg1, csh2, csc2, cg2 = jnp.split(mod_c[None, None, :], 6, axis=-1)
        hl = modulate(xl, sh1, sc1)
        hc = modulate(xc, csh1, csc1)
        y_c, y_l = token_mixers(hc, hl, cos, sin, w_in[l], b_in[l], q_norm[l], k_norm[l], gmlp_norm[l],
                                gmlp_ws[l], gmlp_b[l], mix_norm[l], ctx_out)
        xl = xl + g1 * (y_l @ w_out[l])
        hl2 = modulate(xl, sh2, sc2)
        if ctx_out:
            xc = xc + cg1 * (y_c @ w_out[l])
            hc2 = modulate(xc, csh2, csc2)
            tokens = jnp.concatenate([hc2.reshape(Bc * Tc, D), hl2.reshape(B * T, D)], axis=0)
            f = moe_ffn(tokens, router_w[l], router_b[l], w_gate_up[l], b_gate_up[l], w_down[l], b_down[l])
            xc = xc + cg2 * f[:Bc * Tc].reshape(Bc, Tc, D)
            xl = xl + g2 * f[Bc * Tc:].reshape(B, T, D)
        else:
            f = moe_ffn(hl2.reshape(B * T, D), router_w[l], router_b[l], w_gate_up[l], b_gate_up[l],
                        w_down[l], b_down[l])
            xl = xl + g2 * f.reshape(B, T, D)
    return rms_norm(xl, final_norm)
```

```cpp
#include <hip/hip_runtime.h>
#include <cstdio>
#include <cstdint>

#ifndef MK_N_LAUNCHES
#define MK_N_LAUNCHES 1
#endif

#define GAS __attribute__((address_space(1)))
#define LAS __attribute__((address_space(3)))
#define DI __device__ __forceinline__
typedef unsigned short bf16;
typedef short bf16x8 __attribute__((ext_vector_type(8)));
typedef float f32x4 __attribute__((ext_vector_type(4)));
typedef float f32x2 __attribute__((ext_vector_type(2)));
typedef unsigned u32x4 __attribute__((ext_vector_type(4)));
typedef int i32x4 __attribute__((ext_vector_type(4)));
typedef unsigned u32x2 __attribute__((ext_vector_type(2)));
typedef __bf16 bf16x2_t __attribute__((ext_vector_type(2)));
typedef GAS unsigned gu32;

constexpr int D = 1024, NB = 16, T = 4096, TC = 256, DEPTH = 4;
constexpr int NCTX = NB * TC;
constexpr int NLAT = NB * T;
constexpr int NTOK = NCTX + NLAT;
constexpr int NRT = NTOK / 256;
constexpr int TKV = TC + T;
constexpr int DIN = 2320, NPROJ = 2304;
constexpr int NE = 32, TOPK = 4, DFF = 1024;
constexpr int NSLOT_MAX = NTOK * TOPK + NE * 256;
constexpr int NRT_MOE_MAX = NSLOT_MAX / 256;
constexpr int NGRP = NTOK / 16;
constexpr float EPS = 1e-6f;
constexpr float C2 = 0.125f * 1.4426950408889634f;

constexpr size_t al256(size_t x) { return (x + 255) & ~(size_t)255; }
constexpr size_t WS_CTL = 0, CTL_ZERO_BYTES = 1u << 20;
constexpr size_t WS_WIN = CTL_ZERO_BYTES;
constexpr size_t WS_WOUT = WS_WIN + (size_t)DEPTH * NPROJ * D * 2;
constexpr size_t WS_WGU = WS_WOUT + (size_t)DEPTH * D * D * 2;
constexpr size_t WS_WDN = WS_WGU + (size_t)DEPTH * NE * 2 * DFF * D * 2;
constexpr size_t WS_WG = WS_WDN + (size_t)DEPTH * NE * D * DFF * 2;
constexpr size_t WS_WR = WS_WG + (size_t)DEPTH * 2 * 16 * D * 2;
constexpr size_t WS_GWS = WS_WR + (size_t)DEPTH * 2 * 32 * D * 2;
constexpr size_t WS_MOD = WS_GWS + (size_t)DEPTH * 4 * 128 * 128 * 2;
constexpr size_t WS_ROPE = al256(WS_MOD + (size_t)DEPTH * 17 * 6 * D * 4);
constexpr size_t WS_XLA = al256(WS_ROPE + (size_t)2 * 65 * 16 * 4);
constexpr size_t XL_BYTES = (size_t)NTOK * D * 2;
constexpr size_t WS_XLB = WS_XLA + (size_t)NTOK * D * 4;
constexpr size_t WS_H = WS_XLB + (size_t)NTOK * D * 4;
constexpr size_t WS_Y = WS_H + (size_t)NTOK * D * 2;
constexpr size_t WS_MQ = WS_Y + (size_t)NTOK * D * 2;
constexpr size_t WS_MK = WS_MQ + (size_t)NTOK * 256 * 2;
constexpr size_t WS_MV = WS_MK + (size_t)NTOK * 256 * 2;
constexpr size_t WS_MO = WS_MV + (size_t)NTOK * 256 * 2;
constexpr size_t WS_MG = WS_MO + (size_t)NTOK * 256 * 2;
constexpr size_t WS_GU = WS_MG + (size_t)NTOK * 16 * 4;
constexpr size_t WS_GV = WS_GU + (size_t)NTOK * 256 * 2;
constexpr size_t WS_AQ = WS_GV + (size_t)NTOK * 256 * 2;
constexpr size_t WS_AK = WS_AQ + (size_t)NTOK * 512 * 2;
constexpr size_t WS_AV = WS_AK + (size_t)NB * 2 * TKV * 64 * 2;
constexpr size_t WS_HFB = WS_AV + (size_t)NB * 2 * TKV * 64 * 2;
constexpr size_t WS_TOKE = WS_HFB + (size_t)NB * 4 * 2 * TKV * 64 * 4;
constexpr size_t WS_TOKG = WS_TOKE + (size_t)NTOK * 4 * 4;
constexpr size_t WS_TOKS = WS_TOKG + (size_t)NTOK * 4 * 4;
constexpr size_t WS_GHIST = WS_TOKS + (size_t)NTOK * 4 * 4;
constexpr size_t WS_BHIST = WS_GHIST + (size_t)NGRP * 32 * 4;
constexpr size_t WS_SLTOK = WS_BHIST + (size_t)1024 * 32 * 4;
constexpr size_t WS_SLG = WS_SLTOK + (size_t)NSLOT_MAX * 4;
constexpr size_t WS_RTE = WS_SLG + (size_t)NSLOT_MAX * 4;
constexpr size_t WS_RTEB = al256(WS_RTE + (size_t)(NRT_MOE_MAX + 64) * 4);
constexpr size_t WS_ACT = al256(WS_RTEB + 2048);
constexpr size_t WS_MOUT = WS_ACT + (size_t)NSLOT_MAX * DFF * 2;
constexpr size_t WS_CSGU = WS_MOUT + (size_t)NSLOT_MAX * D * 2;
constexpr size_t WS_H8 = WS_CSGU + (size_t)DEPTH * NE * 2 * DFF * 4;
constexpr size_t WS_HS = WS_H8 + (size_t)NTOK * D;
constexpr size_t WS_SLS = WS_HS + (size_t)NTOK * 4;
constexpr size_t WS_CSIN = al256(WS_SLS + (size_t)NSLOT_MAX * 4);
constexpr size_t WS_MSC = al256(WS_CSIN + (size_t)DEPTH * NPROJ * 4);
constexpr size_t WS_DSC = al256(WS_MSC + (size_t)NSLOT_MAX * 16 * 4);
constexpr size_t WS_CSOUT = al256(WS_DSC + (size_t)NTOK * 16 * 4);
constexpr size_t WS_END = al256(WS_CSOUT + (size_t)DEPTH * D * 4);
static_assert(WS_END < (size_t)4200 * 1000 * 1000, "workspace map exceeds 4x the largest input");

constexpr int CW_TMO = 0;
constexpr int CW_Q = 64;
constexpr int CW_BAR = 4096;

constexpr int SCR_BYTES = 135168;
constexpr int LDSCTL_OFF = SCR_BYTES;
constexpr int ROPE_LDS_OFF = LDSCTL_OFF + 4096 + 6144;
constexpr int LDS_BYTES = 155648;

#define LDS_WAIT() asm volatile("s_waitcnt lgkmcnt(0)" ::: "memory")
#define VM_WAIT() asm volatile("s_waitcnt vmcnt(0)" ::: "memory")
#define RLX_AGENT __ATOMIC_RELAXED, __HIP_MEMORY_SCOPE_AGENT
DI unsigned pk2(float lo, float hi) { f32x2 v = {lo, hi}; bf16x2_t b = __builtin_convertvector(v, bf16x2_t); return __builtin_bit_cast(unsigned, b); }
DI bf16 f2bf(float f) { return (bf16)(pk2(f, 0.f) & 0xffffu); }
DI float bf2f(unsigned b) { return __uint_as_float(b << 16); }
DI float bflo(unsigned w) { return __uint_as_float(w << 16); }
DI float bfhi(unsigned w) { return __uint_as_float(w & 0xffff0000u); }
DI int opaque_tid() { int t = threadIdx.x; asm volatile("" : "+v"(t)); return t; }
DI int opaque_bid() { int b = blockIdx.x; asm volatile("" : "+s"(b)); return b; }
template <class Tp> DI Tp* opaque_ptr(Tp* p) { asm volatile("" : "+s"(p)); return p; }
template <class Tp> DI const GAS Tp* uni(const GAS Tp* p) { const unsigned long long v = (unsigned long long)p; const unsigned lo = (unsigned)__builtin_amdgcn_readfirstlane((int)(unsigned)v), hi = (unsigned)__builtin_amdgcn_readfirstlane((int)(unsigned)(v >> 32)); return (const GAS Tp*)(((unsigned long long)hi << 32) | lo); }
template <class Tp> DI GAS Tp* uni(GAS Tp* p) { const unsigned long long v = (unsigned long long)p; const unsigned lo = (unsigned)__builtin_amdgcn_readfirstlane((int)(unsigned)v), hi = (unsigned)__builtin_amdgcn_readfirstlane((int)(unsigned)(v >> 32)); return (GAS Tp*)(((unsigned long long)hi << 32) | lo); }
DI unsigned pk_fp8x4(float a, float b, float c, float d) { int p = __builtin_amdgcn_cvt_pk_fp8_f32(fminf(fmaxf(a, -448.f), 448.f), fminf(fmaxf(b, -448.f), 448.f), 0, false); p = __builtin_amdgcn_cvt_pk_fp8_f32(fminf(fmaxf(c, -448.f), 448.f), fminf(fmaxf(d, -448.f), 448.f), p, true); return (unsigned)p; }
DI unsigned pk_i8x4(float a, float b, float c, float d) { const int q0 = (int)rintf(a), q1 = (int)rintf(b), q2 = (int)rintf(c), q3 = (int)rintf(d); return (unsigned)(q0 & 255) | ((unsigned)(q1 & 255) << 8) | ((unsigned)(q2 & 255) << 16) | ((unsigned)q3 << 24); }
constexpr float YS = 127.0f / 8.0f;
DI unsigned pk_fp8x4_nc(float a, float b, float c, float d) { int p = __builtin_amdgcn_cvt_pk_fp8_f32(a, b, 0, false); p = __builtin_amdgcn_cvt_pk_fp8_f32(c, d, p, true); return (unsigned)p; }
template <int CTRL> DI float dpp_f(float v) { return __builtin_bit_cast(float, __builtin_amdgcn_update_dpp(0, __builtin_bit_cast(int, v), CTRL, 0xF, 0xF, true)); }
template <int CTRL> DI int dpp_i(int v) { return __builtin_amdgcn_update_dpp(0, v, CTRL, 0xF, 0xF, true); }
DI float sum_x16(float v) { auto r = __builtin_amdgcn_permlane16_swap(__float_as_uint(v), __float_as_uint(v), false, false); return __uint_as_float(r[0]) + __uint_as_float(r[1]); }
DI float sum_x32(float v) { auto r = __builtin_amdgcn_permlane32_swap(__float_as_uint(v), __float_as_uint(v), false, false); return __uint_as_float(r[0]) + __uint_as_float(r[1]); }
DI float max_x16(float v) { auto r = __builtin_amdgcn_permlane16_swap(__float_as_uint(v), __float_as_uint(v), false, false); return fmaxf(__uint_as_float(r[0]), __uint_as_float(r[1])); }
DI float max_x32(float v) { auto r = __builtin_amdgcn_permlane32_swap(__float_as_uint(v), __float_as_uint(v), false, false); return fmaxf(__uint_as_float(r[0]), __uint_as_float(r[1])); }
DI float sum_x16x32(float v) { return sum_x32(sum_x16(v)); }
DI float max_x16x32(float v) { return max_x32(max_x16(v)); }
DI float sum_row16(float v) { v += dpp_f<0xB1>(v); v += dpp_f<0x4E>(v); v += dpp_f<0x141>(v); v += dpp_f<0x140>(v); return v; }
DI float max_row16(float v) { v = fmaxf(v, dpp_f<0xB1>(v)); v = fmaxf(v, dpp_f<0x4E>(v)); v = fmaxf(v, dpp_f<0x141>(v)); v = fmaxf(v, dpp_f<0x140>(v)); return v; }
DI float sum_oct(float v) { v += dpp_f<0xB1>(v); v += dpp_f<0x4E>(v); v += dpp_f<0x141>(v); return v; }
DI float sum_quad(float v) { v += dpp_f<0xB1>(v); v += dpp_f<0x4E>(v); return v; }
template <int CTRL, int RMASK> DI float dpp_id(float idv, float v) { return __builtin_bit_cast(float, __builtin_amdgcn_update_dpp(__builtin_bit_cast(int, idv), __builtin_bit_cast(int, v), CTRL, RMASK, 0xF, false)); }
DI float scan_sum64(float v) { v += dpp_id<0x111, 0xF>(0.f, v); v += dpp_id<0x112, 0xF>(0.f, v); v += dpp_id<0x114, 0xF>(0.f, v); v += dpp_id<0x118, 0xF>(0.f, v); v += dpp_id<0x142, 0xA>(0.f, v); v += dpp_id<0x143, 0xC>(0.f, v); return v; }
DI float scan_max64(float v) { const float ni = -INFINITY; v = fmaxf(v, dpp_id<0x111, 0xF>(ni, v)); v = fmaxf(v, dpp_id<0x112, 0xF>(ni, v)); v = fmaxf(v, dpp_id<0x114, 0xF>(ni, v)); v = fmaxf(v, dpp_id<0x118, 0xF>(ni, v));
    v = fmaxf(v, dpp_id<0x142, 0xA>(ni, v)); v = fmaxf(v, dpp_id<0x143, 0xC>(ni, v)); return v; }
DI float wave_sum(float v) { return sum_x16x32(sum_row16(v)); }
DI float wave_max(float v) { return max_x16x32(max_row16(v)); }
DI float fast_exp(float x) { return __builtin_amdgcn_exp2f(x * 1.4426950408889634f); }
DI float fast_sigmoid(float x) { return __builtin_amdgcn_rcpf(1.0f + fast_exp(-x)); }
DI float gelu_tanh(float x) { const float u = 0.7978845608028654f * (x + 0.044715f * x * x * x); return x * fast_sigmoid(2.0f * u); }
DI float log_sigmoid(float x) { return fminf(x, 0.f) - __builtin_amdgcn_logf(1.0f + fast_exp(-fabsf(x))) * 0.6931471805599453f; }
DI int mod_row(int row) { return row < NCTX ? 16 : ((row - NCTX) >> 12); }

#define XB_TMO      128
#define XB_XCNT(j)  (256  + 64 * (j))
#define XB_XSUB(j)  (1280 + 64 * (j))
#define XB_XGEN(j)  (2304 + 64 * (j))
#define XB_TOP      3328
#define XB_TOPGEN   3392
#define XCD_BAR_WORDS 3456
#define XB_SPIN_CAP (1u << 22)
DI unsigned xb_ld(unsigned* p)              { return __hip_atomic_load(p, __ATOMIC_RELAXED, __HIP_MEMORY_SCOPE_AGENT); }
DI unsigned xb_add(unsigned* p, unsigned v) { return __hip_atomic_fetch_add(p, v, __ATOMIC_RELAXED, __HIP_MEMORY_SCOPE_AGENT); }
DI unsigned xb_xcc_id() { return (unsigned)__builtin_amdgcn_s_getreg((3 << 11) | 20) & 0xFu; }
#define XB_SPIN(cond, bar) do { unsigned _sp = 0; while (cond) { __builtin_amdgcn_s_sleep(1); \
    if ((++_sp & 255u) == 0u) { if (xb_ld(&(bar)[XB_TMO])) break; if (_sp > XB_SPIN_CAP) { atomicAdd(&(bar)[XB_TMO], 1u); break; } } } } while (0)
struct XcdBarrier { unsigned* bar; unsigned x; volatile LAS unsigned* st; };
DI XcdBarrier xcd_barrier_post(unsigned* bar, volatile LAS unsigned* st) {
    XcdBarrier b; b.bar = bar; b.x = xb_xcc_id(); b.st = st;
    if (threadIdx.x == 0) (void)xb_add(&bar[XB_XCNT(b.x)], 1u);
    return b;
}
DI void xcd_barrier_complete(unsigned* bar, unsigned x, unsigned& nloc, unsigned& nx) {
    const unsigned G = gridDim.x * gridDim.y * gridDim.z;
    unsigned sum, cnt, mine, sp = 0u;
    for (;;) {
        sum = 0u; cnt = 0u; mine = 0u;
#pragma unroll
        for (unsigned j = 0; j < 16; ++j) { const unsigned c = xb_ld(&bar[XB_XCNT(j)]); sum += c; cnt += (c > 0u) ? 1u : 0u; mine = (j == x) ? c : mine; }
        if (sum == G) break;
        __builtin_amdgcn_s_sleep(1);
        if ((++sp & 255u) == 0u) { if (xb_ld(&bar[XB_TMO])) break; if (sp > XB_SPIN_CAP) { atomicAdd(&bar[XB_TMO], 1u); break; } }
    }
    nloc = mine > 0u ? mine : 1u; nx = cnt > 0u ? cnt : 1u;
}
DI void xcd_barrier(const XcdBarrier& b) {
    asm volatile("s_waitcnt vmcnt(0)" ::: "memory");
    __syncthreads();
    if (threadIdx.x == 0) {
        unsigned* bar = b.bar;
        __builtin_amdgcn_s_waitcnt(0);
        unsigned nloc = b.st[0], nx = b.st[1];
        if (nloc == 0u) { xcd_barrier_complete(bar, b.x, nloc, nx); b.st[0] = nloc; b.st[1] = nx; }
        const unsigned old = xb_add(&bar[XB_XSUB(b.x)], 1u);
        const unsigned gen = old / nloc;
        if (old + 1u == (gen + 1u) * nloc) {
            __builtin_amdgcn_fence(__ATOMIC_RELEASE, "agent");
            asm volatile("s_waitcnt vmcnt(0)" ::: "memory");
            const unsigned og = xb_add(&bar[XB_TOP], 1u);
            const unsigned tg = og / nx;
            if (og + 1u == (tg + 1u) * nx) xb_add(&bar[XB_TOPGEN], 1u);
            else XB_SPIN(xb_ld(&bar[XB_TOPGEN]) == tg, bar);
            __builtin_amdgcn_fence(__ATOMIC_ACQUIRE, "agent");
            xb_add(&bar[XB_XGEN(b.x)], 1u);
            asm volatile("s_waitcnt vmcnt(0)" ::: "memory");
        } else {
            XB_SPIN(xb_ld(&bar[XB_XGEN(b.x)]) == gen, bar);
            __builtin_amdgcn_fence(__ATOMIC_ACQUIRE, "agent");
            asm volatile("s_waitcnt vmcnt(0)" ::: "memory");
        }
    }
    __syncthreads();
}

namespace pg8 {
constexpr int BM = 256, BK = 64, HALF = 128, HTB = HALF * BK * 2, STAGE_BYTES = 8 * HTB, NXCD = 8, WGM = 8;
DI int lds_byte(int r, int c) { const int st = (r >> 4) * 2 + (c >> 5), rr = r & 15, cc = c & 31, ob = rr * 64 + cc * 2; return st * 1024 + (ob ^ (((ob >> 9) & 1) << 5)); }
DI void stage_rc(int b, int& R, int& C) { const int st = b / 1024, sb = b % 1024, swz = sb ^ (((sb >> 9) & 1) << 5); R = (st >> 1) * 16 + swz / 64; C = (st & 1) * 32 + (swz % 64) / 2; }
struct Unit { int pm, pn, e; };
DI void glds_s(const char* sbase_, unsigned voff, unsigned lds_dst) { unsigned keep; const unsigned long long sbase = (unsigned long long)sbase_;
    asm volatile("s_mov_b32 %0, m0\n\ts_mov_b32 m0, %3\n\ts_nop 0\n\tglobal_load_lds_dwordx4 %1, %2\n\ts_mov_b32 m0, %0" : "=&s"(keep) : "v"(voff), "s"(sbase), "s"(lds_dst) : "memory"); }
struct TileOrder {
    int nM, nN, nwg, G, c, pm0;
    DI void init(int nM_, int nN_, int G_, int c_, int pm0_ = 0) { nM = nM_; nN = nN_; nwg = nM * nN; G = G_; c = c_; pm0 = pm0_; }
    DI bool next(int i, Unit& u) const {
        const long L = (long)i * G + c; if (L >= nwg) return false;
        int wgid = (int)L; { const int q = nwg / NXCD, r = nwg % NXCD, xcd = wgid % NXCD, off = wgid / NXCD; wgid = (xcd < r ? xcd * (q + 1) : r * (q + 1) + (xcd - r) * q) + off; }
        const int nig = WGM * nN, gid = wgid / nig, fm = gid * WGM, gsz = (nM - fm) < WGM ? (nM - fm) : WGM;
        u.pm = pm0 + fm + ((wgid % nig) % gsz); u.pn = (wgid % nig) / gsz; return true;
    }
};
typedef int i32x8 __attribute__((ext_vector_type(8)));
DI f32x4 mma1(bf16x8 a, bf16x8 b, f32x4 c) { return __builtin_amdgcn_mfma_f32_16x16x32_bf16(a, b, c, 0, 0, 0); }
DI i32x4 mma1(bf16x8 a, bf16x8 b, i32x4 c) { return __builtin_amdgcn_mfma_i32_16x16x64_i8(__builtin_bit_cast(i32x4, a), __builtin_bit_cast(i32x4, b), c, 0, 0, 0); }
DI i32x8 cat8(bf16x8 a0, bf16x8 a1) { const i32x4 x0 = __builtin_bit_cast(i32x4, a0), x1 = __builtin_bit_cast(i32x4, a1); return __builtin_shufflevector(x0, x1, 0, 1, 2, 3, 4, 5, 6, 7); }
DI f32x4 mma_f8(i32x8 a, i32x8 b, f32x4 c) { asm volatile("v_mfma_f32_16x16x128_f8f6f4 %0, %1, %2, %0" : "+v"(c) : "v"(a), "v"(b)); return c; }
template <int QM> struct AccT { typedef f32x4 type; };
template <> struct AccT<1> { typedef i32x4 type; };
template <class Epi, class Src, bool DUP = false, int QM = 0>
DI void gemm_phase(LAS unsigned char* lds, const bf16* Abase, const TileOrder& S, const Src& src, const Epi& E) {
    const int tid = opaque_tid(), wid = __builtin_amdgcn_readfirstlane(tid >> 6), lane = tid & 63, wr = wid >> 2, wc = wid & 3, fr = lane & 15, fq = lane >> 4;
    unsigned voffB[2];
    constexpr unsigned RPB = QM ? 1024u : 2048u;
    constexpr int NT = QM ? 8 : 16;
    typedef typename AccT<QM>::type acc_t;
#pragma unroll
    for (int i = 0; i < 2; ++i) { int R_, C_; stage_rc(tid * 16 + i * 8192, R_, C_); voffB[i] = (unsigned)R_ * RPB + (unsigned)C_ * 2u; }
    constexpr size_t kstep = (size_t)(BK * 2), hstep = (size_t)HALF * RPB;
    const unsigned ldsb = (unsigned)(uintptr_t)lds + (unsigned)wid * 1024u;
    const int aoff = lds_byte(wr * 64 + fr, fq * 8), boff = lds_byte(wc * 32 + fr, fq * 8);
    const LAS unsigned char* ldsA = lds + aoff; const LAS unsigned char* ldsB = lds + 4 * HTB + boff;
    asm volatile("" : "+v"(ldsA), "+v"(ldsB));
#define PG8_SA(b, h) (((b) * 2 + (h)) * HTB)
#define PG8_SB(b, h) ((4 + (b) * 2 + (h)) * HTB)
#define PG8_SBR(b, h) (((b) * 2 + (h)) * HTB)
#define PG8_STAGEB(bufoff, gbase) do { _Pragma("unroll") for (int _i = 0; _i < 2; ++_i) \
        glds_s((const char*)(gbase), voffB[_i], ldsb + (unsigned)((bufoff) + _i * 8192)); } while (0)
#define PG8_STAGEA(bufoff, arr, hf, koff) do { _Pragma("unroll") for (int _i = 0; _i < 2; ++_i) \
        glds_s((const char*)Abase + (koff) + (Src::GATHER ? (size_t)0 : (size_t)(hf) * hstep), (arr)[Src::GATHER ? (hf) : 0][_i], ldsb + (unsigned)((bufoff) + _i * 8192)); } while (0)
#define PG8_LDA(dst, b, h) do { _Pragma("unroll") for (int m = 0; m < 4; ++m) { if constexpr (QM == 2) dst##8[m] = cat8(*(const LAS bf16x8*)(ldsA + PG8_SA(b, h) + m * 2048), *(const LAS bf16x8*)(ldsA + PG8_SA(b, h) + m * 2048 + 1024)); \
        else { _Pragma("unroll") for (int k = 0; k < 2; ++k) dst[m][k] = *(const LAS bf16x8*)(ldsA + PG8_SA(b, h) + m * 2048 + k * 1024); } } } while (0)
#define PG8_LDB(dst, b, h) do { _Pragma("unroll") for (int n = 0; n < 2; ++n) { if constexpr (QM == 2) dst##8[n] = cat8(*(const LAS bf16x8*)(ldsB + PG8_SBR(b, h) + n * 2048), *(const LAS bf16x8*)(ldsB + PG8_SBR(b, h) + n * 2048 + 1024)); \
        else { _Pragma("unroll") for (int k = 0; k < 2; ++k) dst[n][k] = *(const LAS bf16x8*)(ldsB + PG8_SBR(b, h) + n * 2048 + k * 1024); } } } while (0)
#define PG8_MMA(ai, bj, At, Bt) do { __builtin_amdgcn_s_setprio(1); _Pragma("unroll") for (int m = 0; m < 4; ++m) _Pragma("unroll") for (int n = 0; n < 2; ++n) { \
        if constexpr (QM == 2) acc[ai][bj][m][n] = mma_f8(Bt##8[n], At##8[m], acc[ai][bj][m][n]); \
        else { _Pragma("unroll") for (int k = 0; k < 2; ++k) acc[ai][bj][m][n] = mma1(Bt[n][k], At[m][k], acc[ai][bj][m][n]); } } __builtin_amdgcn_s_setprio(0); } while (0)
#define PG8_WAIT_V(n) asm volatile("s_waitcnt vmcnt(" #n ")" ::: "memory")
#define PG8_WAIT_L(n) asm volatile("s_waitcnt lgkmcnt(" #n ")" ::: "memory")
#define PG8_BAR __builtin_amdgcn_s_barrier()
#define PG8_SCHED __builtin_amdgcn_sched_barrier(0)
#define PG8_OFFS(dst, u) do { _Pragma("unroll") for (int _i = 0; _i < 2; ++_i) { int R_, C_; stage_rc(tid * 16 + _i * 8192, R_, C_); _Pragma("unroll") for (int _h = 0; _h < NH; ++_h) \
        dst[_h][_i] = (unsigned)src.arow(u, _h * HALF + R_) * RPB + (unsigned)C_ * 2u; } } while (0)
    Unit cur, nxt; int ui = 0;
    if (!S.next(0, cur)) return;
    LAS unsigned char* xtab = lds + STAGE_BYTES;
    const unsigned xtabb = (unsigned)(uintptr_t)lds + (unsigned)STAGE_BYTES;
#define PG8_IDXDMA(u, buf) do { if (wid == 0) glds_s(src.idx_base(), (unsigned)((u).pm * 1024 + lane * 16), xtabb + (unsigned)(buf) * 1024u); } while (0)
#define PG8_OFFS_LDS(dst, buf) do { _Pragma("unroll") for (int _i = 0; _i < 2; ++_i) { int R_, C_; stage_rc(tid * 16 + _i * 8192, R_, C_); _Pragma("unroll") for (int _h = 0; _h < 2; ++_h) \
        dst[_h][_i] = (unsigned)(*(const LAS int*)(xtab + (buf) * 1024 + (_h * HALF + R_) * 4)) * RPB + (unsigned)C_ * 2u; } } while (0)
#define PG8_EXPERT(u) (Src::EXPERT ? __builtin_amdgcn_readfirstlane((int)*(const LAS unsigned char*)(xtab + 2048 + (u).pm)) : 0)
    if constexpr (Src::EXPERT) {
        if (wid < 2) glds_s(src.rteb_base(), (unsigned)(wid * 1024 + lane * 16), xtabb + 2048u + (unsigned)wid * 1024u);
        if constexpr (Src::GATHER) { PG8_IDXDMA(cur, 0); Unit u1_; if (S.next(1, u1_)) PG8_IDXDMA(u1_, 1); }
        asm volatile("s_waitcnt vmcnt(0)" ::: "memory"); __builtin_amdgcn_s_barrier(); asm volatile("" ::: "memory");
    }
    cur.e = PG8_EXPERT(cur);
    const LAS unsigned char* etab = lds + LDSCTL_OFF + 4096; const unsigned etabb = (unsigned)(uintptr_t)lds + (unsigned)(LDSCTL_OFF + 4096);
#define PG8_ETAB(u, par) do { if constexpr (Epi::NTAB > 0) { if (wid >= 1 && wid <= Epi::NTAB) glds_s(E.tab(wid - 1, u), (unsigned)(lane * 16), etabb + (unsigned)(par) * 3072u + (unsigned)(wid - 1) * 1024u); } } while (0)
    acc_t acc[2][2][4][2];
#pragma unroll
    for (int a = 0; a < 2; ++a)
#pragma unroll
        for (int b = 0; b < 2; ++b)
#pragma unroll
            for (int m = 0; m < 4; ++m)
#pragma unroll
                for (int n = 0; n < 2; ++n) acc[a][b][m][n] = (acc_t){0, 0, 0, 0};
    bf16x8 At[4][2], B0[2][2], B1[2][2]; i32x8 At8[4], B08[2], B18[2];
    constexpr int NH = Src::GATHER ? 2 : 1;
    unsigned oA[NH][2], nO[NH][2];
    if constexpr (Src::GATHER) { PG8_OFFS_LDS(oA, 0); } else { PG8_OFFS(oA, cur); }
    const char* cB = src.bt(cur);
#define PG8_KOF(r, t) ((size_t)((((t) + (r)) & (NT - 1))) * kstep)
    int rc = (cur.pm + cur.pn) & (NT - 1), rn = rc;
    PG8_STAGEB(PG8_SB(0, 0), cB + PG8_KOF(rc, 0)); PG8_STAGEB(PG8_SB(0, 1), cB + hstep + PG8_KOF(rc, 0)); PG8_STAGEA(PG8_SA(0, 0), oA, 0, PG8_KOF(rc, 0)); PG8_STAGEA(PG8_SA(0, 1), oA, 1, PG8_KOF(rc, 0));
    if (wr == 1) PG8_BAR;
    PG8_WAIT_V(2); PG8_BAR;
    PG8_STAGEB(PG8_SB(1, 0), cB + PG8_KOF(rc, 1)); PG8_STAGEA(PG8_SA(1, 0), oA, 0, PG8_KOF(rc, 1)); PG8_STAGEB(PG8_SB(1, 1), cB + hstep + PG8_KOF(rc, 1));
    PG8_WAIT_V(6); PG8_BAR;
    for (;;) {
        const bool has_next = S.next(DUP ? ((ui + 1) >> 1) : (ui + 1), nxt);
        const char* nB = cB; rn = has_next ? ((nxt.pm + nxt.pn) & (NT - 1)) : rc;
        if (has_next) { nxt.e = PG8_EXPERT(nxt); if constexpr (Src::GATHER) { PG8_OFFS_LDS(nO, (ui + 1) & 1); } else { PG8_OFFS(nO, nxt); } nB = src.bt(nxt); }
        else {
#pragma unroll
            for (int h = 0; h < NH; ++h)
#pragma unroll
                for (int i = 0; i < 2; ++i) nO[h][i] = oA[h][i];
        }
        if constexpr (Src::GATHER) { Unit u2_; if (S.next(ui + 2, u2_)) PG8_IDXDMA(u2_, ui & 1); }
        PG8_ETAB(cur, ui & 1);
#pragma unroll 1
        for (int t = 0; t < NT; t += 2) {
            const bool last = (t == NT - 2);
            const size_t k1 = PG8_KOF(rc, t + 1), k2 = last ? PG8_KOF(rn, 0) : PG8_KOF(rc, t + 2), k3 = last ? PG8_KOF(rn, 1) : PG8_KOF(rc, t + 3);
            unsigned sx[NH][2];
#pragma unroll
            for (int h = 0; h < NH; ++h)
#pragma unroll
                for (int i = 0; i < 2; ++i) sx[h][i] = last ? nO[h][i] : oA[h][i];
            const char* b2 = (last ? nB : cB) + k2; const char* b3 = (last ? nB : cB) + k3;
            PG8_LDB(B0, 0, 0); PG8_LDB(B1, 0, 1); PG8_SCHED; PG8_LDA(At, 0, 0); PG8_STAGEA(PG8_SA(1, 1), oA, 1, k1);
            PG8_WAIT_V(8); PG8_WAIT_L(0); PG8_BAR; PG8_MMA(0, 0, At, B0); PG8_MMA(0, 1, At, B1); PG8_BAR; PG8_SCHED;
            PG8_LDA(At, 0, 1); PG8_STAGEB(PG8_SB(0, 0), b2); PG8_STAGEB(PG8_SB(0, 1), b2 + hstep); PG8_STAGEA(PG8_SA(0, 0), sx, 0, k2);
            PG8_WAIT_V(8); PG8_WAIT_L(0); PG8_BAR; PG8_MMA(1, 0, At, B0); PG8_MMA(1, 1, At, B1); PG8_BAR; PG8_SCHED;
            PG8_LDB(B0, 1, 0); PG8_LDB(B1, 1, 1); PG8_SCHED; PG8_LDA(At, 1, 0); PG8_STAGEA(PG8_SA(0, 1), sx, 1, k2);
            PG8_WAIT_V(8); PG8_WAIT_L(0); PG8_BAR; PG8_MMA(0, 0, At, B0); PG8_MMA(0, 1, At, B1); PG8_BAR; PG8_SCHED;
            PG8_LDA(At, 1, 1); PG8_STAGEB(PG8_SB(1, 0), b3); PG8_STAGEB(PG8_SB(1, 1), b3 + hstep); PG8_STAGEA(PG8_SA(1, 0), sx, 0, k3);
            PG8_WAIT_V(8); PG8_WAIT_L(0); PG8_BAR; PG8_MMA(1, 0, At, B0); PG8_MMA(1, 1, At, B1); PG8_BAR; PG8_SCHED;
        }
        if (wr == 0) PG8_BAR;
        if constexpr (QM == 2) asm volatile("s_nop 15\n\ts_nop 15" ::: "memory");
        if (!DUP || (ui & 1)) {
            if (DUP) {
#pragma unroll
                for (int a = 0; a < 2; ++a)
#pragma unroll
                    for (int b = 0; b < 2; ++b)
#pragma unroll
                        for (int m = 0; m < 4; ++m)
#pragma unroll
                            for (int n = 0; n < 2; ++n) acc[a][b][m][n] = acc[a][b][m][n] / 2;
            }
            E(acc, cur, wr, wc, fr, fq, etab + (ui & 1) * 3072);
        }
        if (!has_next) break;
        if (!DUP || (ui & 1)) {
#pragma unroll
        for (int a = 0; a < 2; ++a)
#pragma unroll
            for (int b = 0; b < 2; ++b)
#pragma unroll
                for (int m = 0; m < 4; ++m)
#pragma unroll
                    for (int n = 0; n < 2; ++n) acc[a][b][m][n] = (acc_t){0, 0, 0, 0};
        }
        cur = nxt; cB = nB; rc = rn; ++ui;
#pragma unroll
        for (int h = 0; h < NH; ++h)
#pragma unroll
            for (int i = 0; i < 2; ++i) oA[h][i] = nO[h][i];
        if (wr == 1) PG8_BAR;
    }
    PG8_WAIT_V(0);
    PG8_BAR;
#undef PG8_SA
#undef PG8_SB
#undef PG8_KOF
#undef PG8_SBR
#undef PG8_STAGEA
#undef PG8_STAGEB
#undef PG8_LDA
#undef PG8_LDB
#undef PG8_MMA
#undef PG8_WAIT_V
#undef PG8_WAIT_L
#undef PG8_BAR
#undef PG8_SCHED
#undef PG8_OFFS
#undef PG8_IDXDMA
#undef PG8_ETAB
#undef PG8_OFFS_LDS
#undef PG8_EXPERT
}
}

struct In { const float *x, *c, *ctx, *c_ctx, *w_ada, *b_ada, *w_in, *b_in, *q_norm, *k_norm, *gmlp_norm, *gmlp_ws, *gmlp_b, *mix_norm, *w_out, *router_w, *router_b, *w_gate_up, *b_gate_up, *w_down, *b_down, *final_norm; };
struct Args { In in; float* out; unsigned char* ws; int ph_lo, ph_hi; };
typedef const __attribute__((address_space(4))) Args* KArgP;
DI KArgP kargs() { KArgP p = (KArgP)__builtin_amdgcn_kernarg_segment_ptr(); asm volatile("" : "+s"(p)); return p; }

constexpr size_t TSTEP = (size_t)256 * D * 2;
template <size_t TS> struct SrcPlainT { static constexpr bool GATHER = false, EXPERT = false; const char* Bt;
    DI const char* idx_base() const { return nullptr; } DI const char* rteb_base() const { return nullptr; }
    DI int arow(const pg8::Unit& u, int r) const { return u.pm * 256 + r; }
    DI int expert(const pg8::Unit&) const { return 0; }
    DI const char* bt(const pg8::Unit& u) const { return Bt + (size_t)u.pn * TS; } };
typedef SrcPlainT<TSTEP> SrcPlain; typedef SrcPlainT<TSTEP / 2> SrcPlain8;
struct SrcMoeGather { static constexpr bool GATHER = true, EXPERT = true; unsigned char* ws; int l;
    DI const char* idx_base() const { return (const char*)(ws + WS_SLTOK); } DI const char* rteb_base() const { return (const char*)(ws + WS_RTEB); }
    DI int arow(const pg8::Unit& u, int r) const { return ((const int*)(ws + WS_SLTOK))[u.pm * 256 + r]; }
    DI int expert(const pg8::Unit& u) const { return __builtin_amdgcn_readfirstlane(((const int*)(ws + WS_RTE))[32 + u.pm]); }
    DI const char* bt(const pg8::Unit& u) const { return (const char*)(ws + WS_WGU) + ((size_t)(l * NE + u.e) * 8 + (size_t)u.pn) * (TSTEP / 2); } };
struct SrcMoePlain { static constexpr bool GATHER = false, EXPERT = true; unsigned char* ws; int l;
    DI const char* idx_base() const { return nullptr; } DI const char* rteb_base() const { return (const char*)(ws + WS_RTEB); }
    DI int arow(const pg8::Unit& u, int r) const { return u.pm * 256 + r; }
    DI int expert(const pg8::Unit& u) const { return __builtin_amdgcn_readfirstlane(((const int*)(ws + WS_RTE))[32 + u.pm]); }
    DI const char* bt(const pg8::Unit& u) const { return (const char*)(ws + WS_WDN) + ((size_t)(l * NE + u.e) * 4 + (size_t)u.pn) * (TSTEP / 2); } };

struct EpiInProj {
    unsigned char* ws; int l; const LAS float* rl;
    static constexpr int NTAB = 3;
    DI const char* tab(int k, const pg8::Unit& u) const {
        const char* t0 = (const char*)(kargs()->in.b_in + (size_t)l * DIN + (size_t)u.pn * 256 + (u.pn >= 4 ? 16 : 0));
        const char* t1 = (const char*)((const float*)(ws + WS_CSIN) + (size_t)l * NPROJ + (size_t)u.pn * 256);
        const char* t2 = (const char*)((const float*)(ws + WS_HS) + (size_t)u.pm * 256);
        return k == 0 ? t0 : (k == 1 ? t1 : t2); }
    DI void operator()(const i32x4 (&acc)[2][2][4][2], const pg8::Unit& u, int wr, int wc, int fr, int fq, const LAS unsigned char* et) const {
        const KArgP ka = kargs();
        const LAS float* bias = (const LAS float*)et;
        const LAS float* csp = (const LAS float*)(et + 1024) + 32 * wc + 4 * fq;
        const LAS float* hs = (const LAS float*)(et + 2048);
        f32x4 cs[2][2];
#pragma unroll
        for (int bj = 0; bj < 2; ++bj)
#pragma unroll
            for (int n = 0; n < 2; ++n) cs[bj][n] = *(const LAS f32x4*)(csp + 128 * bj + 16 * n);
        const int hh = u.pn * 4 + wc;
        const int lcol0 = hh * 64 + 8 * fq, ocol0 = lcol0 + (lcol0 >= 1024 ? 16 : 0);
        f32x4 bv[2][2];
#pragma unroll
        for (int bj = 0; bj < 2; ++bj)
#pragma unroll
            for (int n = 0; n < 2; ++n) bv[bj][n] = *(const LAS f32x4*)(bias + 64 * wc + 8 * fq + 32 * bj + 4 * n);
        const bool latent = u.pm >= 16;
        int op; bf16* base; int pitch, colb; bool kv = false;
        if (hh < 24) { const int ty = hh >> 2; op = (ty == 1) ? 1 : (ty == 3) ? 2 : (ty >= 4) ? 3 : 0;
            base = (bf16*)(ws + ((ty == 0) ? WS_MQ : (ty == 1) ? WS_MK : (ty == 2) ? WS_MV : (ty == 3) ? WS_MO : (ty == 4) ? WS_GU : WS_GV)); pitch = 256; colb = (hh & 3) * 64; }
        else if (hh < 32) { op = 4; base = (bf16*)(ws + WS_AQ); pitch = 512; colb = (hh - 24) * 64; }
        else { op = (hh < 34) ? 5 : 0; base = (bf16*)(ws + ((hh < 34) ? WS_AK : WS_AV)); pitch = 64; colb = 0; kv = true; }
        const int kvh = hh & 1;
        float rscs[2][4];
#pragma unroll
        for (int ai = 0; ai < 2; ++ai)
#pragma unroll
            for (int m = 0; m < 4; ++m) rscs[ai][m] = hs[ai * 128 + wr * 64 + m * 16 + fr];
        f32x4 xf[2][2][4][2];
#pragma unroll
        for (int ai = 0; ai < 2; ++ai)
#pragma unroll
            for (int m = 0; m < 4; ++m)
#pragma unroll
                for (int bj = 0; bj < 2; ++bj)
#pragma unroll
                    for (int n = 0; n < 2; ++n)
#pragma unroll
                        for (int j = 0; j < 4; ++j) xf[ai][bj][m][n][j] = (float)acc[ai][bj][m][n][j] * (rscs[ai][m] * cs[bj][n][j]) + bv[bj][n][j];
        asm volatile("" ::: "memory");
        f32x4 gn[2][2];
        if (op >= 4) { const LAS float* g = rl + 2080 + ((op == 4) ? 0 : 64);
#pragma unroll
            for (int bj = 0; bj < 2; ++bj)
#pragma unroll
                for (int n = 0; n < 2; ++n) gn[bj][n] = *(const LAS f32x4*)(g + 32 * bj + 8 * fq + 4 * n); }
#pragma unroll
        for (int ai = 0; ai < 2; ++ai)
#pragma unroll
            for (int m = 0; m < 4; ++m) {
                const int row = u.pm * 256 + ai * 128 + wr * 64 + m * 16 + fr;
                f32x4 v[2][2];
#pragma unroll
                for (int bj = 0; bj < 2; ++bj)
#pragma unroll
                    for (int n = 0; n < 2; ++n) v[bj][n] = xf[ai][bj][m][n];
                if (op == 1) {
#pragma unroll
                    for (int bj = 0; bj < 2; ++bj)
#pragma unroll
                        for (int n = 0; n < 2; ++n) v[bj][n] = v[bj][n] * 0.125f;
                } else if (op == 2) {
#pragma unroll
                    for (int bj = 0; bj < 2; ++bj)
#pragma unroll
                        for (int n = 0; n < 2; ++n)
#pragma unroll
                            for (int j = 0; j < 4; ++j) v[bj][n][j] = fast_sigmoid(v[bj][n][j]);
                } else if (op == 3) {
#pragma unroll
                    for (int bj = 0; bj < 2; ++bj)
#pragma unroll
                        for (int n = 0; n < 2; ++n)
#pragma unroll
                            for (int j = 0; j < 4; ++j) v[bj][n][j] = gelu_tanh(v[bj][n][j]);
                } else if (op >= 4) {
                    float ss = 0.f;
#pragma unroll
                    for (int bj = 0; bj < 2; ++bj)
#pragma unroll
                        for (int n = 0; n < 2; ++n) ss += (v[bj][n][0] * v[bj][n][0] + v[bj][n][1] * v[bj][n][1]) + (v[bj][n][2] * v[bj][n][2] + v[bj][n][3] * v[bj][n][3]);
                    ss = sum_x16x32(ss);
                    const float rs = __builtin_amdgcn_rsqf(ss * (1.0f / 64.0f) + EPS);
#pragma unroll
                    for (int bj = 0; bj < 2; ++bj)
#pragma unroll
                        for (int n = 0; n < 2; ++n) v[bj][n] = v[bj][n] * rs * gn[bj][n];
                    { const int t = (row - NCTX) & (T - 1); const int pos = latent ? ((fq < 2) ? (t >> 6) : (t & 63)) : 64;
                        const LAS float* rp = rl + pos * 16 + 8 * (fq & 1);
#pragma unroll
                        for (int n = 0; n < 2; ++n) { const f32x4 c = *(const LAS f32x4*)(rp + 4 * n), s = *(const LAS f32x4*)(rp + 1040 + 4 * n);
                            const f32x4 x1 = v[0][n], x2 = v[1][n]; v[0][n] = x1 * c - x2 * s; v[1][n] = x2 * c + x1 * s; } }
                    if (op == 4) {
#pragma unroll
                        for (int bj = 0; bj < 2; ++bj)
#pragma unroll
                            for (int n = 0; n < 2; ++n) v[bj][n] = v[bj][n] * C2; }
                }
                size_t drow;
                if (kv) { int b, p; if (latent) { const int r2 = row - NCTX; b = r2 >> 12; p = TC + (r2 & (T - 1)); } else { b = row >> 8; p = row & 255; }
                    drow = (size_t)((b * 2 + kvh) * TKV + p); }
                else drow = (size_t)row;
                if (op >= 4) {
                    unsigned char* dp8 = (unsigned char*)base + drow * pitch + colb + 8 * fq;
#pragma unroll
                    for (int bj = 0; bj < 2; ++bj) { u32x2 w; w.x = pk_fp8x4(v[bj][0][0], v[bj][0][1], v[bj][0][2], v[bj][0][3]); w.y = pk_fp8x4(v[bj][1][0], v[bj][1][1], v[bj][1][2], v[bj][1][3]);
                        *(u32x2*)(dp8 + 32 * bj) = w; }
                } else {
                bf16* dp = base + drow * pitch + colb + 8 * fq;
#pragma unroll
                for (int bj = 0; bj < 2; ++bj) { u32x4 w; w.x = pk2(v[bj][0][0], v[bj][0][1]); w.y = pk2(v[bj][0][2], v[bj][0][3]); w.z = pk2(v[bj][1][0], v[bj][1][1]); w.w = pk2(v[bj][1][2], v[bj][1][3]);
                    *(u32x4*)(dp + 32 * bj) = w; }
                }
                asm volatile("" ::: "memory");
            }
    }
};
struct EpiOutProj {
    unsigned char* ws; int l;
    static constexpr int NTAB = 2;
    DI const char* tab(int k, const pg8::Unit& u) const { const int mrow = u.pm < 16 ? 16 : ((u.pm - 16) >> 4);
        const char* t0 = (const char*)((const float*)(ws + WS_MOD) + (size_t)l * 17 * 6144 + (size_t)mrow * 6 * D + 2 * D + (size_t)u.pn * 256);
        const char* t1 = (const char*)((const float*)(ws + WS_CSOUT) + (size_t)l * D + (size_t)u.pn * 256);
        return k == 0 ? t0 : t1; }
    DI void operator()(const i32x4 (&acc)[2][2][4][2], const pg8::Unit& u, int wr, int wc, int fr, int fq, const LAS unsigned char* et) const {
        GAS signed char* dout = (GAS signed char*)(ws + WS_H); GAS float* dsc = (GAS float*)(ws + WS_DSC);
        const int c0 = u.pn * 256 + 64 * wc + 8 * fq;
        const LAS float* g1 = (const LAS float*)et + 64 * wc + 8 * fq;
        f32x4 gv[2][2];
#pragma unroll
        for (int bj = 0; bj < 2; ++bj)
#pragma unroll
            for (int n = 0; n < 2; ++n) gv[bj][n] = *(const LAS f32x4*)(g1 + 32 * bj + 4 * n) * *(const LAS f32x4*)((const LAS float*)(et + 1024) + 32 * wc + 4 * fq + 128 * bj + 16 * n) * (1.0f / YS);
#pragma unroll
        for (int ai = 0; ai < 2; ++ai)
#pragma unroll
            for (int m = 0; m < 4; ++m) { const size_t row = (size_t)(u.pm * 256 + ai * 128 + wr * 64 + m * 16 + fr);
                f32x4 v[2][2]; float am = 0.f;
#pragma unroll
                for (int bj = 0; bj < 2; ++bj)
#pragma unroll
                    for (int n = 0; n < 2; ++n) { v[bj][n] = gv[bj][n] * (f32x4){(float)acc[ai][bj][m][n][0], (float)acc[ai][bj][m][n][1], (float)acc[ai][bj][m][n][2], (float)acc[ai][bj][m][n][3]};
                        am = fmaxf(am, fmaxf(fmaxf(fabsf(v[bj][n][0]), fabsf(v[bj][n][1])), fmaxf(fabsf(v[bj][n][2]), fabsf(v[bj][n][3])))); }
                am = max_x16x32(am);
                const float qs = 127.0f / fmaxf(am, 1e-30f);
#pragma unroll
                for (int bj = 0; bj < 2; ++bj) { u32x2 w;
#pragma unroll
                    for (int n = 0; n < 2; ++n) { const int q0 = (int)rintf(v[bj][n][0] * qs), q1 = (int)rintf(v[bj][n][1] * qs), q2 = (int)rintf(v[bj][n][2] * qs), q3 = (int)rintf(v[bj][n][3] * qs);
                        w[n] = (unsigned)(q0 & 255) | ((unsigned)(q1 & 255) << 8) | ((unsigned)(q2 & 255) << 16) | ((unsigned)(q3 & 255) << 24); }
                    *(GAS u32x2*)(dout + row * D + c0 + 32 * bj) = w; }
                if (fq == 0) dsc[row * 16 + u.pn * 4 + wc] = am * (1.0f / 127.0f); }
    }
};
struct EpiGateUp {
    unsigned char* ws; int l;
    static constexpr int NTAB = 3;
    DI const char* tab(int k, const pg8::Unit& u) const {
        const char* t0 = (const char*)(kargs()->in.b_gate_up + ((size_t)(l * NE + u.e) * 2 * DFF + (size_t)u.pn * 256));
        const char* t1 = (const char*)((const float*)(ws + WS_CSGU) + ((size_t)(l * NE + u.e) * 2 * DFF + (size_t)u.pn * 256));
        const char* t2 = (const char*)((const float*)(ws + WS_SLS) + (size_t)u.pm * 256);
        return k == 0 ? t0 : (k == 1 ? t1 : t2); }
    DI void operator()(const i32x4 (&acc)[2][2][4][2], const pg8::Unit& u, int wr, int wc, int fr, int fq, const LAS unsigned char* et) const {
        GAS unsigned char* act = (GAS unsigned char*)(ws + WS_ACT);
        const int f0 = u.pn * 128 + 32 * wc + 8 * fq;
        const LAS float* bp = (const LAS float*)et + 2 * (32 * wc + 8 * fq);
        const LAS float* csp = (const LAS float*)(et + 1024) + 32 * wc + 4 * fq;
        const LAS float* sls = (const LAS float*)(et + 2048);
        f32x4 bb[2][2], cs[2][2];
#pragma unroll
        for (int bj = 0; bj < 2; ++bj) { bb[bj][0] = *(const LAS f32x4*)(bp + 8 * bj); bb[bj][1] = *(const LAS f32x4*)(bp + 8 * bj + 4);
            cs[bj][0] = *(const LAS f32x4*)(csp + 128 * bj); cs[bj][1] = *(const LAS f32x4*)(csp + 128 * bj + 16); }
        float rss[2][4];
#pragma unroll
        for (int ai = 0; ai < 2; ++ai)
#pragma unroll
            for (int m = 0; m < 4; ++m) rss[ai][m] = sls[ai * 128 + wr * 64 + m * 16 + fr];
        constexpr float KE = -1.702f * 1.4426950408889634f;
#pragma unroll
        for (int ai = 0; ai < 2; ++ai)
#pragma unroll
            for (int m = 0; m < 4; ++m) { const size_t srow = (size_t)(u.pm * 256 + ai * 128 + wr * 64 + m * 16 + fr); const float rs = rss[ai][m];
                f32x2 av[2][2];
#pragma unroll
                for (int bj = 0; bj < 2; ++bj)
#pragma unroll
                    for (int jp = 0; jp < 2; ++jp) {
                        const f32x2 g = {(float)acc[ai][bj][m][0][2 * jp], (float)acc[ai][bj][m][0][2 * jp + 1]}, lv = {(float)acc[ai][bj][m][1][2 * jp], (float)acc[ai][bj][m][1][2 * jp + 1]};
                        const f32x2 sg = (f32x2){cs[bj][0][2 * jp], cs[bj][0][2 * jp + 1]} * rs, sl = (f32x2){cs[bj][1][2 * jp], cs[bj][1][2 * jp + 1]} * rs;
                        const f32x2 bg = {bb[bj][jp][0], bb[bj][jp][2]}, bl = {bb[bj][jp][1], bb[bj][jp][3]};
                        const f32x2 xg = __builtin_elementwise_min(g * sg + bg, (f32x2){7.0f, 7.0f});
                        const f32x2 xl = __builtin_elementwise_min(__builtin_elementwise_max(lv * sl + bl, (f32x2){-7.0f, -7.0f}), (f32x2){7.0f, 7.0f});
                        const f32x2 z = xg * KE; f32x2 ex; ex.x = __builtin_amdgcn_exp2f(z.x); ex.y = __builtin_amdgcn_exp2f(z.y);
                        const f32x2 dn = ex + 1.0f; f32x2 sig; sig.x = __builtin_amdgcn_rcpf(dn.x); sig.y = __builtin_amdgcn_rcpf(dn.y);
                        av[bj][jp] = (xg * sig) * (xl * 4.0f + 4.0f); }
                u32x2 w; w.x = pk_fp8x4_nc(av[0][0].x, av[0][0].y, av[0][1].x, av[0][1].y); w.y = pk_fp8x4_nc(av[1][0].x, av[1][0].y, av[1][1].x, av[1][1].y);
                *(GAS u32x2*)(act + srow * DFF + f0) = w; }
    }
};
struct EpiDown {
    unsigned char* ws; int l;
    static constexpr int NTAB = 2;
    DI const char* tab(int k, const pg8::Unit& u) const {
        const char* t0 = (const char*)(kargs()->in.b_down + ((size_t)(l * NE + u.e) * D + (size_t)u.pn * 256));
        const char* t1 = (const char*)((const float*)(ws + WS_SLG) + (size_t)u.pm * 256);
        return k == 0 ? t0 : t1; }
    DI void operator()(const f32x4 (&acc)[2][2][4][2], const pg8::Unit& u, int wr, int wc, int fr, int fq, const LAS unsigned char* et) const {
        GAS signed char* mout = (GAS signed char*)(ws + WS_MOUT); GAS float* msc = (GAS float*)(ws + WS_MSC);
        const int c0 = u.pn * 256 + 64 * wc + 8 * fq;
        const LAS float* bp = (const LAS float*)et + 64 * wc + 8 * fq; const LAS float* slg = (const LAS float*)(et + 1024);
        f32x4 bv[2][2];
#pragma unroll
        for (int bj = 0; bj < 2; ++bj)
#pragma unroll
            for (int n = 0; n < 2; ++n) bv[bj][n] = *(const LAS f32x4*)(bp + 32 * bj + 4 * n);
        float gts[2][4];
#pragma unroll
        for (int ai = 0; ai < 2; ++ai)
#pragma unroll
            for (int m = 0; m < 4; ++m) gts[ai][m] = slg[ai * 128 + wr * 64 + m * 16 + fr];
#pragma unroll
        for (int ai = 0; ai < 2; ++ai)
#pragma unroll
            for (int m = 0; m < 4; ++m) { const size_t srow = (size_t)(u.pm * 256 + ai * 128 + wr * 64 + m * 16 + fr); const float gt = gts[ai][m], g256 = gt * (1.0f / 256.0f);
                f32x4 v[2][2]; float am = 0.f;
#pragma unroll
                for (int bj = 0; bj < 2; ++bj)
#pragma unroll
                    for (int n = 0; n < 2; ++n) { v[bj][n] = acc[ai][bj][m][n] * g256 + bv[bj][n] * gt;
                        am = fmaxf(am, fmaxf(fmaxf(fabsf(v[bj][n][0]), fabsf(v[bj][n][1])), fmaxf(fabsf(v[bj][n][2]), fabsf(v[bj][n][3])))); }
                am = max_x16x32(am);
                const float qs = 127.0f / fmaxf(am, 1e-30f);
#pragma unroll
                for (int bj = 0; bj < 2; ++bj) { u32x2 w;
#pragma unroll
                    for (int n = 0; n < 2; ++n) { const int q0 = (int)rintf(v[bj][n][0] * qs), q1 = (int)rintf(v[bj][n][1] * qs), q2 = (int)rintf(v[bj][n][2] * qs), q3 = (int)rintf(v[bj][n][3] * qs);
                        w[n] = (unsigned)(q0 & 255) | ((unsigned)(q1 & 255) << 8) | ((unsigned)(q2 & 255) << 16) | ((unsigned)(q3 & 255) << 24); }
                    *(GAS u32x2*)(mout + srow * D + c0 + 32 * bj) = w; }
                if (fq == 0) msc[srow * 16 + u.pn * 4 + wc] = am * (1.0f / 127.0f); }
    }
};

struct NormArgs {
    const float* xin; const float* x0; const float* ctx0;
    const bf16* delta; const float* dsc;
    const bf16* mout; const float* msc; const int* toks; const float* g2mod;
    const float* mod; int shi, sci;
    float* xout; bf16* hout; signed char* h8; float* hs;
    const bf16* wsm; const float* sbias;
    float* mg;
    int* toke; float* tokg; int* ghist; int* bhist;
    const float* fnorm; float* out;
    int gs;
};
template <int MODE>
DI void norm_phase(LAS unsigned char* lds, const NormArgs& a) {
    constexpr int NS = (MODE == 0) ? 16 : 32, NBK = NS / 16, TP = 2064, RP = 36;
    const int tid = opaque_tid(), wid = __builtin_amdgcn_readfirstlane(tid >> 6), lane = tid & 63, fr = lane & 15, fq = lane >> 4;
    const GAS float* gxin = (const GAS float*)a.xin; const GAS float* gx0 = (const GAS float*)a.x0; const GAS float* gctx0 = (const GAS float*)a.ctx0; const GAS bf16* gdelta = (const GAS bf16*)a.delta;
    const GAS float* gdsc = (const GAS float*)a.dsc; const GAS float* gmsc = (const GAS float*)a.msc; const GAS bf16* gmout = (const GAS bf16*)a.mout; const GAS int* gtoks = (const GAS int*)a.toks; const GAS float* gg2mod = (const GAS float*)a.g2mod; const GAS float* gmod = (const GAS float*)a.mod;
    GAS float* gxout = (GAS float*)a.xout; GAS signed char* gh8 = (GAS signed char*)a.h8; GAS float* ghs = (GAS float*)a.hs; const GAS float* gfnorm = (const GAS float*)a.fnorm; GAS float* gout = (GAS float*)a.out;
    LAS unsigned char* Thi = lds; LAS unsigned char* Tlo = lds + 16 * TP;
    LAS float* red = (LAS float*)(lds + 2 * 16 * TP);
    LAS int* hist = (LAS int*)(lds + 2 * 16 * TP + 8 * 16 * RP * 4);
    const int G = gridDim.x, bid = opaque_bid(), per = (NGRP - a.gs + G - 1) / G, g0 = a.gs + bid * per, g1 = (g0 + per < NGRP) ? g0 + per : NGRP;
    bf16x8 Bh[4][NBK], Bl[4][NBK];
    if (MODE == 1) {
#pragma unroll
        for (int s = 0; s < 4; ++s)
#pragma unroll
            for (int nb = 0; nb < NBK; ++nb) { const size_t o = (size_t)(nb * 16 + fr) * D + 128 * wid + 32 * s + 8 * fq;
                Bh[s][nb] = *(const bf16x8*)(a.wsm + o); Bl[s][nb] = *(const bf16x8*)(a.wsm + (size_t)NS * D + o); }
    }
    int blk = 0;
    if (MODE == 1) { if (tid < 32) hist[tid] = 0; }
    f32x4 xv[2][4]; unsigned dv[2][4]; float ds[2][2]; i32x4 tk[2];
#define NCOL(j) (512 * ((j) >> 1) + 8 * lane + 4 * ((j) & 1))
#define NORM_LOAD(gg) do { _Pragma("unroll") for (int rr = 0; rr < 2; ++rr) { const int row_ = 16 * (gg) + 2 * wid + rr; \
        if (a.xin) { const GAS bf16* xr_ = uni((const GAS bf16*)gxin + (size_t)row_ * D); _Pragma("unroll") for (int h_ = 0; h_ < 2; ++h_) { const u32x4 xb_ = *(const GAS u32x4*)(xr_ + 512 * h_ + 8 * lane); \
            xv[rr][2 * h_] = (f32x4){bflo(xb_.x), bfhi(xb_.x), bflo(xb_.y), bfhi(xb_.y)}; xv[rr][2 * h_ + 1] = (f32x4){bflo(xb_.z), bfhi(xb_.z), bflo(xb_.w), bfhi(xb_.w)}; } } \
        else { const GAS float* xp_ = uni(row_ < NCTX ? gctx0 + (size_t)row_ * D : gx0 + (size_t)(row_ - NCTX) * D); \
            _Pragma("unroll") for (int j = 0; j < 4; ++j) xv[rr][j] = *(const GAS f32x4*)(xp_ + NCOL(j)); } \
        if (a.delta) { const GAS signed char* dr_ = uni((const GAS signed char*)gdelta + (size_t)row_ * D); const GAS float* sr_ = uni(gdsc + (size_t)row_ * 16); _Pragma("unroll") for (int h_ = 0; h_ < 2; ++h_) { const u32x2 d_ = *(const GAS u32x2*)(dr_ + 512 * h_ + 8 * lane); \
            dv[rr][2 * h_] = d_.x; dv[rr][2 * h_ + 1] = d_.y; ds[rr][h_] = sr_[8 * h_ + (lane >> 3)]; } } } } while (0)
    unsigned mo[2][4][4]; float ms[2][4][2];
#define TK_LOAD(gg) do { _Pragma("unroll") for (int rr = 0; rr < 2; ++rr) tk[rr] = *(const GAS i32x4*)(uni(gtoks + (size_t)(16 * (gg) + 2 * wid + rr) * 4)); } while (0)
#define MOE_LOAD() do { _Pragma("unroll") for (int rr = 0; rr < 2; ++rr) { const int sl_[4] = {__builtin_amdgcn_readfirstlane(tk[rr][0]), __builtin_amdgcn_readfirstlane(tk[rr][1]), __builtin_amdgcn_readfirstlane(tk[rr][2]), __builtin_amdgcn_readfirstlane(tk[rr][3])}; \
        _Pragma("unroll") for (int k = 0; k < 4; ++k) { const GAS signed char* mr_ = (const GAS signed char*)gmout + (size_t)sl_[k] * D; const GAS float* cr_ = gmsc + (size_t)sl_[k] * 16; \
          _Pragma("unroll") for (int h_ = 0; h_ < 2; ++h_) { const u32x2 m_ = *(const GAS u32x2*)(mr_ + 512 * h_ + 8 * lane); \
            mo[rr][k][2 * h_] = m_.x; mo[rr][k][2 * h_ + 1] = m_.y; ms[rr][k][h_] = cr_[8 * h_ + (lane >> 3)]; } } } } while (0)
    if (g0 < g1) { NORM_LOAD(g0); if (a.mout) { TK_LOAD(g0); MOE_LOAD(); if (g0 + 1 < g1) TK_LOAD(g0 + 1); } }
    for (int g = g0; g < g1; ++g) {
        f32x4 v[2][4];
#pragma unroll
        for (int rr = 0; rr < 2; ++rr) {
#pragma unroll
            for (int j = 0; j < 4; ++j) { v[rr][j] = xv[rr][j];
                if (a.delta) { const int w = (int)dv[rr][j]; const float sc = ds[rr][j >> 1];
                    v[rr][j][0] += (float)((int)((unsigned)w << 24) >> 24) * sc; v[rr][j][1] += (float)((int)((unsigned)w << 16) >> 24) * sc; v[rr][j][2] += (float)((int)((unsigned)w << 8) >> 24) * sc; v[rr][j][3] += (float)(w >> 24) * sc; } }
        }
        if (a.mout) {
#pragma unroll
            for (int rr = 0; rr < 2; ++rr) { const int row = 16 * g + 2 * wid + rr; const GAS float* g2 = gg2mod + (size_t)mod_row(row) * 6 * D + 5 * D;
#pragma unroll
                for (int j = 0; j < 4; ++j) { const f32x4 gg = *(const GAS f32x4*)(g2 + NCOL(j));
                    f32x4 sm = (f32x4){0.f, 0.f, 0.f, 0.f};
#pragma unroll
                    for (int k = 0; k < 4; ++k) { const int w = (int)mo[rr][k][j]; const float sc = ms[rr][k][j >> 1];
                        sm[0] += (float)((int)((unsigned)w << 24) >> 24) * sc; sm[1] += (float)((int)((unsigned)w << 16) >> 24) * sc; sm[2] += (float)((int)((unsigned)w << 8) >> 24) * sc; sm[3] += (float)(w >> 24) * sc; }
                    v[rr][j] = v[rr][j] + gg * sm; } }
        }
        if (g + 1 < g1) { NORM_LOAD(g + 1); if (a.mout) { MOE_LOAD(); if (g + 2 < g1) TK_LOAD(g + 2); } }
#pragma unroll
        for (int rr = 0; rr < 2; ++rr) {
            const int r = 2 * wid + rr, row = 16 * g + r;
            const int mrow = mod_row(row);
            if (MODE == 0) {
#pragma unroll
                for (int h_ = 0; h_ < 2; ++h_) { u32x4 xb; xb.x = pk2(v[rr][2 * h_][0], v[rr][2 * h_][1]); xb.y = pk2(v[rr][2 * h_][2], v[rr][2 * h_][3]); xb.z = pk2(v[rr][2 * h_ + 1][0], v[rr][2 * h_ + 1][1]); xb.w = pk2(v[rr][2 * h_ + 1][2], v[rr][2 * h_ + 1][3]);
                    *(GAS u32x4*)((GAS bf16*)gxout + (size_t)row * D + 512 * h_ + 8 * lane) = xb;
                    v[rr][2 * h_] = (f32x4){bflo(xb.x), bfhi(xb.x), bflo(xb.y), bfhi(xb.y)}; v[rr][2 * h_ + 1] = (f32x4){bflo(xb.z), bfhi(xb.z), bflo(xb.w), bfhi(xb.w)}; }
            }
            float ss = 0.f;
#pragma unroll
            for (int j = 0; j < 4; ++j) ss += (v[rr][j][0] * v[rr][j][0] + v[rr][j][1] * v[rr][j][1]) + (v[rr][j][2] * v[rr][j][2] + v[rr][j][3] * v[rr][j][3]);
            const float rstd = 1.0f / sqrtf(wave_sum(ss) * (1.0f / D) + EPS);
            if (MODE == 2) {
                if (row >= NCTX) {
#pragma unroll
                    for (int j = 0; j < 4; ++j) { const int c = NCOL(j); const f32x4 fn = *(const GAS f32x4*)(gfnorm + c); *(GAS f32x4*)(gout + (size_t)(row - NCTX) * D + c) = v[rr][j] * rstd * fn; }
                }
            } else {
                const GAS float* shp = gmod + (size_t)mrow * 6 * D + a.shi * D; const GAS float* scp = gmod + (size_t)mrow * 6 * D + a.sci * D;
                f32x4 h[4]; float am = 0.f;
#pragma unroll
                for (int j = 0; j < 4; ++j) { const int c = NCOL(j); const f32x4 sh = *(const GAS f32x4*)(shp + c), sc = *(const GAS f32x4*)(scp + c);
                    h[j] = v[rr][j] * rstd * (sc + 1.0f) + sh;
                    u32x2 hi; hi.x = pk2(h[j][0], h[j][1]); hi.y = pk2(h[j][2], h[j][3]);
                    u32x2 lo; lo.x = pk2(h[j][0] - bflo(hi.x), h[j][1] - bfhi(hi.x)); lo.y = pk2(h[j][2] - bflo(hi.y), h[j][3] - bfhi(hi.y));
                    am = fmaxf(am, fmaxf(fmaxf(fabsf(h[j][0]), fabsf(h[j][1])), fmaxf(fabsf(h[j][2]), fabsf(h[j][3]))));
                    *(LAS u32x2*)(Thi + r * TP + c * 2) = hi; *(LAS u32x2*)(Tlo + r * TP + c * 2) = lo; }
                {
                    am = wave_max(am);
                    am = fmaxf(am, 1e-20f); const float qs = 127.0f / am;
#pragma unroll
                    for (int h_ = 0; h_ < 2; ++h_) { u32x2 qw;
#pragma unroll
                        for (int q_ = 0; q_ < 2; ++q_) { const int j = 2 * h_ + q_; const int q0 = (int)rintf(h[j][0] * qs), q1 = (int)rintf(h[j][1] * qs), q2 = (int)rintf(h[j][2] * qs), q3 = (int)rintf(h[j][3] * qs);
                            qw[q_] = (unsigned)(q0 & 255) | ((unsigned)(q1 & 255) << 8) | ((unsigned)(q2 & 255) << 16) | ((unsigned)(q3 & 255) << 24); }
                        *(GAS u32x2*)(gh8 + (size_t)row * D + 512 * h_ + 8 * lane) = qw; }
                    if (lane == 0) ghs[row] = am * (1.0f / 127.0f);
                }
            }
        }
        if (MODE == 2) continue;
        if (MODE == 0) {
#pragma unroll
            for (int s = 0; s < 4; ++s)
#pragma unroll
                for (int nb = 0; nb < NBK; ++nb) { const size_t o = (size_t)(nb * 16 + fr) * D + 128 * wid + 32 * s + 8 * fq;
                    Bh[s][nb] = *(const bf16x8*)(a.wsm + o); Bl[s][nb] = *(const bf16x8*)(a.wsm + (size_t)NS * D + o); }
        }
        __syncthreads();
        f32x4 pacc[NBK];
#pragma unroll
        for (int nb = 0; nb < NBK; ++nb) pacc[nb] = (f32x4){0.f, 0.f, 0.f, 0.f};
#pragma unroll
        for (int s = 0; s < 4; ++s) { const int ko = (128 * wid + 32 * s + 8 * fq) * 2;
            const bf16x8 ah = *(const LAS bf16x8*)(Thi + fr * TP + ko), al = *(const LAS bf16x8*)(Tlo + fr * TP + ko);
#pragma unroll
            for (int nb = 0; nb < NBK; ++nb) { pacc[nb] = __builtin_amdgcn_mfma_f32_16x16x32_bf16(ah, Bh[s][nb], pacc[nb], 0, 0, 0);
                pacc[nb] = __builtin_amdgcn_mfma_f32_16x16x32_bf16(ah, Bl[s][nb], pacc[nb], 0, 0, 0); pacc[nb] = __builtin_amdgcn_mfma_f32_16x16x32_bf16(al, Bh[s][nb], pacc[nb], 0, 0, 0); } }
#pragma unroll
        for (int nb = 0; nb < NBK; ++nb)
#pragma unroll
            for (int i = 0; i < 4; ++i) red[(wid * 16 + 4 * fq + i) * RP + nb * 16 + fr] = pacc[nb][i];
        __syncthreads();
        if (tid < 16 * NS) {
            const int rw = tid / NS, n = tid % NS;
            float val = a.sbias[n];
#pragma unroll
            for (int w = 0; w < 8; ++w) val += red[(w * 16 + rw) * RP + n];
            const int row = 16 * g + rw;
            if (MODE == 0) {
                if ((n >> 2) & 1) val = log_sigmoid(val);
                a.mg[(size_t)row * 16 + n] = val;
            } else {
                float vv = val; int ei[4]; float tv[4];
#pragma unroll
                for (int it = 0; it < 4; ++it) { float bvv = vv; int bi = n;
                    {
#define TOPSTEP(CTRL) { const float ov = dpp_f<CTRL>(bvv); const int oi = dpp_i<CTRL>(bi); if (ov > bvv || (ov == bvv && oi < bi)) { bvv = ov; bi = oi; } }
                        TOPSTEP(0xB1) TOPSTEP(0x4E) TOPSTEP(0x141) TOPSTEP(0x140)
#undef TOPSTEP
                        const auto rv = __builtin_amdgcn_permlane16_swap(__float_as_uint(bvv), __float_as_uint(bvv), false, false); const auto ri = __builtin_amdgcn_permlane16_swap((unsigned)bi, (unsigned)bi, false, false);
                        const float v0 = __uint_as_float(rv[0]), v1 = __uint_as_float(rv[1]); const int i0 = (int)ri[0], i1 = (int)ri[1];
                        if (v0 > v1 || (v0 == v1 && i0 < i1)) { bvv = v0; bi = i0; } else { bvv = v1; bi = i1; } }
                    ei[it] = bi; tv[it] = bvv; if (n == bi) vv = -INFINITY; }
                if (n == 0) {
                    const float e1 = __expf(tv[1] - tv[0]), e2 = __expf(tv[2] - tv[0]), e3 = __expf(tv[3] - tv[0]); const float inv = 1.0f / (1.0f + e1 + e2 + e3);
                    *(int4*)(a.toke + (size_t)row * 4) = make_int4(ei[0], ei[1], ei[2], ei[3]);
                    *(float4*)(a.tokg + (size_t)row * 4) = make_float4(inv, e1 * inv, e2 * inv, e3 * inv);
                    atomicAdd((int*)&hist[ei[0]], 1); atomicAdd((int*)&hist[ei[1]], 1); atomicAdd((int*)&hist[ei[2]], 1); atomicAdd((int*)&hist[ei[3]], 1);
                }
            }
        }
        if (MODE == 1) { __syncthreads(); if (tid < 32) { const int h = hist[tid]; a.ghist[(size_t)g * 32 + tid] = h; blk += h; hist[tid] = 0; } }
    }
    if (MODE == 1) { if (tid < 32) a.bhist[(size_t)bid * 32 + tid] = blk; }
    __syncthreads();
}

#undef NORM_LOAD
#undef NCOL
#undef TK_LOAD
#undef MOE_LOAD
struct ScatterArgs { const int* toke; const float* tokg; const int* ghist; const int* bhist; int* toks; int* sltok; float* slg; int* rte; const float* hs; float* sls; int gs; unsigned char* rteb; };
DI void scatter_phase(LAS unsigned char* lds, const ScatterArgs& a) {
    const int tid = opaque_tid(), wid = __builtin_amdgcn_readfirstlane(tid >> 6), lane = tid & 63;
    LAS int* ptot = (LAS int*)lds; LAS int* ppre = ptot + 512; LAS int* stt = ppre + 512; LAS int* tot = stt + 32; LAS int* pre = tot + 32; LAS int* padv = pre + 32;
    const int G = gridDim.x, B = opaque_bid(), per = (NGRP - a.gs + G - 1) / G, g0 = a.gs + B * per, g1 = (g0 + per < NGRP) ? g0 + per : NGRP;
    { const int e = tid & 31, seg = tid >> 5; int t = 0, p = 0;
      for (int b = seg; b < G; b += 16) { const int h = a.bhist[(size_t)b * 32 + e]; t += h; if (b < B) p += h; }
      ptot[seg * 32 + e] = t; ppre[seg * 32 + e] = p; }
    __syncthreads();
    if (tid < 32) { int t = 0, p = 0;
#pragma unroll
        for (int s = 0; s < 16; ++s) { t += ptot[s * 32 + tid]; p += ppre[s * 32 + tid]; }
        const int pd = (t + 255) & ~255; int sc = pd;
#pragma unroll
        for (int o = 1; o < 32; o <<= 1) { const int x = __shfl_up(sc, o); if (tid >= o) sc += x; }
        stt[tid] = sc - pd; tot[tid] = t; pre[tid] = p; padv[tid] = pd;
        if (B == 0 && tid == 31) a.rte[0] = sc >> 8; }
    __syncthreads();
    if (B == 0) {
        for (int e = 0; e < 32; ++e) { const int s0 = stt[e], t = tot[e], pd = padv[e];
            for (int s = t + tid; s < pd; s += 512) { a.sltok[s0 + s] = 0; a.slg[s0 + s] = 0.f; a.sls[s0 + s] = 0.f; }
            for (int rt = (s0 >> 8) + tid; rt < ((s0 + pd) >> 8); rt += 512) { a.rte[32 + rt] = e; a.rteb[rt] = (unsigned char)e; } }
    }
    for (int g = g0 + wid; g < g1; g += 8) {
        int base = 0;
        if (lane < 32) { base = stt[lane] + pre[lane]; for (int gg = g0; gg < g; ++gg) base += a.ghist[(size_t)gg * 32 + lane]; }
        const int ti = lane >> 2, tok = 16 * g + ti;
        const int e = a.toke[(size_t)tok * 4 + (lane & 3)]; const float gt = a.tokg[(size_t)tok * 4 + (lane & 3)];
        const unsigned long long below = (ti == 0) ? 0ull : ((1ull << (4 * ti)) - 1ull);
        int rank = 0;
        for (int ee = 0; ee < 32; ++ee) { const unsigned long long m = __ballot(e == ee); if (e == ee) rank = __popcll(m & below); }
        const int slot = __shfl(base, e) + rank;
        a.sltok[slot] = tok; a.slg[slot] = gt; a.sls[slot] = a.hs[tok]; a.toks[(size_t)tok * 4 + (lane & 3)] = slot;
    }
    __syncthreads();
}

namespace attn_body {
using f32x16 = __attribute__((ext_vector_type(16))) float;
using s16x4 = __attribute__((ext_vector_type(4))) short;
constexpr int NW = 8, QBLK = 32, KVBLK = 64;
constexpr int QP = 512, KP = 64, OP = 1024;
DI int crow(int r, int hi) { return (r & 3) + 8 * (r >> 2) + 4 * hi; }
#define SBAR() __builtin_amdgcn_sched_barrier(0)
constexpr int NSLOT = 3, SLOTB = 8192;
constexpr int LDS_K = 0, LDS_V = NSLOT * SLOTB, LDS_WS = 2 * NSLOT * SLOTB, LDS_OST = LDS_WS + NW * 64 * 4, ATT_LDS_BYTES = LDS_OST + NW * 4096;
DI void glds16(const void* gsrc, unsigned lds_dst) { unsigned keep;
    asm volatile("s_mov_b32 %0, m0\n\ts_mov_b32 m0, %2\n\ts_nop 0\n\tglobal_load_lds_dwordx4 %1, off\n\ts_mov_b32 m0, %0" : "=&s"(keep) : "v"(gsrc), "s"(lds_dst) : "memory"); }
DI float max3f(float a, float b, float c) { float r; asm("v_max3_f32 %0, %1, %2, %3" : "=v"(r) : "v"(a), "v"(b), "v"(c)); return r; }
DI float max2f(float a, float b) { float r; asm("v_max_f32_e32 %0, %1, %2" : "=v"(r) : "v"(a), "v"(b)); return r; }
DI float fadd_s(float a, float b) { float r; asm("v_add_f32_e32 %0, %1, %2" : "=v"(r) : "v"(a), "v"(b)); return r; }
DI float fsub_s(float a, float b) { float r; asm("v_sub_f32_e32 %0, %1, %2" : "=v"(r) : "v"(a), "v"(b)); return r; }
DI unsigned cvtpk_s(float lo, float hi) { return pk2(lo, hi); }
#define WAIT_BAR(N) asm volatile("s_waitcnt vmcnt(" #N ") lgkmcnt(0)\n\ts_barrier" ::: "memory")
typedef LAS const char* lds_cptr;
typedef short v4i16_t __attribute__((ext_vector_type(4)));
typedef int i32x8 __attribute__((ext_vector_type(8)));
DI i32x8 cat8i(i32x4 x0, i32x4 x1) { return __builtin_shufflevector(x0, x1, 0, 1, 2, 3, 4, 5, 6, 7); }
DI i32x8 kload1(lds_cptr kp, int kh) { return cat8i(*(const LAS i32x4*)(kp + kh * 512), *(const LAS i32x4*)(kp + 1024 + kh * 512)); }
DI f32x16 mfq(i32x8 a, i32x8 b, f32x16 c) { return __builtin_amdgcn_mfma_scale_f32_32x32x64_f8f6f4(a, b, c, 0, 0, 0, 0, 0, 0); }
DI s16x4 vtr(lds_cptr p) { return __builtin_bit_cast(s16x4, __builtin_amdgcn_ds_read_tr16_b64_v4i16((LAS v4i16_t*)p)); }
DI float rowmax(const f32x16& p0, const f32x16& p1) {
    float a = max3f(p0[0], p0[1], p1[0]), b = max3f(p0[2], p0[3], p1[1]); a = max3f(a, p1[2], p1[3]);
#pragma unroll
    for (int r = 4; r < 16; r += 4) { a = max3f(a, p0[r], p0[r + 1]); b = max3f(b, p0[r + 2], p0[r + 3]); a = max3f(a, p1[r], p1[r + 1]); b = max3f(b, p1[r + 2], p1[r + 3]); }
    const float m = max2f(a, b);
    auto rr = __builtin_amdgcn_permlane32_swap(__float_as_uint(m), __float_as_uint(m), false, false);
    return max2f(__uint_as_float(rr[0]), __uint_as_float(rr[1]));
}
DI void pv(f32x16* o, int vb, bf16x8 pa0, bf16x8 pa1, bf16x8 pa2, bf16x8 pa3) {
#pragma unroll
    for (int d0 = 0; d0 < 2; ++d0) { s16x4 lo[4], hi[4];
#pragma unroll
        for (int ks = 0; ks < 4; ++ks) {
            asm volatile("ds_read_b64_tr_b16 %0,%1 offset:%c2" : "=&v"(lo[ks]) : "v"(vb), "i"(d0 * 4096 + ks * 1024) : "memory");
            asm volatile("ds_read_b64_tr_b16 %0,%1 offset:%c2" : "=&v"(hi[ks]) : "v"(vb), "i"(d0 * 4096 + ks * 1024 + 512) : "memory"); }
        asm volatile("s_waitcnt lgkmcnt(0)" ::: "memory"); SBAR();
#define PK(k) (bf16x8){lo[k][0], lo[k][1], lo[k][2], lo[k][3], hi[k][0], hi[k][1], hi[k][2], hi[k][3]}
        o[d0] = __builtin_amdgcn_mfma_f32_32x32x16_bf16(pa0, PK(0), o[d0], 0, 0, 0);
        o[d0] = __builtin_amdgcn_mfma_f32_32x32x16_bf16(pa1, PK(1), o[d0], 0, 0, 0);
        o[d0] = __builtin_amdgcn_mfma_f32_32x32x16_bf16(pa2, PK(2), o[d0], 0, 0, 0);
        o[d0] = __builtin_amdgcn_mfma_f32_32x32x16_bf16(pa3, PK(3), o[d0], 0, 0, 0);
#undef PK
    }
}
template <int THRL, bool NOMAX> DI void attn_unit(const unsigned char* Qu, const unsigned char* __restrict__ Kh, const bf16* __restrict__ Vh, const int NT, unsigned char* Ou, const float* gain, char* shm) {
    const int tid = opaque_tid(), lane = tid & 63, r32 = lane & 31, hi = lane >> 5; const int wid = __builtin_amdgcn_readfirstlane(tid >> 6);
    const unsigned char* Qw = Qu + (long)(wid * QBLK) * QP;
    const unsigned lds0 = (unsigned)(uintptr_t)shm;
    float* wsf = (float*)(shm + LDS_WS) + wid * 64;
    const unsigned char* ksrc = Kh + (long)lane * KP + (wid & 3) * 16;
    const bf16* vsrc = Vh + (long)(16 * (wid & 3) + (lane >> 2)) * KP + (wid >> 2) * 32 + (lane & 3) * 8;
    const unsigned kdst = lds0 + LDS_K + (wid & 3) * 1024, vdst = lds0 + LDS_V + wid * 1024;
#define DMA_K(t, slot) glds16(ksrc + (long)(t) * KVBLK * KP, (unsigned)__builtin_amdgcn_readfirstlane(kdst + (slot)))
#define DMA_V(t, slot) glds16(vsrc + (long)(t) * KVBLK * KP, (unsigned)__builtin_amdgcn_readfirstlane(vdst + (slot)))
    const int vb0 = (int)(lds0 + LDS_V) + ((lane >> 4) & 1) * 32 + (lane & 3) * 8 + (4 * hi + ((lane & 15) >> 2)) * 64;
    i32x8 kf[2];
    const lds_cptr shm3 = (lds_cptr)shm; const lds_cptr kp0 = shm3 + LDS_K + hi * 2048 + r32 * 16; const lds_cptr vp0 = shm3 + LDS_V + ((lane >> 4) & 1) * 32 + (lane & 3) * 8 + (4 * hi + ((lane & 15) >> 2)) * 64;
    DMA_K(0, 0); DMA_V(0, 0); DMA_K(1, SLOTB);
    const i32x8 qr = cat8i(*reinterpret_cast<const i32x4*>(Qw + (long)r32 * QP + hi * 32), *reinterpret_cast<const i32x4*>(Qw + (long)r32 * QP + hi * 32 + 16));
    float mhat = 0.f, l_reg = 0.f; f32x16 o[2]; o[0] = f32x16{}; o[1] = f32x16{}; f32x16 negm = f32x16{}; asm volatile("" : "+v"(negm));
    bool resc = false;
#define START(P0, P1) do { resc = false; \
    if constexpr (!NOMAX) { const float rm = rowmax(P0, P1); const float dl = rm; mhat = fadd_s(mhat, dl); \
      _Pragma("unroll") for (int r = 0; r < 16; ++r) { P0[r] = fsub_s(P0[r], dl); P1[r] = fsub_s(P1[r], dl); } \
      _Pragma("unroll") for (int r = 0; r < 16; ++r) negm[r] = -mhat; asm volatile("" : "+v"(negm)); } \
    _Pragma("unroll") for (int r = 0; r < 16; ++r) P0[r] = __builtin_amdgcn_exp2f(P0[r]); } while (0)
#define RESC() do { if (resc) { asm volatile("s_waitcnt lgkmcnt(0)" ::: "memory"); \
      _Pragma("unroll") for (int d_ = 0; d_ < 2; ++d_) _Pragma("unroll") for (int r = 0; r < 16; ++r) o[d_][r] *= wsf[crow(r, hi)]; } } while (0)
    f32x16 pA0, pA1, pB0, pB1;
    int sl_prev = 0, sl_cur = 0, sl_next = SLOTB;
#define ROT() do { sl_prev = sl_cur; sl_cur = sl_next; sl_next = (sl_next == (NSLOT - 1) * SLOTB) ? 0 : sl_next + SLOTB; } while (0)
    DMA_K(2, 2 * SLOTB);
    WAIT_BAR(3);
    pA0 = mfq(kload1(kp0, 0), qr, negm); pA1 = mfq(kload1(kp0, 1), qr, negm);
    if constexpr (!NOMAX) asm volatile("s_nop 15\n\ts_nop 15" : "+v"(pA0), "+v"(pA1));
    START(pA0, pA1);
    _Pragma("unroll") for (int r = 0; r < 16; ++r) pA1[r] = __builtin_amdgcn_exp2f(pA1[r]);
    WAIT_BAR(0);
    DMA_K(3, 0); DMA_V(1, SLOTB);
    ROT();
    kf[0] = kload1(kp0 + sl_cur, 0); kf[1] = kload1(kp0 + sl_cur, 1);
    WAIT_BAR(2);
    s16x4 vlo[8], vhi[8]; u32x4 pw0, pw1, pw2, pw3;
#define PKW(P, B) cvtpk_s(P[B], P[B + 1])
#define PAF(k) __builtin_bit_cast(bf16x8, pw##k)
#define VFR(i) (bf16x8){vlo[i][0], vlo[i][1], vlo[i][2], vlo[i][3], vhi[i][0], vhi[i][1], vhi[i][2], vhi[i][3]}
#define PIN(x) asm volatile("" : "+v"(x))
#define MX3(a, b, c) __builtin_fmaxf(__builtin_fmaxf((a), (b)), (c))
#define GAPA(MF, A0, A1, A2, A3, W0, W1, PW) do { MF; sacc += A0; sacc += A1; sacc += A2; sacc += A3; PIN(sacc); W0; W1; PIN(PW); SBAR(); } while (0)
#define EX(v) __builtin_amdgcn_exp2f(v)
#define GAPB(MF, X, B) do { MF; X[B] = EX(X[B]); X[B + 1] = EX(X[B + 1]); X[B + 2] = EX(X[B + 2]); X[B + 3] = EX(X[B + 3]); PIN(X); SBAR(); } while (0)
#define VRD(i) do { vlo[i] = vtr(vp_ + (((i) >> 2) * 4096 + ((i) & 3) * 1024)); vhi[i] = vtr(vp_ + (((i) >> 2) * 4096 + ((i) & 3) * 1024 + 512)); } while (0)
#define KRD(G, j) do { if (G) { kf[j] = kload1(kp0 + sl_next, j); SBAR(); } } while (0)
#define STEP(C0, C1, P0, P1, t, GK, GV, GL) do { SBAR(); \
    const lds_cptr vp_ = vp0 + sl_prev; \
    VRD(0); SBAR(); float sacc = (P0[0] + P0[1]); \
    GAPA(C0 = mfq(kf[0], qr, negm), P0[2], P0[3], P0[4], P0[5],     pw0[0] = PKW(P0, 0), pw0[1] = PKW(P0, 2), pw0); \
    VRD(4); SBAR(); GAPA((void)0, P0[6], P0[7], P0[8], P0[9],     pw0[2] = PKW(P0, 4), pw0[3] = PKW(P0, 6), pw0); \
    VRD(1); SBAR(); GAPA((void)0, P0[10], P0[11], P0[12], P0[13], pw1[0] = PKW(P0, 8), pw1[1] = PKW(P0, 10), pw1); \
    VRD(5); SBAR(); GAPA((void)0, P0[14], P0[15], P1[0], P1[1],   pw1[2] = PKW(P0, 12), pw1[3] = PKW(P0, 14), pw1); \
    VRD(2); SBAR(); GAPA(C1 = mfq(kf[1], qr, negm), P1[2], P1[3], P1[4], P1[5],     pw2[0] = PKW(P1, 0), pw2[1] = PKW(P1, 2), pw2); \
    VRD(6); SBAR(); GAPA((void)0, P1[6], P1[7], P1[8], P1[9],     pw2[2] = PKW(P1, 4), pw2[3] = PKW(P1, 6), pw2); \
    VRD(3); SBAR(); GAPA((void)0, P1[10], P1[11], P1[12], P1[13], pw3[0] = PKW(P1, 8), pw3[1] = PKW(P1, 10), pw3); \
    VRD(7); SBAR(); GAPA((void)0, P1[14], P1[15], 0.f, 0.f,       pw3[2] = PKW(P1, 12), pw3[3] = PKW(P1, 14), pw3); \
    l_reg += sacc; \
    if (GK) { DMA_K((t) + 3, sl_cur); } if (GV) { DMA_V((t) + 1, sl_next); } \
    if constexpr (!NOMAX) { float a = MX3(C0[0], C0[1], C1[0]), b = MX3(C0[2], C0[3], C1[1]); a = MX3(a, C1[2], C1[3]); \
      _Pragma("unroll") for (int r = 4; r < 16; r += 4) { a = MX3(a, C0[r], C0[r + 1]); b = MX3(b, C0[r + 2], C0[r + 3]); a = MX3(a, C1[r], C1[r + 1]); b = MX3(b, C1[r + 2], C1[r + 3]); } \
      float rm = __builtin_fmaxf(a, b); { auto rr = __builtin_amdgcn_permlane32_swap(__float_as_uint(rm), __float_as_uint(rm), false, false); rm = __builtin_fmaxf(__uint_as_float(rr[0]), __uint_as_float(rr[1])); } \
      resc = false; \
      if (__builtin_expect(__any(rm > (float)THRL), 0)) { const float dl = __builtin_fmaxf(rm, 0.f); mhat += dl; \
        _Pragma("unroll") for (int r = 0; r < 16; ++r) { C0[r] -= dl; C1[r] -= dl; } \
        _Pragma("unroll") for (int r = 0; r < 16; ++r) negm[r] = -mhat; asm volatile("" : "+v"(negm)); \
        const float f = __builtin_amdgcn_exp2f(-dl); l_reg *= f; if (hi == 0) wsf[r32] = f; resc = true; } } \
    SBAR(); \
    GAPB(o[0] = __builtin_amdgcn_mfma_f32_32x32x16_bf16(PAF(0), VFR(0), o[0], 0, 0, 0), C0, 0); \
    GAPB(o[1] = __builtin_amdgcn_mfma_f32_32x32x16_bf16(PAF(0), VFR(4), o[1], 0, 0, 0), C0, 4); \
    KRD(GL, 0); GAPB(o[0] = __builtin_amdgcn_mfma_f32_32x32x16_bf16(PAF(1), VFR(1), o[0], 0, 0, 0), C0, 8); \
    GAPB(o[1] = __builtin_amdgcn_mfma_f32_32x32x16_bf16(PAF(1), VFR(5), o[1], 0, 0, 0), C0, 12); \
    KRD(GL, 1); GAPB(o[0] = __builtin_amdgcn_mfma_f32_32x32x16_bf16(PAF(2), VFR(2), o[0], 0, 0, 0), C1, 0); \
    GAPB(o[1] = __builtin_amdgcn_mfma_f32_32x32x16_bf16(PAF(2), VFR(6), o[1], 0, 0, 0), C1, 4); \
    GAPB(o[0] = __builtin_amdgcn_mfma_f32_32x32x16_bf16(PAF(3), VFR(3), o[0], 0, 0, 0), C1, 8); \
    GAPB(o[1] = __builtin_amdgcn_mfma_f32_32x32x16_bf16(PAF(3), VFR(7), o[1], 0, 0, 0), C1, 12); \
    } while (0)
    int t = 1;
    for (; t + 5 < NT; t += 2) {
        STEP(pB0, pB1, pA0, pA1, t, true, true, true);     WAIT_BAR(2); RESC(); ROT();
        STEP(pA0, pA1, pB0, pB1, t + 1, true, true, true); WAIT_BAR(2); RESC(); ROT();
    }
#define ENDW(tt) do { if ((tt) + 3 < NT) { WAIT_BAR(2); } else if ((tt) + 2 < NT) { WAIT_BAR(1); } else { WAIT_BAR(0); } } while (0)
    for (; t + 1 < NT; t += 2) {
        STEP(pB0, pB1, pA0, pA1, t, (t + 3 < NT), (t + 1 < NT), (t + 1 < NT));         ENDW(t);     RESC(); ROT();
        STEP(pA0, pA1, pB0, pB1, t + 1, (t + 4 < NT), (t + 2 < NT), (t + 2 < NT));     ENDW(t + 1); RESC(); ROT();
    }
    STEP(pB0, pB1, pA0, pA1, NT - 1, false, false, false); RESC();
    { float sacc = pB0[0] + pB0[1]; _Pragma("unroll") for (int r = 2; r < 16; ++r) sacc += pB0[r]; _Pragma("unroll") for (int r = 0; r < 16; ++r) sacc += pB1[r]; l_reg += sacc;
      pw0 = (u32x4){PKW(pB0, 0), PKW(pB0, 2), PKW(pB0, 4), PKW(pB0, 6)}; pw1 = (u32x4){PKW(pB0, 8), PKW(pB0, 10), PKW(pB0, 12), PKW(pB0, 14)}; pw2 = (u32x4){PKW(pB1, 0), PKW(pB1, 2), PKW(pB1, 4), PKW(pB1, 6)}; pw3 = (u32x4){PKW(pB1, 8), PKW(pB1, 10), PKW(pB1, 12), PKW(pB1, 14)};
      SBAR(); pv(o, vb0 + sl_cur, PAF(0), PAF(1), PAF(2), PAF(3)); }
#undef PKW
#undef PAF
#undef VFR
#undef PIN
#undef MX3
#undef GAPA
#undef GAPB
#undef EX
#undef VRD
#undef KRD
#undef STEP
#undef ENDW
    { auto rr = __builtin_amdgcn_permlane32_swap(__float_as_uint(l_reg), __float_as_uint(l_reg), false, false); l_reg = __uint_as_float(rr[0]) + __uint_as_float(rr[1]); }
    if (hi == 0) wsf[32 + r32] = l_reg; asm volatile("s_waitcnt lgkmcnt(0)" ::: "memory");
    float rli[16];
#pragma unroll
    for (int r = 0; r < 16; ++r) rli[r] = __builtin_amdgcn_rcpf(wsf[32 + crow(r, hi)]);
    unsigned char* Ow = Ou + (long)(wid * QBLK) * OP;
    { bf16* stg = (bf16*)(shm + LDS_OST) + wid * 2048;
#pragma unroll
      for (int r = 0; r < 16; ++r) { const int orow = crow(r, hi);
#pragma unroll
          for (int d0 = 0; d0 < 2; ++d0) stg[orow * 64 + d0 * 32 + r32] = f2bf(o[d0][r] * rli[r]); }
      asm volatile("s_waitcnt lgkmcnt(0)" ::: "memory");
      const int ch = lane & 7;
#pragma unroll
      for (int i = 0; i < 4; ++i) { const int row = i * 8 + (lane >> 3); const u32x4 v = *(const u32x4*)(stg + row * 64 + ch * 8);
          float x[8] = {bflo(v.x), bfhi(v.x), bflo(v.y), bfhi(v.y), bflo(v.z), bfhi(v.z), bflo(v.w), bfhi(v.w)};
          float ss = 0.f;
#pragma unroll
          for (int k = 0; k < 8; ++k) ss += x[k] * x[k];
          ss = sum_oct(ss);
          const float rs = __builtin_amdgcn_rsqf(ss * (1.0f / 64.0f) + EPS);
          const float rq = rs * YS; u32x2 w; w.x = pk_i8x4(x[0] * rq, x[1] * rq, x[2] * rq, x[3] * rq); w.y = pk_i8x4(x[4] * rq, x[5] * rq, x[6] * rq, x[7] * rq);
          *(u32x2*)(Ow + (long)row * OP + ch * 8) = w; } }
    asm volatile("s_waitcnt lgkmcnt(0)\n\ts_barrier" ::: "memory");
#undef DMA_K
#undef DMA_V
#undef START
#undef RESC
#undef ROT
}
#undef SBAR
#undef WAIT_BAR
}

namespace mlstm {
constexpr int P2 = 144;
constexpr int TILE = 64 * P2;
constexpr int O_Q = 0, O_K = TILE, O_KT = 2 * TILE, O_VT = 3 * TILE, O_P = 4 * TILE, O_CT = 5 * TILE  , O_N = 7 * TILE  , O_SC = O_N + 512  , DIRB = O_SC + 2048;
static_assert(2 * DIRB <= SCR_BYTES, "mLSTM LDS");
struct Args { const bf16 *MQ, *MK, *MV, *MO; const float* MG; float* HFB; bf16* Y; const float* mixn; };
DI int chunk_mc(int dir, int j) { return dir == 0 ? j : (j < 4 ? 3 - j : 71 - j); }
DI int tok_row(int b, int p) { return p < TC ? b * TC + p : NCTX + b * T + (p - TC); }
DI void item(LAS unsigned char* lds, const Args& a, int b, int h) {
    const int tid = opaque_tid(), wid = __builtin_amdgcn_readfirstlane(tid >> 6), lane = tid & 63, fr = lane & 15, fq = lane >> 4;
    const int dir = wid >> 2, w4 = wid & 3;
    LAS unsigned char* L = lds + dir * DIRB;
    LAS float* sa = (LAS float*)(L + O_SC + w4 * 512); LAS float* sg = sa + 64;
    for (int i = (tid & 255); i < TILE / 4; i += 256) ((LAS unsigned*)(L + O_CT))[i] = 0u;
    if ((tid & 255) < 64) ((LAS float*)(L + O_N))[tid & 255] = 0.f;
    f32x4 Cacc[4];
#pragma unroll
    for (int c = 0; c < 4; ++c) Cacc[c] = (f32x4){0.f, 0.f, 0.f, 0.f};
    float n_reg = 0.f, m_prev = 0.f;
    const GAS bf16* gMQ = (const GAS bf16*)a.MQ; const GAS bf16* gMK = (const GAS bf16*)a.MK; const GAS bf16* gMV = (const GAS bf16*)a.MV; const GAS float* gMG = (const GAS float*)a.MG;
    GAS float* HF = (GAS float*)a.HFB + ((size_t)((b * 4 + h) * 2 + dir)) * TKV * 64;
    u32x4 qA[2], kA[2], vA[2]; float li, lf;
    const unsigned psel = (lane & 1) ? 0x07060302u : 0x01000504u; const int tb = (lane & 1) ? (P2 + 2 * (lane - 1)) : 2 * lane;
#define MLOAD(j) do { const int mc_ = chunk_mc(dir, (j)); const int p_ = 64 * mc_ + (dir == 0 ? lane : 63 - lane); const size_t row_ = (size_t)tok_row(b, p_); \
        li = gMG[row_ * 16 + dir * 8 + h]; lf = gMG[row_ * 16 + dir * 8 + 4 + h]; \
        _Pragma("unroll") for (int m_ = 0; m_ < 2; ++m_) { const int tr_ = 16 * w4 + 8 * m_ + (lane >> 3); const size_t o_ = (size_t)tok_row(b, 64 * mc_ + (dir == 0 ? tr_ : 63 - tr_)) * 256 + h * 64 + 8 * (lane & 7); \
            qA[m_] = *(const GAS u32x4*)(gMQ + o_); kA[m_] = *(const GAS u32x4*)(gMK + o_); vA[m_] = *(const GAS u32x4*)(gMV + o_); } } while (0)
    MLOAD(0);
    __syncthreads();
    for (int j = 0; j < 68; ++j) {
        const int cb = j & 1;
        const float bcs = scan_sum64(lf);
        const float av = li - bcs;
        const float pmx = scan_max64(av);
        const float gv = fmaxf(m_prev, pmx);
        const float G63 = __builtin_bit_cast(float, __builtin_amdgcn_readlane(__builtin_bit_cast(int, gv), 63)), bend = __builtin_bit_cast(float, __builtin_amdgcn_readlane(__builtin_bit_cast(int, bcs), 63));
        const float wsv = __expf(av - G63), w_prev = __expf(m_prev - G63);
        const float w_int = __expf(m_prev - gv), emt = __expf(-(bcs + gv));
#pragma unroll
        for (int m = 0; m < 2; ++m) { const int tr = 16 * w4 + 8 * m + (lane >> 3), po = tr * P2 + 16 * (lane & 7);
            *(LAS u32x4*)(L + O_Q + po) = qA[m]; *(LAS u32x4*)(L + O_K + po) = kA[m]; *(LAS u32x4*)(L + O_P + po) = vA[m]; }
        if (j + 1 < 68) MLOAD(j + 1);
        __syncthreads();
        const u32x4 k0 = *(const LAS u32x4*)(L + O_K + lane * P2 + 16 * w4), k1 = *(const LAS u32x4*)(L + O_K + lane * P2 + 16 * w4 + 64), v0 = *(const LAS u32x4*)(L + O_P + lane * P2 + 16 * w4), v1 = *(const LAS u32x4*)(L + O_P + lane * P2 + 16 * w4 + 64);
        {
            const unsigned kw[8] = {k0.x, k0.y, k0.z, k0.w, k1.x, k1.y, k1.z, k1.w}, vw[8] = {v0.x, v0.y, v0.z, v0.w, v1.x, v1.y, v1.z, v1.w};
#pragma unroll
            for (int pp = 0; pp < 2; ++pp)
#pragma unroll
                for (int i = 0; i < 4; ++i) { const int d = 8 * w4 + 32 * pp + 2 * i;
                    const unsigned kk = pk2(bflo(kw[pp * 4 + i]) * wsv, bfhi(kw[pp * 4 + i]) * wsv), vv = vw[pp * 4 + i];
                    const unsigned kn = (unsigned)dpp_i<0xB1>((int)kk), vn = (unsigned)dpp_i<0xB1>((int)vv);
                    *(LAS unsigned*)(L + O_KT + d * P2 + tb) = __builtin_amdgcn_perm(kk, kn, psel); *(LAS unsigned*)(L + O_VT + d * P2 + tb) = __builtin_amdgcn_perm(vv, vn, psel); }
        }
        sa[lane] = av; sg[lane] = gv;
        __syncthreads();
        bf16x8 qf[2];
#pragma unroll
        for (int ks = 0; ks < 2; ++ks) qf[ks] = *(const LAS bf16x8*)(L + O_Q + (16 * w4 + fr) * P2 + (32 * ks + 8 * fq) * 2);
        const int tt = 16 * w4 + fr;
        const float g_t = sg[tt];
        float rsum = 0.f;
#pragma unroll
        for (int c = 0; c < 4; ++c) {
            f32x4 s = (f32x4){0.f, 0.f, 0.f, 0.f};
#pragma unroll
            for (int ks = 0; ks < 2; ++ks) { const bf16x8 kf = *(const LAS bf16x8*)(L + O_K + (16 * c + fr) * P2 + (32 * ks + 8 * fq) * 2); s = __builtin_amdgcn_mfma_f32_16x16x32_bf16(kf, qf[ks], s, 0, 0, 0); }
            const f32x4 as4 = *(const LAS f32x4*)(sa + 16 * c + 4 * fq);
            float p[4];
#pragma unroll
            for (int i = 0; i < 4; ++i) { const int ss = 16 * c + 4 * fq + i; p[i] = (ss <= tt) ? s[i] * __expf(as4[i] - g_t) : 0.f; rsum += p[i]; }
            u32x2 pw; pw.x = pk2(p[0], p[1]); pw.y = pk2(p[2], p[3]);
            *(LAS u32x2*)(L + O_P + tt * P2 + (16 * c + 4 * fq) * 2) = pw;
        }
        rsum = sum_x16x32(rsum);
        float qn = 0.f;
        { const u32x4 qa = *(const LAS u32x4*)(L + O_Q + tt * P2 + (16 * fq) * 2), qb = *(const LAS u32x4*)(L + O_Q + tt * P2 + (16 * fq + 8) * 2);
          const LAS float* nv = (const LAS float*)(L + O_N + cb * 256) + 16 * fq;
          const f32x4 n0 = *(const LAS f32x4*)(nv), n1 = *(const LAS f32x4*)(nv + 4), n2 = *(const LAS f32x4*)(nv + 8), n3 = *(const LAS f32x4*)(nv + 12);
          qn = bflo(qa.x) * n0[0] + bfhi(qa.x) * n0[1] + bflo(qa.y) * n0[2] + bfhi(qa.y) * n0[3] + bflo(qa.z) * n1[0] + bfhi(qa.z) * n1[1] + bflo(qa.w) * n1[2] + bfhi(qa.w) * n1[3]
             + bflo(qb.x) * n2[0] + bfhi(qb.x) * n2[1] + bflo(qb.y) * n2[2] + bfhi(qb.y) * n2[3] + bflo(qb.z) * n3[0] + bfhi(qb.z) * n3[1] + bflo(qb.w) * n3[2] + bfhi(qb.w) * n3[3];
          qn = sum_x16x32(qn); }
        const float wi_t = __shfl(w_int, tt), em_t = __shfl(emt, tt);
        const float den = rsum + wi_t * qn;
        const float rden = 1.0f / fmaxf(fabsf(den), em_t);
        LDS_WAIT();
        bf16x8 pf[2];
#pragma unroll
        for (int ks = 0; ks < 2; ++ks) pf[ks] = *(const LAS bf16x8*)(L + O_P + tt * P2 + (32 * ks + 8 * fq) * 2);
        const int pos = 64 * chunk_mc(dir, j) + (dir == 0 ? tt : 63 - tt);
#pragma unroll
        for (int c = 0; c < 4; ++c) {
            f32x4 qc = (f32x4){0.f, 0.f, 0.f, 0.f}, pvv = (f32x4){0.f, 0.f, 0.f, 0.f};
#pragma unroll
            for (int ks = 0; ks < 2; ++ks) { const bf16x8 cf = *(const LAS bf16x8*)(L + O_CT + cb * TILE + (16 * c + fr) * P2 + (32 * ks + 8 * fq) * 2); qc = __builtin_amdgcn_mfma_f32_16x16x32_bf16(cf, qf[ks], qc, 0, 0, 0);
                const bf16x8 vf = *(const LAS bf16x8*)(L + O_VT + (16 * c + fr) * P2 + (32 * ks + 8 * fq) * 2); pvv = __builtin_amdgcn_mfma_f32_16x16x32_bf16(vf, pf[ks], pvv, 0, 0, 0); }
            const f32x4 hv = (pvv + qc * wi_t) * rden;
            *(GAS f32x4*)(HF + (size_t)pos * 64 + 16 * c + 4 * fq) = hv;
        }
        { bf16x8 vf[2];
#pragma unroll
          for (int ks = 0; ks < 2; ++ks) vf[ks] = *(const LAS bf16x8*)(L + O_VT + (16 * w4 + fr) * P2 + (32 * ks + 8 * fq) * 2);
#pragma unroll
          for (int c = 0; c < 4; ++c) { Cacc[c] = Cacc[c] * w_prev;
#pragma unroll
              for (int ks = 0; ks < 2; ++ks) { const bf16x8 kt = *(const LAS bf16x8*)(L + O_KT + (16 * c + fr) * P2 + (32 * ks + 8 * fq) * 2); Cacc[c] = __builtin_amdgcn_mfma_f32_16x16x32_bf16(kt, vf[ks], Cacc[c], 0, 0, 0); }
              u32x2 cw; cw.x = pk2(Cacc[c][0], Cacc[c][1]); cw.y = pk2(Cacc[c][2], Cacc[c][3]);
              *(LAS u32x2*)(L + O_CT + (cb ^ 1) * TILE + (16 * w4 + fr) * P2 + (16 * c + 4 * fq) * 2) = cw; }
          const u32x4 ka = *(const LAS u32x4*)(L + O_KT + (16 * w4 + fr) * P2 + (16 * fq) * 2), kb = *(const LAS u32x4*)(L + O_KT + (16 * w4 + fr) * P2 + (16 * fq + 8) * 2);
          float ksum = ((bflo(ka.x) + bfhi(ka.x)) + (bflo(ka.y) + bfhi(ka.y))) + ((bflo(ka.z) + bfhi(ka.z)) + (bflo(ka.w) + bfhi(ka.w)))
                     + ((bflo(kb.x) + bfhi(kb.x)) + (bflo(kb.y) + bfhi(kb.y))) + ((bflo(kb.z) + bfhi(kb.z)) + (bflo(kb.w) + bfhi(kb.w)));
          ksum = sum_x16x32(ksum);
          n_reg = w_prev * n_reg + ksum;
          if (fq == 0) ((LAS float*)(L + O_N + (cb ^ 1) * 256))[16 * w4 + fr] = n_reg; }
        m_prev = bend + G63;
        __syncthreads();
    }
#undef MLOAD
    VM_WAIT(); __threadfence_block(); __syncthreads();
    const GAS float* HF0 = (const GAS float*)a.HFB + ((size_t)((b * 4 + h) * 2)) * TKV * 64; const GAS float* HF1 = HF0 + (size_t)TKV * 64; const GAS bf16* gMO = (const GAS bf16*)a.MO; GAS unsigned char* gY = (GAS unsigned char*)a.Y;
    const int ch = tid & 7;
    for (int it0 = 0; it0 < TKV * 8 / 512; it0 += 4) {
        f32x4 a0[4], a1[4], b0[4], b1[4]; u32x4 ov[4];
#pragma unroll
        for (int u = 0; u < 4; ++u) { const int p = ((it0 + u) * 512 + tid) >> 3; const size_t row = (size_t)tok_row(b, p);
            a0[u] = *(const GAS f32x4*)(HF0 + (size_t)p * 64 + ch * 8); a1[u] = *(const GAS f32x4*)(HF0 + (size_t)p * 64 + ch * 8 + 4); b0[u] = *(const GAS f32x4*)(HF1 + (size_t)p * 64 + ch * 8); b1[u] = *(const GAS f32x4*)(HF1 + (size_t)p * 64 + ch * 8 + 4);
            ov[u] = *(const GAS u32x4*)(gMO + row * 256 + h * 64 + ch * 8); }
#pragma unroll
        for (int u = 0; u < 4; ++u) { const int p = ((it0 + u) * 512 + tid) >> 3; const size_t row = (size_t)tok_row(b, p);
            float y[8] = {bflo(ov[u].x) * (a0[u][0] + b0[u][0]), bfhi(ov[u].x) * (a0[u][1] + b0[u][1]), bflo(ov[u].y) * (a0[u][2] + b0[u][2]), bfhi(ov[u].y) * (a0[u][3] + b0[u][3]),
                          bflo(ov[u].z) * (a1[u][0] + b1[u][0]), bfhi(ov[u].z) * (a1[u][1] + b1[u][1]), bflo(ov[u].w) * (a1[u][2] + b1[u][2]), bfhi(ov[u].w) * (a1[u][3] + b1[u][3])};
            float ss = 0.f;
#pragma unroll
            for (int k = 0; k < 8; ++k) ss += y[k] * y[k];
            ss = sum_oct(ss);
            const float rs = __builtin_amdgcn_rsqf(ss * (1.0f / 64.0f) + EPS);
            const float rq = rs * YS; u32x2 w; w.x = pk_i8x4(y[0] * rq, y[1] * rq, y[2] * rq, y[3] * rq); w.y = pk_i8x4(y[4] * rq, y[5] * rq, y[6] * rq, y[7] * rq);
            *(GAS u32x2*)(gY + row * D + h * 64 + ch * 8) = w; }
    }
    __syncthreads();
}
}

namespace gmlp {
constexpr int VP = 272;
struct Args { const bf16* GU; const bf16* GV; const bf16* W; const float* gb; const float* gnorm; const float* mixn; bf16* Y; };
DI void item(LAS unsigned char* lds, const Args& a, size_t row0) {
    const int tid = opaque_tid(), wid = __builtin_amdgcn_readfirstlane(tid >> 6), lane = tid & 63, fr = lane & 15, fq = lane >> 4;
    { const int p = tid >> 2, part = tid & 3;
      const bf16* src = a.GV + (row0 + p) * 256 + 64 * part;
      u32x4 v[8]; float ss = 0.f;
#pragma unroll
      for (int i = 0; i < 8; ++i) { v[i] = *(const u32x4*)(src + 8 * i);
          ss += bflo(v[i].x) * bflo(v[i].x) + bfhi(v[i].x) * bfhi(v[i].x) + bflo(v[i].y) * bflo(v[i].y) + bfhi(v[i].y) * bfhi(v[i].y)
              + bflo(v[i].z) * bflo(v[i].z) + bfhi(v[i].z) * bfhi(v[i].z) + bflo(v[i].w) * bflo(v[i].w) + bfhi(v[i].w) * bfhi(v[i].w); }
      ss = sum_quad(ss);
      const float rs = __builtin_amdgcn_rsqf(ss * (1.0f / 256.0f) + EPS);
#pragma unroll
      for (int i = 0; i < 8; ++i) { const unsigned w[4] = {v[i].x, v[i].y, v[i].z, v[i].w};
#pragma unroll
          for (int k = 0; k < 4; ++k) { const int ch = 64 * part + 8 * i + 2 * k;
              const unsigned o = pk2(bflo(w[k]) * rs * a.gnorm[ch], bfhi(w[k]) * rs * a.gnorm[ch + 1]);
              *(LAS bf16*)(lds + ch * VP + 2 * p) = (bf16)(o & 0xffffu); *(LAS bf16*)(lds + (ch + 1) * VP + 2 * p) = (bf16)(o >> 16); } }
    }
    __syncthreads();
    const size_t row = row0 + 16 * wid + fr;
#pragma unroll 1
    for (int g = 0; g < 4; ++g) {
        bf16x8 wf[4];
#pragma unroll
        for (int ks = 0; ks < 4; ++ks) wf[ks] = *(const bf16x8*)(a.W + ((size_t)(g * 128 + 16 * wid + fr)) * 128 + 32 * ks + 8 * fq);
        const float bias = a.gb[g * 128 + 16 * wid + fr];
        f32x4 y[4]; float ss = 0.f;
#pragma unroll
        for (int ct = 0; ct < 4; ++ct) {
            f32x4 acc = (f32x4){0.f, 0.f, 0.f, 0.f};
#pragma unroll
            for (int ks = 0; ks < 4; ++ks) { const bf16x8 vf = *(const LAS bf16x8*)(lds + (64 * g + 16 * ct + fr) * VP + (32 * ks + 8 * fq) * 2); acc = __builtin_amdgcn_mfma_f32_16x16x32_bf16(vf, wf[ks], acc, 0, 0, 0); }
            const u32x2 uu = *(const u32x2*)(a.GU + row * 256 + 64 * g + 16 * ct + 4 * fq);
            y[ct][0] = bflo(uu.x) * (acc[0] + bias); y[ct][1] = bfhi(uu.x) * (acc[1] + bias); y[ct][2] = bflo(uu.y) * (acc[2] + bias); y[ct][3] = bfhi(uu.y) * (acc[3] + bias);
            ss += (y[ct][0] * y[ct][0] + y[ct][1] * y[ct][1]) + (y[ct][2] * y[ct][2] + y[ct][3] * y[ct][3]);
        }
        ss = sum_x16x32(ss);
        const float rs = __builtin_amdgcn_rsqf(ss * (1.0f / 64.0f) + EPS);
#pragma unroll
        for (int ct = 0; ct < 4; ++ct) { const float rq = rs * YS;
            *(unsigned*)((unsigned char*)a.Y + row * D + 256 + 64 * g + 16 * ct + 4 * fq) = pk_i8x4(y[ct][0] * rq, y[ct][1] * rq, y[ct][2] * rq, y[ct][3] * rq); }
    }
    __syncthreads();
}
}

DI int phys_head(int l) { return 128 * ((l >> 5) & 1) + 32 * (l >> 6) + 16 * ((l >> 2) & 1) + 4 * ((l >> 3) & 3) + (l & 3); }
DI int phys_glu(int c) { return 128 * ((c >> 3) & 1) + 32 * (c >> 6) + 16 * (c & 1) + 4 * ((c >> 4) & 3) + ((c >> 1) & 3); }
DI void tr_item_f8(const float* W, size_t ldw, int k0, size_t c0, unsigned char* WT8tile, int l0, LAS bf16* scr, int lane) {
    { const int kr = lane >> 4, c4 = lane & 15; const GAS float* Wg = (const GAS float*)W;
#pragma unroll 8
      for (int it = 0; it < 16; ++it) { const int kk = 4 * it + kr; const f32x4 v = *(const GAS f32x4*)(Wg + (size_t)(k0 + kk) * ldw + c0 + 4 * c4) * 64.0f;
          *(LAS unsigned*)(scr + kk * 66 + 4 * c4) = pk2(v[0], v[1]); *(LAS unsigned*)(scr + kk * 66 + 4 * c4 + 2) = pk2(v[2], v[3]); } }
    LDS_WAIT(); asm volatile("" ::: "memory");
    const int c = lane & 7;
#pragma unroll
    for (int jj = 0; jj < 8; ++jj) { const int o = (lane >> 3) + 8 * jj; const LAS bf16* s = scr + (8 * c) * 66 + o;
        u32x2 w; w.x = pk_fp8x4(bf2f(s[0]), bf2f(s[66]), bf2f(s[2 * 66]), bf2f(s[3 * 66])); w.y = pk_fp8x4(bf2f(s[4 * 66]), bf2f(s[5 * 66]), bf2f(s[6 * 66]), bf2f(s[7 * 66]));
        *(GAS u32x2*)((GAS unsigned char*)WT8tile + (size_t)phys_head(l0 + o) * 1024 + k0 + 8 * c) = w; }
    LDS_WAIT(); asm volatile("" ::: "memory");
}
DI void tr_item(const float* W, size_t ldw, int k0, size_t c0, bf16* WTtile, int l0, bool glu, LAS bf16* scr, int lane) {
#pragma unroll 8
    for (int kk = 0; kk < 64; ++kk) scr[kk * 66 + lane] = f2bf(W[(size_t)(k0 + kk) * ldw + c0 + lane]);
    LDS_WAIT(); asm volatile("" ::: "memory");
    const int c = lane & 7;
#pragma unroll
    for (int jj = 0; jj < 8; ++jj) { const int o = (lane >> 3) + 8 * jj; const LAS bf16* s = scr + (8 * c) * 66 + o;
        u32x4 w; w.x = (unsigned)s[0] | ((unsigned)s[66] << 16); w.y = (unsigned)s[2 * 66] | ((unsigned)s[3 * 66] << 16); w.z = (unsigned)s[4 * 66] | ((unsigned)s[5 * 66] << 16); w.w = (unsigned)s[6 * 66] | ((unsigned)s[7 * 66] << 16);
        const int pr = glu ? phys_glu(l0 + o) : phys_head(l0 + o);
        *(u32x4*)(WTtile + (size_t)pr * D + k0 + 8 * c) = w; }
    LDS_WAIT(); asm volatile("" ::: "memory");
}
DI void gu_item_i8(LAS unsigned char* lds, const float* W, size_t ldw, size_t c0, int cbk, bool glu, signed char* W8, float* CS, int tid, int wid, int lane, const float* rg = nullptr) {
    LAS bf16* scr = (LAS bf16*)lds; LAS float* cmx = (LAS float*)(lds + LDSCTL_OFF + 1024);
    { const int kr = lane >> 4, c4 = lane & 15; const GAS float* Wg = (const GAS float*)W;
      f32x4 mx = (f32x4){0.f, 0.f, 0.f, 0.f};
#pragma unroll 8
      for (int it = 0; it < 32; ++it) { const int k = 128 * wid + 4 * it + kr; f32x4 v = *(const GAS f32x4*)(Wg + (size_t)k * ldw + c0 + 4 * c4); if (rg) v = v * rg[k];
          mx[0] = fmaxf(mx[0], fabsf(v[0])); mx[1] = fmaxf(mx[1], fabsf(v[1])); mx[2] = fmaxf(mx[2], fabsf(v[2])); mx[3] = fmaxf(mx[3], fabsf(v[3]));
          *(LAS unsigned*)(scr + k * 66 + 4 * c4) = pk2(v[0], v[1]); *(LAS unsigned*)(scr + k * 66 + 4 * c4 + 2) = pk2(v[2], v[3]); }
#pragma unroll
      for (int j = 0; j < 4; ++j) mx[j] = max_x16x32(mx[j]);
      if (kr == 0) *(LAS f32x4*)(cmx + wid * 64 + 4 * c4) = mx; }
    __syncthreads();
    if (tid < 64) { float m = cmx[tid];
#pragma unroll
        for (int w = 1; w < 8; ++w) m = fmaxf(m, cmx[w * 64 + tid]);
        m = fmaxf(m, 1e-30f); cmx[512 + tid] = m; CS[(cbk >> 2) * 256 + (glu ? phys_glu((cbk & 3) * 64 + tid) : phys_head((cbk & 3) * 64 + tid))] = m * (1.0f / 127.0f); }
    __syncthreads();
#pragma unroll 2
    for (int it = 0; it < 8; ++it) { const int r = (it * 512 + tid) >> 6, o = 16 * (r & 3) + ((tid >> 2) & 15), kc = 4 * (r >> 2) + (tid & 3);
        const float qs = 127.0f / cmx[512 + o]; const LAS bf16* sp = scr + (16 * kc) * 66 + o;
        unsigned w[4];
#pragma unroll
        for (int g = 0; g < 4; ++g) { unsigned acc = 0;
#pragma unroll
            for (int i = 0; i < 4; ++i) { int q = (int)rintf(bf2f(sp[(4 * g + i) * 66]) * qs); q = q > 127 ? 127 : (q < -127 ? -127 : q); acc |= (unsigned)(q & 255) << (8 * i); }
            w[g] = acc; }
        *(GAS u32x4*)((GAS signed char*)W8 + ((size_t)((cbk >> 2) * 256 + (glu ? phys_glu((cbk & 3) * 64 + o) : phys_head((cbk & 3) * 64 + o)))) * 1024 + 16 * kc) = (u32x4){w[0], w[1], w[2], w[3]}; }
    __syncthreads();
}
DI void prologue(LAS unsigned char* lds, unsigned char* ws) {
    const KArgP ka = kargs();
#define in (ka->in)
    const int tid = opaque_tid(), wid = __builtin_amdgcn_readfirstlane(tid >> 6), lane = tid & 63;
    const int G = gridDim.x, B = opaque_bid();
    float* MOD = (float*)(ws + WS_MOD);
    if (B < 192) {
        LAS float* sl = (LAS float*)lds;
        LAS float* red = (LAS float*)(lds + 17 * 1024 * 4);
        for (int i = tid; i < 17 * 1024; i += 512) { const int r = i >> 10, k = i & 1023; const float v = r < 16 ? in.c[r * 1024 + k] : in.c_ctx[k]; sl[i] = v / (1.0f + __expf(-v)); }
        __syncthreads();
        for (int it = B; it < 192; it += G) {
            const int l = it / 48, cb = it % 48; const float* wp = in.w_ada + ((size_t)l * 1024 + 128 * wid) * 6144 + 128 * cb + 2 * lane;
            f32x2 acc[17];
#pragma unroll
            for (int r = 0; r < 17; ++r) acc[r] = (f32x2){0.f, 0.f};
#pragma unroll 4
            for (int k = 0; k < 128; ++k) { const f32x2 w = *(const f32x2*)(wp + (size_t)k * 6144);
#pragma unroll
                for (int r = 0; r < 17; ++r) { const float s = sl[r * 1024 + 128 * wid + k]; acc[r] = acc[r] + w * s; } }
            if (wid > 0) {
#pragma unroll
                for (int r = 0; r < 17; ++r) *(LAS f32x2*)(red + ((wid - 1) * 17 + r) * 128 + 2 * lane) = acc[r]; }
            __syncthreads();
            if (wid == 0) {
#pragma unroll
                for (int r = 0; r < 17; ++r) { f32x2 s = acc[r];
#pragma unroll
                    for (int w = 0; w < 7; ++w) s = s + *(const LAS f32x2*)(red + (w * 17 + r) * 128 + 2 * lane);
                    const f32x2 bb = *(const f32x2*)(in.b_ada + (size_t)l * 6144 + 128 * cb + 2 * lane);
                    *(f32x2*)(MOD + ((size_t)l * 17 + r) * 6144 + 128 * cb + 2 * lane) = s + bb; } }
            __syncthreads();
        }
    }
    __syncthreads();
    const size_t gt = (size_t)B * 512 + tid, gs = (size_t)G * 512;
    { float* rc = (float*)(ws + WS_ROPE); float* rs = rc + 65 * 16;
      if (gt < 16) { rc[64 * 16 + gt] = 1.0f; rs[64 * 16 + gt] = 0.0f; }
      for (size_t i = gt; i < (size_t)64 * 16; i += gs) { const int pos = (int)(i >> 4), k = (int)(i & 15); const float invf = powf(10000.0f, -(float)k / 16.0f);
          const float ang = (float)pos * invf; rc[i] = cosf(ang); rs[i] = sinf(ang); } }
    { bf16* WG = (bf16*)(ws + WS_WG);
      for (size_t i = gt; i < (size_t)DEPTH * 16 * 1024; i += gs) { const int l = (int)(i >> 14), n = (int)((i >> 10) & 15), k = (int)(i & 1023);
          const float v = in.w_in[((size_t)l * 1024 + k) * DIN + 1024 + n]; const bf16 hi = f2bf(v); WG[((size_t)(l * 2) * 16 + n) * 1024 + k] = hi; WG[((size_t)(l * 2 + 1) * 16 + n) * 1024 + k] = f2bf(v - bf2f(hi)); } }
    { bf16* WR = (bf16*)(ws + WS_WR);
      for (size_t i = gt; i < (size_t)DEPTH * 32 * 1024; i += gs) { const int l = (int)(i >> 15), n = (int)((i >> 10) & 31), k = (int)(i & 1023);
          const float v = in.router_w[((size_t)l * 1024 + k) * 32 + n]; const bf16 hi = f2bf(v); WR[((size_t)(l * 2) * 32 + n) * 1024 + k] = hi; WR[((size_t)(l * 2 + 1) * 32 + n) * 1024 + k] = f2bf(v - bf2f(hi)); } }
    { bf16* GW = (bf16*)(ws + WS_GWS);
      for (size_t i = gt; i < (size_t)DEPTH * 4 * 128 * 128; i += gs) GW[i] = f2bf(in.gmlp_ws[i]); }
    __syncthreads();
    for (int it = B; it < DEPTH * NE * 32; it += G) { const int le = it >> 5, cbk = it & 31;
        gu_item_i8(lds, in.w_gate_up + (size_t)le * 1024 * 2048, 2048, (size_t)cbk * 64, cbk, true, (signed char*)(ws + WS_WGU) + (size_t)le * 2048 * 1024, (float*)(ws + WS_CSGU) + (size_t)le * 2048, tid, wid, lane); }
    for (int it = B; it < DEPTH * 36; it += G) { const int l = it / 36, cbk = it % 36;
        gu_item_i8(lds, in.w_in + (size_t)l * 1024 * DIN, DIN, (size_t)cbk * 64 + (cbk >= 16 ? 16 : 0), cbk, false, (signed char*)(ws + WS_WIN) + (size_t)l * NPROJ * 1024, (float*)(ws + WS_CSIN) + (size_t)l * NPROJ, tid, wid, lane); }
    for (int it = B; it < DEPTH * 16; it += G) { const int l = it >> 4, cbk = it & 15;
        gu_item_i8(lds, in.w_out + (size_t)l * 1024 * 1024, 1024, (size_t)cbk * 64, cbk, false, (signed char*)(ws + WS_WOUT) + (size_t)l * 1024 * 1024, (float*)(ws + WS_CSOUT) + (size_t)l * 1024, tid, wid, lane, in.mix_norm + (size_t)l * 1024); }
    {
        LAS bf16* scr = (LAS bf16*)(lds + wid * (64 * 66 * 2));
        const int vcu = (G % 8 == 0) ? (B % 8) * (G / 8) + B / 8 : B;
        const long gw = (long)vcu * 8 + wid, NGW = (long)G * 8;
        constexpr long I_IN = 0, I_OUT = 0, I_GU = 0, I_DN = (long)DEPTH * NE * 16 * 16;
        for (long it = gw; it < I_IN + I_OUT + I_GU + I_DN; it += NGW) {
            long r = it;
            if (r < I_IN) { const int l = (int)(r / (36 * 16)), q = (int)(r % (36 * 16)), cbk = q >> 4, kb = q & 15;
                const size_t c0 = (size_t)cbk * 64 + (cbk >= 16 ? 16 : 0);
                tr_item(in.w_in + (size_t)l * 1024 * DIN, DIN, 64 * kb, c0, (bf16*)(ws + WS_WIN) + ((size_t)l * NPROJ + (size_t)(cbk >> 2) * 256) * D, (cbk & 3) * 64, false, scr, lane); continue; }
            r -= I_IN;
            if (r < I_OUT) { const int l = (int)(r >> 8), q = (int)(r & 255), cbk = q >> 4, kb = q & 15;
                tr_item_f8(in.w_out + (size_t)l * 1024 * 1024, 1024, 64 * kb, (size_t)cbk * 64, (unsigned char*)(ws + WS_WOUT) + ((size_t)l * 1024 + (size_t)(cbk >> 2) * 256) * D, (cbk & 3) * 64, scr, lane); continue; }
            r -= I_OUT;
            if (r < I_GU) { const int le = (int)(r >> 9), q = (int)(r & 511), cbk = q >> 4, kb = q & 15;
                tr_item(in.w_gate_up + (size_t)le * 1024 * 2048, 2048, 64 * kb, (size_t)cbk * 64, (bf16*)(ws + WS_WGU) + ((size_t)le * 2048 + (size_t)(cbk >> 2) * 256) * D, (cbk & 3) * 64, true, scr, lane); continue; }
            r -= I_GU;
            { const int le = (int)(r >> 8), q = (int)(r & 255), cbk = q >> 4, kb = q & 15;
                tr_item_f8(in.w_down + (size_t)le * 1024 * 1024, 1024, 64 * kb, (size_t)cbk * 64, (unsigned char*)(ws + WS_WDN) + ((size_t)le * 1024 + (size_t)(cbk >> 2) * 256) * D, (cbk & 3) * 64, scr, lane); }
        }
    }
    __syncthreads();
#undef in
}

DI void moe_convert_item(LAS unsigned char* lds, unsigned char* ws, int l, int it) {
    const int tid = opaque_tid(), wid = __builtin_amdgcn_readfirstlane(tid >> 6), lane = tid & 63;
    const KArgP ka = kargs();
    if (it < 1024) { const int le = l * NE + (it >> 5), cbk = it & 31;
        gu_item_i8(lds, (const float*)ka->in.w_gate_up + (size_t)le * 1024 * 2048, 2048, (size_t)cbk * 64, cbk, true, (signed char*)(ws + WS_WGU) + (size_t)le * 2048 * 1024, (float*)(ws + WS_CSGU) + (size_t)le * 2048, tid, wid, lane); }
    else { const int r = it - 1024, le = l * NE + (r >> 5), q = r & 31, cbk = q >> 1, kb = (q & 1) * 8 + wid;
        tr_item_f8((const float*)ka->in.w_down + (size_t)le * 1024 * 1024, 1024, 64 * kb, (size_t)cbk * 64, (unsigned char*)(ws + WS_WDN) + ((size_t)le * 1024 + (size_t)(cbk >> 2) * 256) * D, (cbk & 3) * 64, (LAS bf16*)(lds + wid * (64 * 66 * 2)), lane); }
}

constexpr int N_PHASES = 2 + 8 * DEPTH;
DI int q_next(unsigned* head, LAS int* bc) {
    if (opaque_tid() == 0) bc[0] = (int)__hip_atomic_fetch_add(head, 1u, RLX_AGENT);
    __syncthreads(); const int v = bc[0]; __syncthreads(); return v;
}
__global__ void __launch_bounds__(512, 2) mega_fwd(Args args) {
    extern __shared__ __attribute__((aligned(16))) unsigned char lds_raw[];
    LAS unsigned char* lds = (LAS unsigned char*)lds_raw;
    const int tid = threadIdx.x;
    volatile LAS unsigned* MISC = (volatile LAS unsigned*)(lds + LDSCTL_OFF);
    for (int u = tid; u < 64; u += 512) MISC[u] = 0u;
    __syncthreads();
    unsigned char* ws = kargs()->ws;
    unsigned* ctl = (unsigned*)(ws + WS_CTL);
    const int lo = kargs()->ph_lo, hi = kargs()->ph_hi;
    XcdBarrier bar; bar.bar = ctl + CW_BAR; bar.x = 0; bar.st = nullptr;
    if (hi - lo > 1) bar = xcd_barrier_post(ctl + CW_BAR, MISC + 8);
    LAS int* qbc = (LAS int*)(lds + LDSCTL_OFF + 128);
    const int G = gridDim.x;
#define IN(k) (lo <= (k) && (k) < hi)
#define SEAM(k) do { if (IN(k) && IN((k) + 1)) xcd_barrier(bar); } while (0)

#ifndef EN_MASK
#define EN_MASK 0xFFFF
#endif
#define EN(b) ((EN_MASK >> (b)) & 1)
#ifndef REP_MASK
#define REP_MASK 0
#endif
#ifndef DUP_MASK
#define DUP_MASK 0
#endif
#define NREP(b) (((REP_MASK >> (b)) & 1) ? 2 : 1)
    if (EN(0) && IN(0)) { for (int rep = 0; rep < NREP(0); ++rep) { prologue(lds, ws); SEAM(0); } }

    for (int l = 0; l < DEPTH; ++l) {
        const int pb = 1 + 8 * l;
        ws = opaque_ptr(ws);
        const float* modl = (const float*)(ws + WS_MOD) + (size_t)l * 17 * 6144;
        if (EN(1) && IN(pb)) {
            NormArgs a{}; const KArgP ka = kargs();
            a.xin = l == 0 ? nullptr : (const float*)(ws + WS_XLA + (size_t)((l - 1) & 1) * XL_BYTES); a.delta = l == 0 ? nullptr : (const bf16*)(ws + WS_H); a.dsc = (const float*)(ws + WS_DSC); a.x0 = ka->in.x; a.ctx0 = ka->in.ctx;
            a.mout = l == 0 ? nullptr : (const bf16*)(ws + WS_MOUT); a.msc = (const float*)(ws + WS_MSC); a.toks = (const int*)(ws + WS_TOKS); a.g2mod = modl - 17 * 6144;
            a.mod = modl; a.shi = 0; a.sci = 1; a.xout = (float*)(ws + WS_XLA + (size_t)(l & 1) * XL_BYTES); a.hout = nullptr; a.h8 = (signed char*)(ws + WS_H8); a.hs = (float*)(ws + WS_HS);
            a.wsm = (const bf16*)(ws + WS_WG) + (size_t)l * 2 * 16 * 1024; a.sbias = ka->in.b_in + (size_t)l * DIN + 1024; a.mg = (float*)(ws + WS_MG);
            for (int rep = 0; rep < NREP(1); ++rep) { norm_phase<0>(lds, a); SEAM(pb); }
        }
        if (EN(2) && IN(pb + 1)) {
            pg8::TileOrder S; S.init(NRT, NPROJ / 256, G, opaque_bid());
            SrcPlain8 src{(const char*)(ws + WS_WIN) + (size_t)l * NPROJ * D};
            { LAS float* rl_ = (LAS float*)(lds + ROPE_LDS_OFF); const float* rg_ = (const float*)(ws + WS_ROPE); const int t_ = opaque_tid();
              for (int i = t_; i < 2080; i += 512) rl_[i] = rg_[i];
              if (t_ < 128) rl_[2080 + t_] = (t_ < 64) ? kargs()->in.q_norm[l * 64 + t_] : kargs()->in.k_norm[l * 64 + t_ - 64];
              __syncthreads(); }
            EpiInProj E{ws, l, (const LAS float*)(lds + ROPE_LDS_OFF)};
            for (int rep = 0; rep < NREP(2); ++rep) { pg8::gemm_phase<EpiInProj, SrcPlain8, false, 1>(lds, (const bf16*)(ws + WS_H8), S, src, E); SEAM(pb + 1); }
        }
        if (IN(pb + 2)) {
            const float* mixn = kargs()->in.mix_norm + (size_t)l * D;
            if (EN(3)) for (int rep = 0; rep < NREP(3); ++rep) { mlstm::Args ma{(const bf16*)(ws + WS_MQ), (const bf16*)(ws + WS_MK), (const bf16*)(ws + WS_MV), (const bf16*)(ws + WS_MO), (const float*)(ws + WS_MG), (float*)(ws + WS_HFB), (bf16*)(ws + WS_Y), mixn};
              for (;;) { const int idx = q_next(ctl + CW_Q + 64 * ((rep * 4 + l) * 3 + 0), qbc); if (idx >= NB * 4) break; mlstm::item(lds, ma, idx >> 2, idx & 3); } }
            if (EN(4)) for (int rep = 0; rep < NREP(4); ++rep) { const int nlat = NB * 8 * 16, ntot = nlat + (l < DEPTH - 1 ? NB * 8 : 0);
              const unsigned char* AQ = (const unsigned char*)(ws + WS_AQ); const unsigned char* AK = (const unsigned char*)(ws + WS_AK); const bf16* AV = (const bf16*)(ws + WS_AV); unsigned char* Y = (unsigned char*)(ws + WS_Y);
              float gq = 0.f, gk = 0.f; { const int ln = opaque_tid() & 63; gq = fabsf(((const float*)kargs()->in.q_norm)[l * 64 + ln]); gk = fabsf(((const float*)kargs()->in.k_norm)[l * 64 + ln]); }
              const float sbound = 8.0f * wave_max(gq) * wave_max(gk) * 1.4426950408889634f * 1.13f;
#define ATT_LOOP(NM) for (;;) { const int idx = q_next(ctl + CW_Q + 64 * ((rep * 4 + l) * 3 + 1), qbc); if (idx >= ntot) break; \
                  int b, h, nt; size_t qrow; \
                  if (idx < nlat) { const int qb = idx & 15, hq = (idx >> 4) & 3, kvh = (idx >> 6) & 1; b = idx >> 7; h = kvh * 4 + hq; nt = TKV / 64; qrow = (size_t)NCTX + (size_t)b * T + (size_t)qb * 256; } \
                  else { const int i2 = idx - nlat; b = i2 >> 3; h = i2 & 7; nt = TC / 64; qrow = (size_t)b * TC; } \
                  const size_t kvo = (size_t)(b * 2 + (h >> 2)) * TKV * 64; \
                  attn_body::attn_unit<8, NM>(AQ + qrow * 512 + h * 64, AK + kvo, AV + kvo, nt, Y + qrow * D + 512 + h * 64, mixn + 512 + h * 64, (char*)lds_raw); }
              if (__builtin_amdgcn_readfirstlane(sbound < 100.0f ? 1 : 0)) { ATT_LOOP(true) } else { ATT_LOOP(false) }
#undef ATT_LOOP
              }
            if (EN(5)) for (int rep = 0; rep < NREP(5); ++rep) { gmlp::Args ga{(const bf16*)(ws + WS_GU), (const bf16*)(ws + WS_GV), (const bf16*)(ws + WS_GWS) + (size_t)l * 4 * 128 * 128, kargs()->in.gmlp_b + (size_t)l * 4 * 128, kargs()->in.gmlp_norm + (size_t)l * 256, mixn, (bf16*)(ws + WS_Y)};
              const int nlat = NB * 32, ntot = nlat + (l < DEPTH - 1 ? NB * 2 : 0);
              for (;;) { const int idx = q_next(ctl + CW_Q + 64 * ((rep * 4 + l) * 3 + 2), qbc); if (idx >= ntot) break;
                  const size_t row0 = idx < nlat ? (size_t)NCTX + (size_t)(idx >> 5) * T + (size_t)(idx & 31) * 128 : (size_t)((idx - nlat) >> 1) * TC + (size_t)((idx - nlat) & 1) * 128;
                  gmlp::item(lds, ga, row0); } }
            SEAM(pb + 2);
        }
        if (EN(6) && IN(pb + 3)) {
            pg8::TileOrder S; S.init(NRT, D / 256, G, opaque_bid());
            SrcPlain8 src{(const char*)(ws + WS_WOUT) + (size_t)l * D * D};
            EpiOutProj E{ws, l};
            for (int rep = 0; rep < NREP(6); ++rep) { pg8::gemm_phase<EpiOutProj, SrcPlain8, false, 1>(lds, (const bf16*)(ws + WS_Y), S, src, E); SEAM(pb + 3); }
        }
        if (EN(7) && IN(pb + 4)) {
            NormArgs a{};
            a.xin = (const float*)(ws + WS_XLA + (size_t)(l & 1) * XL_BYTES); a.delta = (const bf16*)(ws + WS_H); a.dsc = (const float*)(ws + WS_DSC); a.mout = nullptr; a.mod = modl; a.shi = 3; a.sci = 4; a.xout = nullptr; a.hout = nullptr; a.h8 = (signed char*)(ws + WS_H8); a.hs = (float*)(ws + WS_HS);
            a.wsm = (const bf16*)(ws + WS_WR) + (size_t)l * 2 * 32 * 1024; a.sbias = kargs()->in.router_b + (size_t)l * 32;
            a.toke = (int*)(ws + WS_TOKE); a.tokg = (float*)(ws + WS_TOKG); a.ghist = (int*)(ws + WS_GHIST); a.bhist = (int*)(ws + WS_BHIST); a.gs = (l == DEPTH - 1) ? NCTX / 16 : 0;
            for (int rep = 0; rep < NREP(7); ++rep) { norm_phase<1>(lds, a); SEAM(pb + 4); }
        }
        if (EN(8) && IN(pb + 5)) {
            ScatterArgs a{(const int*)(ws + WS_TOKE), (const float*)(ws + WS_TOKG), (const int*)(ws + WS_GHIST), (const int*)(ws + WS_BHIST), (int*)(ws + WS_TOKS), (int*)(ws + WS_SLTOK), (float*)(ws + WS_SLG), (int*)(ws + WS_RTE), (const float*)(ws + WS_HS), (float*)(ws + WS_SLS), (l == DEPTH - 1) ? NCTX / 16 : 0, (unsigned char*)(ws + WS_RTEB)};
            for (int rep = 0; rep < NREP(8); ++rep) { scatter_phase(lds, a); SEAM(pb + 5); }
        }
        if (EN(9) && IN(pb + 6)) {
            const int* rte = (const int*)(ws + WS_RTE);
            pg8::TileOrder S; S.init(__builtin_amdgcn_readfirstlane(rte[0]), 2 * DFF / 256, G, opaque_bid());
            SrcMoeGather src{ws, l};
            EpiGateUp E{ws, l};
            for (int rep = 0; rep < NREP(9); ++rep) { pg8::gemm_phase<EpiGateUp, SrcMoeGather, false, 1>(lds, (const bf16*)(ws + WS_H8), S, src, E); SEAM(pb + 6); }
        }
        if (EN(10) && IN(pb + 7)) {
            const int* rte = (const int*)(ws + WS_RTE);
            pg8::TileOrder S; S.init(__builtin_amdgcn_readfirstlane(rte[0]), D / 256, G, opaque_bid());
            SrcMoePlain src{ws, l};
            EpiDown E{ws, l};
            for (int rep = 0; rep < NREP(10); ++rep) { pg8::gemm_phase<EpiDown, SrcMoePlain, false, 2>(lds, (const bf16*)(ws + WS_ACT), S, src, E); SEAM(pb + 7); }
        }
    }
    if (EN(11) && IN(N_PHASES - 1)) {
        NormArgs a{};
        a.xin = (const float*)(ws + WS_XLA + (size_t)((DEPTH - 1) & 1) * XL_BYTES); a.delta = (const bf16*)(ws + WS_H); a.dsc = (const float*)(ws + WS_DSC); a.mout = (const bf16*)(ws + WS_MOUT); a.msc = (const float*)(ws + WS_MSC); a.toks = (const int*)(ws + WS_TOKS); a.g2mod = (const float*)(ws + WS_MOD) + (size_t)(DEPTH - 1) * 17 * 6144;
        a.fnorm = kargs()->in.final_norm; a.out = kargs()->out;
        norm_phase<2>(lds, a);
    }
#undef IN
#undef SEAM
}

extern "C" void kernel_launch(void* const* d_in, const int* in_sizes, int n_in, void* d_out, int out_size, void* d_ws, size_t ws_size, hipStream_t stream) {
    static int grid = 0;
    if (grid == 0) {
        if (n_in != 22 || out_size != NLAT * D || ws_size < WS_END) { fprintf(stderr, "kernel_launch: unexpected shapes (n_in %d, out %d, ws %zu, need %zu)\n", n_in, out_size, ws_size, (size_t)WS_END); grid = -1; return; }
        int dev = 0, cus = 0, per_cu = 0;
        if (hipGetDevice(&dev) != hipSuccess || hipDeviceGetAttribute(&cus, hipDeviceAttributeMultiprocessorCount, dev) != hipSuccess) { grid = -1; return; }
        if (hipFuncSetAttribute((const void*)mega_fwd, hipFuncAttributeMaxDynamicSharedMemorySize, LDS_BYTES) != hipSuccess) { fprintf(stderr, "kernel_launch: hipFuncSetAttribute failed\n"); grid = -1; return; }
        if (hipOccupancyMaxActiveBlocksPerMultiprocessor(&per_cu, (const void*)mega_fwd, 512, LDS_BYTES) != hipSuccess || per_cu < 1) { fprintf(stderr, "kernel_launch: occupancy query says %d\n", per_cu); per_cu = 1; }
        (void)hipGetLastError();
        grid = cus;
    }
    if (grid < 0) return;
    if (hipMemsetAsync((char*)d_ws + WS_CTL, 0, CTL_ZERO_BYTES, stream) != hipSuccess) return;
    Args a{};
    const float** ip = (const float**)&a.in;
    for (int i = 0; i < 22; ++i) ip[i] = (const float*)d_in[i];
    a.out = (float*)d_out; a.ws = (unsigned char*)d_ws;
#if MK_N_LAUNCHES == 1
    a.ph_lo = 0; a.ph_hi = N_PHASES;
    hipLaunchKernelGGL(mega_fwd, dim3(grid), dim3(512), LDS_BYTES, stream, a);
#else
    for (int p = 0; p < N_PHASES; ++p) { a.ph_lo = p; a.ph_hi = p + 1; hipLaunchKernelGGL(mega_fwd, dim3(grid), dim3(512), LDS_BYTES, stream, a); }
#endif
}
```

```cpp
#include <hip/hip_runtime.h>
#include <cstdio>
#include <cstdint>

#ifndef MK_N_LAUNCHES
#define MK_N_LAUNCHES 1
#endif

#define GAS __attribute__((address_space(1)))
#define LAS __attribute__((address_space(3)))
#define DI __device__ __forceinline__
typedef unsigned short bf16;
typedef short bf16x8 __attribute__((ext_vector_type(8)));
typedef float f32x4 __attribute__((ext_vector_type(4)));
typedef float f32x2 __attribute__((ext_vector_type(2)));
typedef unsigned u32x4 __attribute__((ext_vector_type(4)));
typedef int i32x4 __attribute__((ext_vector_type(4)));
typedef unsigned u32x2 __attribute__((ext_vector_type(2)));
typedef __bf16 bf16x2_t __attribute__((ext_vector_type(2)));
typedef GAS unsigned gu32;

constexpr int D = 1024, NB = 16, T = 4096, TC = 256, DEPTH = 4;
constexpr int NCTX = NB * TC;
constexpr int NLAT = NB * T;
constexpr int NTOK = NCTX + NLAT;
constexpr int NRT = NTOK / 256;
constexpr int TKV = TC + T;
constexpr int DIN = 2320, NPROJ = 2304;
constexpr int NE = 32, TOPK = 4, DFF = 1024;
constexpr int NSLOT_MAX = NTOK * TOPK + NE * 256;
constexpr int NRT_MOE_MAX = NSLOT_MAX / 256;
constexpr int NGRP = NTOK / 16;
constexpr float EPS = 1e-6f;
constexpr float C2 = 0.125f * 1.4426950408889634f;

constexpr size_t al256(size_t x) { return (x + 255) & ~(size_t)255; }
constexpr size_t WS_CTL = 0, CTL_ZERO_BYTES = 1u << 20;
constexpr size_t WS_WIN = CTL_ZERO_BYTES;
constexpr size_t WS_WOUT = WS_WIN + (size_t)DEPTH * NPROJ * D * 2;
constexpr size_t WS_WGU = WS_WOUT + (size_t)DEPTH * D * D * 2;
constexpr size_t WS_WDN = WS_WGU + (size_t)DEPTH * NE * 2 * DFF * D * 2;
constexpr size_t WS_WG = WS_WDN + (size_t)DEPTH * NE * D * DFF * 2;
constexpr size_t WS_WR = WS_WG + (size_t)DEPTH * 2 * 16 * D * 2;
constexpr size_t WS_GWS = WS_WR + (size_t)DEPTH * 2 * 32 * D * 2;
constexpr size_t WS_MOD = WS_GWS + (size_t)DEPTH * 4 * 128 * 128 * 2;
constexpr size_t WS_ROPE = al256(WS_MOD + (size_t)DEPTH * 17 * 6 * D * 4);
constexpr size_t WS_XLA = al256(WS_ROPE + (size_t)2 * 65 * 16 * 4);
constexpr size_t XL_BYTES = (size_t)NTOK * D * 2;
constexpr size_t WS_XLB = WS_XLA + (size_t)NTOK * D * 4;
constexpr size_t WS_H = WS_XLB + (size_t)NTOK * D * 4;
constexpr size_t WS_Y = WS_H + (size_t)NTOK * D * 2;
constexpr size_t WS_MQ = WS_Y + (size_t)NTOK * D * 2;
constexpr size_t WS_MK = WS_MQ + (size_t)NTOK * 256 * 2;
constexpr size_t WS_MV = WS_MK + (size_t)NTOK * 256 * 2;
constexpr size_t WS_MO = WS_MV + (size_t)NTOK * 256 * 2;
constexpr size_t WS_MG = WS_MO + (size_t)NTOK * 256 * 2;
constexpr size_t WS_GU = WS_MG + (size_t)NTOK * 16 * 4;
constexpr size_t WS_GV = WS_GU + (size_t)NTOK * 256 * 2;
constexpr size_t WS_AQ = WS_GV + (size_t)NTOK * 256 * 2;
constexpr size_t WS_AK = WS_AQ + (size_t)NTOK * 512 * 2;
constexpr size_t WS_AV = WS_AK + (size_t)NB * 2 * TKV * 64 * 2;
constexpr size_t WS_HFB = WS_AV + (size_t)NB * 2 * TKV * 64 * 2;
constexpr size_t WS_TOKE = WS_HFB + (size_t)NB * 4 * 2 * TKV * 64 * 4;
constexpr size_t WS_TOKG = WS_TOKE + (size_t)NTOK * 4 * 4;
constexpr size_t WS_TOKS = WS_TOKG + (size_t)NTOK * 4 * 4;
constexpr size_t WS_GHIST = WS_TOKS + (size_t)NTOK * 4 * 4;
constexpr size_t WS_BHIST = WS_GHIST + (size_t)NGRP * 32 * 4;
constexpr size_t WS_SLTOK = WS_BHIST + (size_t)1024 * 32 * 4;
constexpr size_t WS_SLG = WS_SLTOK + (size_t)NSLOT_MAX * 4;
constexpr size_t WS_RTE = WS_SLG + (size_t)NSLOT_MAX * 4;
constexpr size_t WS_RTEB = al256(WS_RTE + (size_t)(NRT_MOE_MAX + 64) * 4);
constexpr size_t WS_ACT = al256(WS_RTEB + 2048);
constexpr size_t WS_MOUT = WS_ACT + (size_t)NSLOT_MAX * DFF * 2;
constexpr size_t WS_CSGU = WS_MOUT + (size_t)NSLOT_MAX * D * 2;
constexpr size_t WS_H8 = WS_CSGU + (size_t)DEPTH * NE * 2 * DFF * 4;
constexpr size_t WS_HS = WS_H8 + (size_t)NTOK * D;
constexpr size_t WS_SLS = WS_HS + (size_t)NTOK * 4;
constexpr size_t WS_CSIN = al256(WS_SLS + (size_t)NSLOT_MAX * 4);
constexpr size_t WS_MSC = al256(WS_CSIN + (size_t)DEPTH * NPROJ * 4);
constexpr size_t WS_DSC = al256(WS_MSC + (size_t)NSLOT_MAX * 16 * 4);
constexpr size_t WS_CSOUT = al256(WS_DSC + (size_t)NTOK * 16 * 4);
constexpr size_t WS_END = al256(WS_CSOUT + (size_t)DEPTH * D * 4);
static_assert(WS_END < (size_t)4200 * 1000 * 1000, "workspace map exceeds 4x the largest input");

constexpr int CW_TMO = 0;
constexpr int CW_Q = 64;
constexpr int CW_BAR = 4096;

constexpr int SCR_BYTES = 135168;
constexpr int LDSCTL_OFF = SCR_BYTES;
constexpr int ROPE_LDS_OFF = LDSCTL_OFF + 4096 + 6144;
constexpr int LDS_BYTES = 155648;

#define LDS_WAIT() asm volatile("s_waitcnt lgkmcnt(0)" ::: "memory")
#define VM_WAIT() asm volatile("s_waitcnt vmcnt(0)" ::: "memory")
#define RLX_AGENT __ATOMIC_RELAXED, __HIP_MEMORY_SCOPE_AGENT
DI unsigned pk2(float lo, float hi) { f32x2 v = {lo, hi}; bf16x2_t b = __builtin_convertvector(v, bf16x2_t); return __builtin_bit_cast(unsigned, b); }
DI bf16 f2bf(float f) { return (bf16)(pk2(f, 0.f) & 0xffffu); }
DI float bf2f(unsigned b) { return __uint_as_float(b << 16); }
DI float bflo(unsigned w) { return __uint_as_float(w << 16); }
DI float bfhi(unsigned w) { return __uint_as_float(w & 0xffff0000u); }
DI int opaque_tid() { int t = threadIdx.x; asm volatile("" : "+v"(t)); return t; }
DI int opaque_bid() { int b = blockIdx.x; asm volatile("" : "+s"(b)); return b; }
template <class Tp> DI Tp* opaque_ptr(Tp* p) { asm volatile("" : "+s"(p)); return p; }
template <class Tp> DI const GAS Tp* uni(const GAS Tp* p) { const unsigned long long v = (unsigned long long)p; const unsigned lo = (unsigned)__builtin_amdgcn_readfirstlane((int)(unsigned)v), hi = (unsigned)__builtin_amdgcn_readfirstlane((int)(unsigned)(v >> 32)); return (const GAS Tp*)(((unsigned long long)hi << 32) | lo); }
template <class Tp> DI GAS Tp* uni(GAS Tp* p) { const unsigned long long v = (unsigned long long)p; const unsigned lo = (unsigned)__builtin_amdgcn_readfirstlane((int)(unsigned)v), hi = (unsigned)__builtin_amdgcn_readfirstlane((int)(unsigned)(v >> 32)); return (GAS Tp*)(((unsigned long long)hi << 32) | lo); }
DI unsigned pk_fp8x4(float a, float b, float c, float d) { int p = __builtin_amdgcn_cvt_pk_fp8_f32(fminf(fmaxf(a, -448.f), 448.f), fminf(fmaxf(b, -448.f), 448.f), 0, false); p = __builtin_amdgcn_cvt_pk_fp8_f32(fminf(fmaxf(c, -448.f), 448.f), fminf(fmaxf(d, -448.f), 448.f), p, true); return (unsigned)p; }
DI unsigned pk_i8x4(float a, float b, float c, float d) { const int q0 = (int)rintf(a), q1 = (int)rintf(b), q2 = (int)rintf(c), q3 = (int)rintf(d); return (unsigned)(q0 & 255) | ((unsigned)(q1 & 255) << 8) | ((unsigned)(q2 & 255) << 16) | ((unsigned)q3 << 24); }
constexpr float YS = 127.0f / 8.0f;
DI unsigned pk_fp8x4_nc(float a, float b, float c, float d) { int p = __builtin_amdgcn_cvt_pk_fp8_f32(a, b, 0, false); p = __builtin_amdgcn_cvt_pk_fp8_f32(c, d, p, true); return (unsigned)p; }
template <int CTRL> DI float dpp_f(float v) { return __builtin_bit_cast(float, __builtin_amdgcn_update_dpp(0, __builtin_bit_cast(int, v), CTRL, 0xF, 0xF, true)); }
template <int CTRL> DI int dpp_i(int v) { return __builtin_amdgcn_update_dpp(0, v, CTRL, 0xF, 0xF, true); }
DI float sum_x16(float v) { auto r = __builtin_amdgcn_permlane16_swap(__float_as_uint(v), __float_as_uint(v), false, false); return __uint_as_float(r[0]) + __uint_as_float(r[1]); }
DI float sum_x32(float v) { auto r = __builtin_amdgcn_permlane32_swap(__float_as_uint(v), __float_as_uint(v), false, false); return __uint_as_float(r[0]) + __uint_as_float(r[1]); }
DI float max_x16(float v) { auto r = __builtin_amdgcn_permlane16_swap(__float_as_uint(v), __float_as_uint(v), false, false); return fmaxf(__uint_as_float(r[0]), __uint_as_float(r[1])); }
DI float max_x32(float v) { auto r = __builtin_amdgcn_permlane32_swap(__float_as_uint(v), __float_as_uint(v), false, false); return fmaxf(__uint_as_float(r[0]), __uint_as_float(r[1])); }
DI float sum_x16x32(float v) { return sum_x32(sum_x16(v)); }
DI float max_x16x32(float v) { return max_x32(max_x16(v)); }
DI float sum_row16(float v) { v += dpp_f<0xB1>(v); v += dpp_f<0x4E>(v); v += dpp_f<0x141>(v); v += dpp_f<0x140>(v); return v; }
DI float max_row16(float v) { v = fmaxf(v, dpp_f<0xB1>(v)); v = fmaxf(v, dpp_f<0x4E>(v)); v = fmaxf(v, dpp_f<0x141>(v)); v = fmaxf(v, dpp_f<0x140>(v)); return v; }
DI float sum_oct(float v) { v += dpp_f<0xB1>(v); v += dpp_f<0x4E>(v); v += dpp_f<0x141>(v); return v; }
DI float sum_quad(float v) { v += dpp_f<0xB1>(v); v += dpp_f<0x4E>(v); return v; }
template <int CTRL, int RMASK> DI float dpp_id(float idv, float v) { return __builtin_bit_cast(float, __builtin_amdgcn_update_dpp(__builtin_bit_cast(int, idv), __builtin_bit_cast(int, v), CTRL, RMASK, 0xF, false)); }
DI float scan_sum64(float v) { v += dpp_id<0x111, 0xF>(0.f, v); v += dpp_id<0x112, 0xF>(0.f, v); v += dpp_id<0x114, 0xF>(0.f, v); v += dpp_id<0x118, 0xF>(0.f, v); v += dpp_id<0x142, 0xA>(0.f, v); v += dpp_id<0x143, 0xC>(0.f, v); return v; }
DI float scan_max64(float v) { const float ni = -INFINITY; v = fmaxf(v, dpp_id<0x111, 0xF>(ni, v)); v = fmaxf(v, dpp_id<0x112, 0xF>(ni, v)); v = fmaxf(v, dpp_id<0x114, 0xF>(ni, v)); v = fmaxf(v, dpp_id<0x118, 0xF>(ni, v));
    v = fmaxf(v, dpp_id<0x142, 0xA>(ni, v)); v = fmaxf(v, dpp_id<0x143, 0xC>(ni, v)); return v; }
DI float wave_sum(float v) { return sum_x16x32(sum_row16(v)); }
DI float wave_max(float v) { return max_x16x32(max_row16(v)); }
DI float fast_exp(float x) { return __builtin_amdgcn_exp2f(x * 1.4426950408889634f); }
DI float fast_sigmoid(float x) { return __builtin_amdgcn_rcpf(1.0f + fast_exp(-x)); }
DI float gelu_tanh(float x) { const float u = 0.7978845608028654f * (x + 0.044715f * x * x * x); return x * fast_sigmoid(2.0f * u); }
DI float log_sigmoid(float x) { return fminf(x, 0.f) - __builtin_amdgcn_logf(1.0f + fast_exp(-fabsf(x))) * 0.6931471805599453f; }
DI int mod_row(int row) { return row < NCTX ? 16 : ((row - NCTX) >> 12); }

#define XB_TMO      128
#define XB_XCNT(j)  (256  + 64 * (j))
#define XB_XSUB(j)  (1280 + 64 * (j))
#define XB_XGEN(j)  (2304 + 64 * (j))
#define XB_TOP      3328
#define XB_TOPGEN   3392
#define XCD_BAR_WORDS 3456
#define XB_SPIN_CAP (1u << 22)
DI unsigned xb_ld(unsigned* p)              { return __hip_atomic_load(p, __ATOMIC_RELAXED, __HIP_MEMORY_SCOPE_AGENT); }
DI unsigned xb_add(unsigned* p, unsigned v) { return __hip_atomic_fetch_add(p, v, __ATOMIC_RELAXED, __HIP_MEMORY_SCOPE_AGENT); }
DI unsigned xb_xcc_id() { return (unsigned)__builtin_amdgcn_s_getreg((3 << 11) | 20) & 0xFu; }
#define XB_SPIN(cond, bar) do { unsigned _sp = 0; while (cond) { __builtin_amdgcn_s_sleep(1); \
    if ((++_sp & 255u) == 0u) { if (xb_ld(&(bar)[XB_TMO])) break; if (_sp > XB_SPIN_CAP) { atomicAdd(&(bar)[XB_TMO], 1u); break; } } } } while (0)
struct XcdBarrier { unsigned* bar; unsigned x; volatile LAS unsigned* st; };
DI XcdBarrier xcd_barrier_post(unsigned* bar, volatile LAS unsigned* st) {
    XcdBarrier b; b.bar = bar; b.x = xb_xcc_id(); b.st = st;
    if (threadIdx.x == 0) (void)xb_add(&bar[XB_XCNT(b.x)], 1u);
    return b;
}
DI void xcd_barrier_complete(unsigned* bar, unsigned x, unsigned& nloc, unsigned& nx) {
    const unsigned G = gridDim.x * gridDim.y * gridDim.z;
    unsigned sum, cnt, mine, sp = 0u;
    for (;;) {
        sum = 0u; cnt = 0u; mine = 0u;
#pragma unroll
        for (unsigned j = 0; j < 16; ++j) { const unsigned c = xb_ld(&bar[XB_XCNT(j)]); sum += c; cnt += (c > 0u) ? 1u : 0u; mine = (j == x) ? c : mine; }
        if (sum == G) break;
        __builtin_amdgcn_s_sleep(1);
        if ((++sp & 255u) == 0u) { if (xb_ld(&bar[XB_TMO])) break; if (sp > XB_SPIN_CAP) { atomicAdd(&bar[XB_TMO], 1u); break; } }
    }
    nloc = mine > 0u ? mine : 1u; nx = cnt > 0u ? cnt : 1u;
}
DI void xcd_barrier(const XcdBarrier& b) {
    asm volatile("s_waitcnt vmcnt(0)" ::: "memory");
    __syncthreads();
    if (threadIdx.x == 0) {
        unsigned* bar = b.bar;
        __builtin_amdgcn_s_waitcnt(0);
        unsigned nloc = b.st[0], nx = b.st[1];
        if (nloc == 0u) { xcd_barrier_complete(bar, b.x, nloc, nx); b.st[0] = nloc; b.st[1] = nx; }
        const unsigned old = xb_add(&bar[XB_XSUB(b.x)], 1u);
        const unsigned gen = old / nloc;
        if (old + 1u == (gen + 1u) * nloc) {
            __builtin_amdgcn_fence(__ATOMIC_RELEASE, "agent");
            asm volatile("s_waitcnt vmcnt(0)" ::: "memory");
            const unsigned og = xb_add(&bar[XB_TOP], 1u);
            const unsigned tg = og / nx;
            if (og + 1u == (tg + 1u) * nx) xb_add(&bar[XB_TOPGEN], 1u);
            else XB_SPIN(xb_ld(&bar[XB_TOPGEN]) == tg, bar);
            __builtin_amdgcn_fence(__ATOMIC_ACQUIRE, "agent");
            xb_add(&bar[XB_XGEN(b.x)], 1u);
            asm volatile("s_waitcnt vmcnt(0)" ::: "memory");
        } else {
            XB_SPIN(xb_ld(&bar[XB_XGEN(b.x)]) == gen, bar);
            __builtin_amdgcn_fence(__ATOMIC_ACQUIRE, "agent");
            asm volatile("s_waitcnt vmcnt(0)" ::: "memory");
        }
    }
    __syncthreads();
}

namespace pg8 {
constexpr int BM = 256, BK = 64, HALF = 128, HTB = HALF * BK * 2, STAGE_BYTES = 8 * HTB, NXCD = 8, WGM = 8;
DI int lds_byte(int r, int c) { const int st = (r >> 4) * 2 + (c >> 5), rr = r & 15, cc = c & 31, ob = rr * 64 + cc * 2; return st * 1024 + (ob ^ (((ob >> 9) & 1) << 5)); }
DI void stage_rc(int b, int& R, int& C) { const int st = b / 1024, sb = b % 1024, swz = sb ^ (((sb >> 9) & 1) << 5); R = (st >> 1) * 16 + swz / 64; C = (st & 1) * 32 + (swz % 64) / 2; }
struct Unit { int pm, pn, e; };
DI void glds_s(const char* sbase_, unsigned voff, unsigned lds_dst) { unsigned keep; const unsigned long long sbase = (unsigned long long)sbase_;
    asm volatile("s_mov_b32 %0, m0\n\ts_mov_b32 m0, %3\n\ts_nop 0\n\tglobal_load_lds_dwordx4 %1, %2\n\ts_mov_b32 m0, %0" : "=&s"(keep) : "v"(voff), "s"(sbase), "s"(lds_dst) : "memory"); }
struct TileOrder {
    int nM, nN, nwg, G, c, pm0;
    DI void init(int nM_, int nN_, int G_, int c_, int pm0_ = 0) { nM = nM_; nN = nN_; nwg = nM * nN; G = G_; c = c_; pm0 = pm0_; }
    DI bool next(int i, Unit& u) const {
        const long L = (long)i * G + c; if (L >= nwg) return false;
        int wgid = (int)L; { const int q = nwg / NXCD, r = nwg % NXCD, xcd = wgid % NXCD, off = wgid / NXCD; wgid = (xcd < r ? xcd * (q + 1) : r * (q + 1) + (xcd - r) * q) + off; }
        const int nig = WGM * nN, gid = wgid / nig, fm = gid * WGM, gsz = (nM - fm) < WGM ? (nM - fm) : WGM;
        u.pm = pm0 + fm + ((wgid % nig) % gsz); u.pn = (wgid % nig) / gsz; return true;
    }
};
typedef int i32x8 __attribute__((ext_vector_type(8)));
DI f32x4 mma1(bf16x8 a, bf16x8 b, f32x4 c) { return __builtin_amdgcn_mfma_f32_16x16x32_bf16(a, b, c, 0, 0, 0); }
DI i32x4 mma1(bf16x8 a, bf16x8 b, i32x4 c) { return __builtin_amdgcn_mfma_i32_16x16x64_i8(__builtin_bit_cast(i32x4, a), __builtin_bit_cast(i32x4, b), c, 0, 0, 0); }
DI i32x8 cat8(bf16x8 a0, bf16x8 a1) { const i32x4 x0 = __builtin_bit_cast(i32x4, a0), x1 = __builtin_bit_cast(i32x4, a1); return __builtin_shufflevector(x0, x1, 0, 1, 2, 3, 4, 5, 6, 7); }
DI f32x4 mma_f8(i32x8 a, i32x8 b, f32x4 c) { asm volatile("v_mfma_f32_16x16x128_f8f6f4 %0, %1, %2, %0" : "+v"(c) : "v"(a), "v"(b)); return c; }
template <int QM> struct AccT { typedef f32x4 type; };
template <> struct AccT<1> { typedef i32x4 type; };
template <class Epi, class Src, bool DUP = false, int QM = 0>
DI void gemm_phase(LAS unsigned char* lds, const bf16* Abase, const TileOrder& S, const Src& src, const Epi& E) {
    const int tid = opaque_tid(), wid = __builtin_amdgcn_readfirstlane(tid >> 6), lane = tid & 63, wr = wid >> 2, wc = wid & 3, fr = lane & 15, fq = lane >> 4;
    unsigned voffB[2];
    constexpr unsigned RPB = QM ? 1024u : 2048u;
    constexpr int NT = QM ? 8 : 16;
    typedef typename AccT<QM>::type acc_t;
#pragma unroll
    for (int i = 0; i < 2; ++i) { int R_, C_; stage_rc(tid * 16 + i * 8192, R_, C_); voffB[i] = (unsigned)R_ * RPB + (unsigned)C_ * 2u; }
    constexpr size_t kstep = (size_t)(BK * 2), hstep = (size_t)HALF * RPB;
    const unsigned ldsb = (unsigned)(uintptr_t)lds + (unsigned)wid * 1024u;
    const int aoff = lds_byte(wr * 64 + fr, fq * 8), boff = lds_byte(wc * 32 + fr, fq * 8);
    const LAS unsigned char* ldsA = lds + aoff; const LAS unsigned char* ldsB = lds + 4 * HTB + boff;
    asm volatile("" : "+v"(ldsA), "+v"(ldsB));
#define PG8_SA(b, h) (((b) * 2 + (h)) * HTB)
#define PG8_SB(b, h) ((4 + (b) * 2 + (h)) * HTB)
#define PG8_SBR(b, h) (((b) * 2 + (h)) * HTB)
#define PG8_STAGEB(bufoff, gbase) do { _Pragma("unroll") for (int _i = 0; _i < 2; ++_i) \
        glds_s((const char*)(gbase), voffB[_i], ldsb + (unsigned)((bufoff) + _i * 8192)); } while (0)
#define PG8_STAGEA(bufoff, arr, hf, koff) do { _Pragma("unroll") for (int _i = 0; _i < 2; ++_i) \
        glds_s((const char*)Abase + (koff) + (Src::GATHER ? (size_t)0 : (size_t)(hf) * hstep), (arr)[Src::GATHER ? (hf) : 0][_i], ldsb + (unsigned)((bufoff) + _i * 8192)); } while (0)
#define PG8_LDA(dst, b, h) do { _Pragma("unroll") for (int m = 0; m < 4; ++m) { if constexpr (QM == 2) dst##8[m] = cat8(*(const LAS bf16x8*)(ldsA + PG8_SA(b, h) + m * 2048), *(const LAS bf16x8*)(ldsA + PG8_SA(b, h) + m * 2048 + 1024)); \
        else { _Pragma("unroll") for (int k = 0; k < 2; ++k) dst[m][k] = *(const LAS bf16x8*)(ldsA + PG8_SA(b, h) + m * 2048 + k * 1024); } } } while (0)
#define PG8_LDB(dst, b, h) do { _Pragma("unroll") for (int n = 0; n < 2; ++n) { if constexpr (QM == 2) dst##8[n] = cat8(*(const LAS bf16x8*)(ldsB + PG8_SBR(b, h) + n * 2048), *(const LAS bf16x8*)(ldsB + PG8_SBR(b, h) + n * 2048 + 1024)); \
        else { _Pragma("unroll") for (int k = 0; k < 2; ++k) dst[n][k] = *(const LAS bf16x8*)(ldsB + PG8_SBR(b, h) + n * 2048 + k * 1024); } } } while (0)
#define PG8_MMA(ai, bj, At, Bt) do { __builtin_amdgcn_s_setprio(1); _Pragma("unroll") for (int m = 0; m < 4; ++m) _Pragma("unroll") for (int n = 0; n < 2; ++n) { \
        if constexpr (QM == 2) acc[ai][bj][m][n] = mma_f8(Bt##8[n], At##8[m], acc[ai][bj][m][n]); \
        else { _Pragma("unroll") for (int k = 0; k < 2; ++k) acc[ai][bj][m][n] = mma1(Bt[n][k], At[m][k], acc[ai][bj][m][n]); } } __builtin_amdgcn_s_setprio(0); } while (0)
#define PG8_WAIT_V(n) asm volatile("s_waitcnt vmcnt(" #n ")" ::: "memory")
#define PG8_WAIT_L(n) asm volatile("s_waitcnt lgkmcnt(" #n ")" ::: "memory")
#define PG8_BAR __builtin_amdgcn_s_barrier()
#define PG8_SCHED __builtin_amdgcn_sched_barrier(0)
#define PG8_OFFS(dst, u) do { _Pragma("unroll") for (int _i = 0; _i < 2; ++_i) { int R_, C_; stage_rc(tid * 16 + _i * 8192, R_, C_); _Pragma("unroll") for (int _h = 0; _h < NH; ++_h) \
        dst[_h][_i] = (unsigned)src.arow(u, _h * HALF + R_) * RPB + (unsigned)C_ * 2u; } } while (0)
    Unit cur, nxt; int ui = 0;
    if (!S.next(0, cur)) return;
    LAS unsigned char* xtab = lds + STAGE_BYTES;
    const unsigned xtabb = (unsigned)(uintptr_t)lds + (unsigned)STAGE_BYTES;
#define PG8_IDXDMA(u, buf) do { if (wid == 0) glds_s(src.idx_base(), (unsigned)((u).pm * 1024 + lane * 16), xtabb + (unsigned)(buf) * 1024u); } while (0)
#define PG8_OFFS_LDS(dst, buf) do { _Pragma("unroll") for (int _i = 0; _i < 2; ++_i) { int R_, C_; stage_rc(tid * 16 + _i * 8192, R_, C_); _Pragma("unroll") for (int _h = 0; _h < 2; ++_h) \
        dst[_h][_i] = (unsigned)(*(const LAS int*)(xtab + (buf) * 1024 + (_h * HALF + R_) * 4)) * RPB + (unsigned)C_ * 2u; } } while (0)
#define PG8_EXPERT(u) (Src::EXPERT ? __builtin_amdgcn_readfirstlane((int)*(const LAS unsigned char*)(xtab + 2048 + (u).pm)) : 0)
    if constexpr (Src::EXPERT) {
        if (wid < 2) glds_s(src.rteb_base(), (unsigned)(wid * 1024 + lane * 16), xtabb + 2048u + (unsigned)wid * 1024u);
        if constexpr (Src::GATHER) { PG8_IDXDMA(cur, 0); Unit u1_; if (S.next(1, u1_)) PG8_IDXDMA(u1_, 1); }
        asm volatile("s_waitcnt vmcnt(0)" ::: "memory"); __builtin_amdgcn_s_barrier(); asm volatile("" ::: "memory");
    }
    cur.e = PG8_EXPERT(cur);
    const LAS unsigned char* etab = lds + LDSCTL_OFF + 4096; const unsigned etabb = (unsigned)(uintptr_t)lds + (unsigned)(LDSCTL_OFF + 4096);
#define PG8_ETAB(u, par) do { if constexpr (Epi::NTAB > 0) { if (wid >= 1 && wid <= Epi::NTAB) glds_s(E.tab(wid - 1, u), (unsigned)(lane * 16), etabb + (unsigned)(par) * 3072u + (unsigned)(wid - 1) * 1024u); } } while (0)
    acc_t acc[2][2][4][2];
#pragma unroll
    for (int a = 0; a < 2; ++a)
#pragma unroll
        for (int b = 0; b < 2; ++b)
#pragma unroll
            for (int m = 0; m < 4; ++m)
#pragma unroll
                for (int n = 0; n < 2; ++n) acc[a][b][m][n] = (acc_t){0, 0, 0, 0};
    bf16x8 At[4][2], B0[2][2], B1[2][2]; i32x8 At8[4], B08[2], B18[2];
    constexpr int NH = Src::GATHER ? 2 : 1;
    unsigned oA[NH][2], nO[NH][2];
    if constexpr (Src::GATHER) { PG8_OFFS_LDS(oA, 0); } else { PG8_OFFS(oA, cur); }
    const char* cB = src.bt(cur);
#define PG8_KOF(r, t) ((size_t)((((t) + (r)) & (NT - 1))) * kstep)
    int rc = (cur.pm + cur.pn) & (NT - 1), rn = rc;
    PG8_STAGEB(PG8_SB(0, 0), cB + PG8_KOF(rc, 0)); PG8_STAGEB(PG8_SB(0, 1), cB + hstep + PG8_KOF(rc, 0)); PG8_STAGEA(PG8_SA(0, 0), oA, 0, PG8_KOF(rc, 0)); PG8_STAGEA(PG8_SA(0, 1), oA, 1, PG8_KOF(rc, 0));
    if (wr == 1) PG8_BAR;
    PG8_WAIT_V(2); PG8_BAR;
    PG8_STAGEB(PG8_SB(1, 0), cB + PG8_KOF(rc, 1)); PG8_STAGEA(PG8_SA(1, 0), oA, 0, PG8_KOF(rc, 1)); PG8_STAGEB(PG8_SB(1, 1), cB + hstep + PG8_KOF(rc, 1));
    PG8_WAIT_V(6); PG8_BAR;
    for (;;) {
        const bool has_next = S.next(DUP ? ((ui + 1) >> 1) : (ui + 1), nxt);
        const char* nB = cB; rn = has_next ? ((nxt.pm + nxt.pn) & (NT - 1)) : rc;
        if (has_next) { nxt.e = PG8_EXPERT(nxt); if constexpr (Src::GATHER) { PG8_OFFS_LDS(nO, (ui + 1) & 1); } else { PG8_OFFS(nO, nxt); } nB = src.bt(nxt); }
        else {
#pragma unroll
            for (int h = 0; h < NH; ++h)
#pragma unroll
                for (int i = 0; i < 2; ++i) nO[h][i] = oA[h][i];
        }
        if constexpr (Src::GATHER) { Unit u2_; if (S.next(ui + 2, u2_)) PG8_IDXDMA(u2_, ui & 1); }
        PG8_ETAB(cur, ui & 1);
#pragma unroll 1
        for (int t = 0; t < NT; t += 2) {
            const bool last = (t == NT - 2);
            const size_t k1 = PG8_KOF(rc, t + 1), k2 = last ? PG8_KOF(rn, 0) : PG8_KOF(rc, t + 2), k3 = last ? PG8_KOF(rn, 1) : PG8_KOF(rc, t + 3);
            unsigned sx[NH][2];
#pragma unroll
            for (int h = 0; h < NH; ++h)
#pragma unroll
                for (int i = 0; i < 2; ++i) sx[h][i] = last ? nO[h][i] : oA[h][i];
            const char* b2 = (last ? nB : cB) + k2; const char* b3 = (last ? nB : cB) + k3;
            PG8_LDB(B0, 0, 0); PG8_LDB(B1, 0, 1); PG8_SCHED; PG8_LDA(At, 0, 0); PG8_STAGEA(PG8_SA(1, 1), oA, 1, k1);
            PG8_WAIT_V(8); PG8_WAIT_L(0); PG8_BAR; PG8_MMA(0, 0, At, B0); PG8_MMA(0, 1, At, B1); PG8_BAR; PG8_SCHED;
            PG8_LDA(At, 0, 1); PG8_STAGEB(PG8_SB(0, 0), b2); PG8_STAGEB(PG8_SB(0, 1), b2 + hstep); PG8_STAGEA(PG8_SA(0, 0), sx, 0, k2);
            PG8_WAIT_V(8); PG8_WAIT_L(0); PG8_BAR; PG8_MMA(1, 0, At, B0); PG8_MMA(1, 1, At, B1); PG8_BAR; PG8_SCHED;
            PG8_LDB(B0, 1, 0); PG8_LDB(B1, 1, 1); PG8_SCHED; PG8_LDA(At, 1, 0); PG8_STAGEA(PG8_SA(0, 1), sx, 1, k2);
            PG8_WAIT_V(8); PG8_WAIT_L(0); PG8_BAR; PG8_MMA(0, 0, At, B0); PG8_MMA(0, 1, At, B1); PG8_BAR; PG8_SCHED;
            PG8_LDA(At, 1, 1); PG8_STAGEB(PG8_SB(1, 0), b3); PG8_STAGEB(PG8_SB(1, 1), b3 + hstep); PG8_STAGEA(PG8_SA(1, 0), sx, 0, k3);
            PG8_WAIT_V(8); PG8_WAIT_L(0); PG8_BAR; PG8_MMA(1, 0, At, B0); PG8_MMA(1, 1, At, B1); PG8_BAR; PG8_SCHED;
        }
        if (wr == 0) PG8_BAR;
        if constexpr (QM == 2) asm volatile("s_nop 15\n\ts_nop 15" ::: "memory");
        if (!DUP || (ui & 1)) {
            if (DUP) {
#pragma unroll
                for (int a = 0; a < 2; ++a)
#pragma unroll
                    for (int b = 0; b < 2; ++b)
#pragma unroll
                        for (int m = 0; m < 4; ++m)
#pragma unroll
                            for (int n = 0; n < 2; ++n) acc[a][b][m][n] = acc[a][b][m][n] / 2;
            }
            E(acc, cur, wr, wc, fr, fq, etab + (ui & 1) * 3072);
        }
        if (!has_next) break;
        if (!DUP || (ui & 1)) {
#pragma unroll
        for (int a = 0; a < 2; ++a)
#pragma unroll
            for (int b = 0; b < 2; ++b)
#pragma unroll
                for (int m = 0; m < 4; ++m)
#pragma unroll
                    for (int n = 0; n < 2; ++n) acc[a][b][m][n] = (acc_t){0, 0, 0, 0};
        }
        cur = nxt; cB = nB; rc = rn; ++ui;
#pragma unroll
        for (int h = 0; h < NH; ++h)
#pragma unroll
            for (int i = 0; i < 2; ++i) oA[h][i] = nO[h][i];
        if (wr == 1) PG8_BAR;
    }
    PG8_WAIT_V(0);
    PG8_BAR;
#undef PG8_SA
#undef PG8_SB
#undef PG8_KOF
#undef PG8_SBR
#undef PG8_STAGEA
#undef PG8_STAGEB
#undef PG8_LDA
#undef PG8_LDB
#undef PG8_MMA
#undef PG8_WAIT_V
#undef PG8_WAIT_L
#undef PG8_BAR
#undef PG8_SCHED
#undef PG8_OFFS
#undef PG8_IDXDMA
#undef PG8_ETAB
#undef PG8_OFFS_LDS
#undef PG8_EXPERT
}
}

struct In { const float *x, *c, *ctx, *c_ctx, *w_ada, *b_ada, *w_in, *b_in, *q_norm, *k_norm, *gmlp_norm, *gmlp_ws, *gmlp_b, *mix_norm, *w_out, *router_w, *router_b, *w_gate_up, *b_gate_up, *w_down, *b_down, *final_norm; };
struct Args { In in; float* out; unsigned char* ws; int ph_lo, ph_hi; };
typedef const __attribute__((address_space(4))) Args* KArgP;
DI KArgP kargs() { KArgP p = (KArgP)__builtin_amdgcn_kernarg_segment_ptr(); asm volatile("" : "+s"(p)); return p; }

constexpr size_t TSTEP = (size_t)256 * D * 2;
template <size_t TS> struct SrcPlainT { static constexpr bool GATHER = false, EXPERT = false; const char* Bt;
    DI const char* idx_base() const { return nullptr; } DI const char* rteb_base() const { return nullptr; }
    DI int arow(const pg8::Unit& u, int r) const { return u.pm * 256 + r; }
    DI int expert(const pg8::Unit&) const { return 0; }
    DI const char* bt(const pg8::Unit& u) const { return Bt + (size_t)u.pn * TS; } };
typedef SrcPlainT<TSTEP> SrcPlain; typedef SrcPlainT<TSTEP / 2> SrcPlain8;
struct SrcMoeGather { static constexpr bool GATHER = true, EXPERT = true; unsigned char* ws; int l;
    DI const char* idx_base() const { return (const char*)(ws + WS_SLTOK); } DI const char* rteb_base() const { return (const char*)(ws + WS_RTEB); }
    DI int arow(const pg8::Unit& u, int r) const { return ((const int*)(ws + WS_SLTOK))[u.pm * 256 + r]; }
    DI int expert(const pg8::Unit& u) const { return __builtin_amdgcn_readfirstlane(((const int*)(ws + WS_RTE))[32 + u.pm]); }
    DI const char* bt(const pg8::Unit& u) const { return (const char*)(ws + WS_WGU) + ((size_t)(l * NE + u.e) * 8 + (size_t)u.pn) * (TSTEP / 2); } };
struct SrcMoePlain { static constexpr bool GATHER = false, EXPERT = true; unsigned char* ws; int l;
    DI const char* idx_base() const { return nullptr; } DI const char* rteb_base() const { return (const char*)(ws + WS_RTEB); }
    DI int arow(const pg8::Unit& u, int r) const { return u.pm * 256 + r; }
    DI int expert(const pg8::Unit& u) const { return __builtin_amdgcn_readfirstlane(((const int*)(ws + WS_RTE))[32 + u.pm]); }
    DI const char* bt(const pg8::Unit& u) const { return (const char*)(ws + WS_WDN) + ((size_t)(l * NE + u.e) * 4 + (size_t)u.pn) * (TSTEP / 2); } };

struct EpiInProj {
    unsigned char* ws; int l; const LAS float* rl;
    static constexpr int NTAB = 3;
    DI const char* tab(int k, const pg8::Unit& u) const {
        const char* t0 = (const char*)(kargs()->in.b_in + (size_t)l * DIN + (size_t)u.pn * 256 + (u.pn >= 4 ? 16 : 0));
        const char* t1 = (const char*)((const float*)(ws + WS_CSIN) + (size_t)l * NPROJ + (size_t)u.pn * 256);
        const char* t2 = (const char*)((const float*)(ws + WS_HS) + (size_t)u.pm * 256);
        return k == 0 ? t0 : (k == 1 ? t1 : t2); }
    DI void operator()(const i32x4 (&acc)[2][2][4][2], const pg8::Unit& u, int wr, int wc, int fr, int fq, const LAS unsigned char* et) const {
        const KArgP ka = kargs();
        const LAS float* bias = (const LAS float*)et;
        const LAS float* csp = (const LAS float*)(et + 1024) + 32 * wc + 4 * fq;
        const LAS float* hs = (const LAS float*)(et + 2048);
        f32x4 cs[2][2];
#pragma unroll
        for (int bj = 0; bj < 2; ++bj)
#pragma unroll
            for (int n = 0; n < 2; ++n) cs[bj][n] = *(const LAS f32x4*)(csp + 128 * bj + 16 * n);
        const int hh = u.pn * 4 + wc;
        const int lcol0 = hh * 64 + 8 * fq, ocol0 = lcol0 + (lcol0 >= 1024 ? 16 : 0);
        f32x4 bv[2][2];
#pragma unroll
        for (int bj = 0; bj < 2; ++bj)
#pragma unroll
            for (int n = 0; n < 2; ++n) bv[bj][n] = *(const LAS f32x4*)(bias + 64 * wc + 8 * fq + 32 * bj + 4 * n);
        const bool latent = u.pm >= 16;
        int op; bf16* base; int pitch, colb; bool kv = false;
        if (hh < 24) { const int ty = hh >> 2; op = (ty == 1) ? 1 : (ty == 3) ? 2 : (ty >= 4) ? 3 : 0;
            base = (bf16*)(ws + ((ty == 0) ? WS_MQ : (ty == 1) ? WS_MK : (ty == 2) ? WS_MV : (ty == 3) ? WS_MO : (ty == 4) ? WS_GU : WS_GV)); pitch = 256; colb = (hh & 3) * 64; }
        else if (hh < 32) { op = 4; base = (bf16*)(ws + WS_AQ); pitch = 512; colb = (hh - 24) * 64; }
        else { op = (hh < 34) ? 5 : 0; base = (bf16*)(ws + ((hh < 34) ? WS_AK : WS_AV)); pitch = 64; colb = 0; kv = true; }
        const int kvh = hh & 1;
        float rscs[2][4];
#pragma unroll
        for (int ai = 0; ai < 2; ++ai)
#pragma unroll
            for (int m = 0; m < 4; ++m) rscs[ai][m] = hs[ai * 128 + wr * 64 + m * 16 + fr];
        f32x4 xf[2][2][4][2];
#pragma unroll
        for (int ai = 0; ai < 2; ++ai)
#pragma unroll
            for (int m = 0; m < 4; ++m)
#pragma unroll
                for (int bj = 0; bj < 2; ++bj)
#pragma unroll
                    for (int n = 0; n < 2; ++n)
#pragma unroll
                        for (int j = 0; j < 4; ++j) xf[ai][bj][m][n][j] = (float)acc[ai][bj][m][n][j] * (rscs[ai][m] * cs[bj][n][j]) + bv[bj][n][j];
        asm volatile("" ::: "memory");
        f32x4 gn[2][2];
        if (op >= 4) { const LAS float* g = rl + 2080 + ((op == 4) ? 0 : 64);
#pragma unroll
            for (int bj = 0; bj < 2; ++bj)
#pragma unroll
                for (int n = 0; n < 2; ++n) gn[bj][n] = *(const LAS f32x4*)(g + 32 * bj + 8 * fq + 4 * n); }
#pragma unroll
        for (int ai = 0; ai < 2; ++ai)
#pragma unroll
            for (int m = 0; m < 4; ++m) {
                const int row = u.pm * 256 + ai * 128 + wr * 64 + m * 16 + fr;
                f32x4 v[2][2];
#pragma unroll
                for (int bj = 0; bj < 2; ++bj)
#pragma unroll
                    for (int n = 0; n < 2; ++n) v[bj][n] = xf[ai][bj][m][n];
                if (op == 1) {
#pragma unroll
                    for (int bj = 0; bj < 2; ++bj)
#pragma unroll
                        for (int n = 0; n < 2; ++n) v[bj][n] = v[bj][n] * 0.125f;
                } else if (op == 2) {
#pragma unroll
                    for (int bj = 0; bj < 2; ++bj)
#pragma unroll
                        for (int n = 0; n < 2; ++n)
#pragma unroll
                            for (int j = 0; j < 4; ++j) v[bj][n][j] = fast_sigmoid(v[bj][n][j]);
                } else if (op == 3) {
#pragma unroll
                    for (int bj = 0; bj < 2; ++bj)
#pragma unroll
                        for (int n = 0; n < 2; ++n)
#pragma unroll
                            for (int j = 0; j < 4; ++j) v[bj][n][j] = gelu_tanh(v[bj][n][j]);
                } else if (op >= 4) {
                    float ss = 0.f;
#pragma unroll
                    for (int bj = 0; bj < 2; ++bj)
#pragma unroll
                        for (int n = 0; n < 2; ++n) ss += (v[bj][n][0] * v[bj][n][0] + v[bj][n][1] * v[bj][n][1]) + (v[bj][n][2] * v[bj][n][2] + v[bj][n][3] * v[bj][n][3]);
                    ss = sum_x16x32(ss);
                    const float rs = __builtin_amdgcn_rsqf(ss * (1.0f / 64.0f) + EPS);
#pragma unroll
                    for (int bj = 0; bj < 2; ++bj)
#pragma unroll
                        for (int n = 0; n < 2; ++n) v[bj][n] = v[bj][n] * rs * gn[bj][n];
                    { const int t = (row - NCTX) & (T - 1); const int pos = latent ? ((fq < 2) ? (t >> 6) : (t & 63)) : 64;
                        const LAS float* rp = rl + pos * 16 + 8 * (fq & 1);
#pragma unroll
                        for (int n = 0; n < 2; ++n) { const f32x4 c = *(const LAS f32x4*)(rp + 4 * n), s = *(const LAS f32x4*)(rp + 1040 + 4 * n);
                            const f32x4 x1 = v[0][n], x2 = v[1][n]; v[0][n] = x1 * c - x2 * s; v[1][n] = x2 * c + x1 * s; } }
                    if (op == 4) {
#pragma unroll
                        for (int bj = 0; bj < 2; ++bj)
#pragma unroll
                            for (int n = 0; n < 2; ++n) v[bj][n] = v[bj][n] * C2; }
                }
                size_t drow;
                if (kv) { int b, p; if (latent) { const int r2 = row - NCTX; b = r2 >> 12; p = TC + (r2 & (T - 1)); } else { b = row >> 8; p = row & 255; }
                    drow = (size_t)((b * 2 + kvh) * TKV + p); }
                else drow = (size_t)row;
                if (op >= 4) {
                    unsigned char* dp8 = (unsigned char*)base + drow * pitch + colb + 8 * fq;
#pragma unroll
                    for (int bj = 0; bj < 2; ++bj) { u32x2 w; w.x = pk_fp8x4(v[bj][0][0], v[bj][0][1], v[bj][0][2], v[bj][0][3]); w.y = pk_fp8x4(v[bj][1][0], v[bj][1][1], v[bj][1][2], v[bj][1][3]);
                        *(u32x2*)(dp8 + 32 * bj) = w; }
                } else {
                bf16* dp = base + drow * pitch + colb + 8 * fq;
#pragma unroll
                for (int bj = 0; bj < 2; ++bj) { u32x4 w; w.x = pk2(v[bj][0][0], v[bj][0][1]); w.y = pk2(v[bj][0][2], v[bj][0][3]); w.z = pk2(v[bj][1][0], v[bj][1][1]); w.w = pk2(v[bj][1][2], v[bj][1][3]);
                    *(u32x4*)(dp + 32 * bj) = w; }
                }
                asm volatile("" ::: "memory");
            }
    }
};
struct EpiOutProj {
    unsigned char* ws; int l;
    static constexpr int NTAB = 2;
    DI const char* tab(int k, const pg8::Unit& u) const { const int mrow = u.pm < 16 ? 16 : ((u.pm - 16) >> 4);
        const char* t0 = (const char*)((const float*)(ws + WS_MOD) + (size_t)l * 17 * 6144 + (size_t)mrow * 6 * D + 2 * D + (size_t)u.pn * 256);
        const char* t1 = (const char*)((const float*)(ws + WS_CSOUT) + (size_t)l * D + (size_t)u.pn * 256);
        return k == 0 ? t0 : t1; }
    DI void operator()(const i32x4 (&acc)[2][2][4][2], const pg8::Unit& u, int wr, int wc, int fr, int fq, const LAS unsigned char* et) const {
        GAS signed char* dout = (GAS signed char*)(ws + WS_H); GAS float* dsc = (GAS float*)(ws + WS_DSC);
        const int c0 = u.pn * 256 + 64 * wc + 8 * fq;
        const LAS float* g1 = (const LAS float*)et + 64 * wc + 8 * fq;
        f32x4 gv[2][2];
#pragma unroll
        for (int bj = 0; bj < 2; ++bj)
#pragma unroll
            for (int n = 0; n < 2; ++n) gv[bj][n] = *(const LAS f32x4*)(g1 + 32 * bj + 4 * n) * *(const LAS f32x4*)((const LAS float*)(et + 1024) + 32 * wc + 4 * fq + 128 * bj + 16 * n) * (1.0f / YS);
#pragma unroll
        for (int ai = 0; ai < 2; ++ai)
#pragma unroll
            for (int m = 0; m < 4; ++m) { const size_t row = (size_t)(u.pm * 256 + ai * 128 + wr * 64 + m * 16 + fr);
                f32x4 v[2][2]; float am = 0.f;
#pragma unroll
                for (int bj = 0; bj < 2; ++bj)
#pragma unroll
                    for (int n = 0; n < 2; ++n) { v[bj][n] = gv[bj][n] * (f32x4){(float)acc[ai][bj][m][n][0], (float)acc[ai][bj][m][n][1], (float)acc[ai][bj][m][n][2], (float)acc[ai][bj][m][n][3]};
                        am = fmaxf(am, fmaxf(fmaxf(fabsf(v[bj][n][0]), fabsf(v[bj][n][1])), fmaxf(fabsf(v[bj][n][2]), fabsf(v[bj][n][3])))); }
                am = max_x16x32(am);
                const float qs = 127.0f / fmaxf(am, 1e-30f);
#pragma unroll
                for (int bj = 0; bj < 2; ++bj) { u32x2 w;
#pragma unroll
                    for (int n = 0; n < 2; ++n) { const int q0 = (int)rintf(v[bj][n][0] * qs), q1 = (int)rintf(v[bj][n][1] * qs), q2 = (int)rintf(v[bj][n][2] * qs), q3 = (int)rintf(v[bj][n][3] * qs);
                        w[n] = (unsigned)(q0 & 255) | ((unsigned)(q1 & 255) << 8) | ((unsigned)(q2 & 255) << 16) | ((unsigned)(q3 & 255) << 24); }
                    *(GAS u32x2*)(dout + row * D + c0 + 32 * bj) = w; }
                if (fq == 0) dsc[row * 16 + u.pn * 4 + wc] = am * (1.0f / 127.0f); }
    }
};
struct EpiGateUp {
    unsigned char* ws; int l;
    static constexpr int NTAB = 3;
    DI const char* tab(int k, const pg8::Unit& u) const {
        const char* t0 = (const char*)(kargs()->in.b_gate_up + ((size_t)(l * NE + u.e) * 2 * DFF + (size_t)u.pn * 256));
        const char* t1 = (const char*)((const float*)(ws + WS_CSGU) + ((size_t)(l * NE + u.e) * 2 * DFF + (size_t)u.pn * 256));
        const char* t2 = (const char*)((const float*)(ws + WS_SLS) + (size_t)u.pm * 256);
        return k == 0 ? t0 : (k == 1 ? t1 : t2); }
    DI void operator()(const i32x4 (&acc)[2][2][4][2], const pg8::Unit& u, int wr, int wc, int fr, int fq, const LAS unsigned char* et) const {
        GAS unsigned char* act = (GAS unsigned char*)(ws + WS_ACT);
        const int f0 = u.pn * 128 + 32 * wc + 8 * fq;
        const LAS float* bp = (const LAS float*)et + 2 * (32 * wc + 8 * fq);
        const LAS float* csp = (const LAS float*)(et + 1024) + 32 * wc + 4 * fq;
        const LAS float* sls = (const LAS float*)(et + 2048);
        f32x4 bb[2][2], cs[2][2];
#pragma unroll
        for (int bj = 0; bj < 2; ++bj) { bb[bj][0] = *(const LAS f32x4*)(bp + 8 * bj); bb[bj][1] = *(const LAS f32x4*)(bp + 8 * bj + 4);
            cs[bj][0] = *(const LAS f32x4*)(csp + 128 * bj); cs[bj][1] = *(const LAS f32x4*)(csp + 128 * bj + 16); }
        float rss[2][4];
#pragma unroll
        for (int ai = 0; ai < 2; ++ai)
#pragma unroll
            for (int m = 0; m < 4; ++m) rss[ai][m] = sls[ai * 128 + wr * 64 + m * 16 + fr];
        constexpr float KE = -1.702f * 1.4426950408889634f;
#pragma unroll
        for (int ai = 0; ai < 2; ++ai)
#pragma unroll
            for (int m = 0; m < 4; ++m) { const size_t srow = (size_t)(u.pm * 256 + ai * 128 + wr * 64 + m * 16 + fr); const float rs = rss[ai][m];
                f32x2 av[2][2];
#pragma unroll
                for (int bj = 0; bj < 2; ++bj)
#pragma unroll
                    for (int jp = 0; jp < 2; ++jp) {
                        const f32x2 g = {(float)acc[ai][bj][m][0][2 * jp], (float)acc[ai][bj][m][0][2 * jp + 1]}, lv = {(float)acc[ai][bj][m][1][2 * jp], (float)acc[ai][bj][m][1][2 * jp + 1]};
                        const f32x2 sg = (f32x2){cs[bj][0][2 * jp], cs[bj][0][2 * jp + 1]} * rs, sl = (f32x2){cs[bj][1][2 * jp], cs[bj][1][2 * jp + 1]} * rs;
                        const f32x2 bg = {bb[bj][jp][0], bb[bj][jp][2]}, bl = {bb[bj][jp][1], bb[bj][jp][3]};
                        const f32x2 xg = __builtin_elementwise_min(g * sg + bg, (f32x2){7.0f, 7.0f});
                        const f32x2 xl = __builtin_elementwise_min(__builtin_elementwise_max(lv * sl + bl, (f32x2){-7.0f, -7.0f}), (f32x2){7.0f, 7.0f});
                        const f32x2 z = xg * KE; f32x2 ex; ex.x = __builtin_amdgcn_exp2f(z.x); ex.y = __builtin_amdgcn_exp2f(z.y);
                        const f32x2 dn = ex + 1.0f; f32x2 sig; sig.x = __builtin_amdgcn_rcpf(dn.x); sig.y = __builtin_amdgcn_rcpf(dn.y);
                        av[bj][jp] = (xg * sig) * (xl * 4.0f + 4.0f); }
                u32x2 w; w.x = pk_fp8x4_nc(av[0][0].x, av[0][0].y, av[0][1].x, av[0][1].y); w.y = pk_fp8x4_nc(av[1][0].x, av[1][0].y, av[1][1].x, av[1][1].y);
                *(GAS u32x2*)(act + srow * DFF + f0) = w; }
    }
};
struct EpiDown {
    unsigned char* ws; int l;
    static constexpr int NTAB = 2;
    DI const char* tab(int k, const pg8::Unit& u) const {
        const char* t0 = (const char*)(kargs()->in.b_down + ((size_t)(l * NE + u.e) * D + (size_t)u.pn * 256));
        const char* t1 = (const char*)((const float*)(ws + WS_SLG) + (size_t)u.pm * 256);
        return k == 0 ? t0 : t1; }
    DI void operator()(const f32x4 (&acc)[2][2][4][2], const pg8::Unit& u, int wr, int wc, int fr, int fq, const LAS unsigned char* et) const {
        GAS signed char* mout = (GAS signed char*)(ws + WS_MOUT); GAS float* msc = (GAS float*)(ws + WS_MSC);
        const int c0 = u.pn * 256 + 64 * wc + 8 * fq;
        const LAS float* bp = (const LAS float*)et + 64 * wc + 8 * fq; const LAS float* slg = (const LAS float*)(et + 1024);
        f32x4 bv[2][2];
#pragma unroll
        for (int bj = 0; bj < 2; ++bj)
#pragma unroll
            for (int n = 0; n < 2; ++n) bv[bj][n] = *(const LAS f32x4*)(bp + 32 * bj + 4 * n);
        float gts[2][4];
#pragma unroll
        for (int ai = 0; ai < 2; ++ai)
#pragma unroll
            for (int m = 0; m < 4; ++m) gts[ai][m] = slg[ai * 128 + wr * 64 + m * 16 + fr];
#pragma unroll
        for (int ai = 0; ai < 2; ++ai)
#pragma unroll
            for (int m = 0; m < 4; ++m) { const size_t srow = (size_t)(u.pm * 256 + ai * 128 + wr * 64 + m * 16 + fr); const float gt = gts[ai][m], g256 = gt * (1.0f / 256.0f);
                f32x4 v[2][2]; float am = 0.f;
#pragma unroll
                for (int bj = 0; bj < 2; ++bj)
#pragma unroll
                    for (int n = 0; n < 2; ++n) { v[bj][n] = acc[ai][bj][m][n] * g256 + bv[bj][n] * gt;
                        am = fmaxf(am, fmaxf(fmaxf(fabsf(v[bj][n][0]), fabsf(v[bj][n][1])), fmaxf(fabsf(v[bj][n][2]), fabsf(v[bj][n][3])))); }
                am = max_x16x32(am);
                const float qs = 127.0f / fmaxf(am, 1e-30f);
#pragma unroll
                for (int bj = 0; bj < 2; ++bj) { u32x2 w;
#pragma unroll
                    for (int n = 0; n < 2; ++n) { const int q0 = (int)rintf(v[bj][n][0] * qs), q1 = (int)rintf(v[bj][n][1] * qs), q2 = (int)rintf(v[bj][n][2] * qs), q3 = (int)rintf(v[bj][n][3] * qs);
                        w[n] = (unsigned)(q0 & 255) | ((unsigned)(q1 & 255) << 8) | ((unsigned)(q2 & 255) << 16) | ((unsigned)(q3 & 255) << 24); }
                    *(GAS u32x2*)(mout + srow * D + c0 + 32 * bj) = w; }
                if (fq == 0) msc[srow * 16 + u.pn * 4 + wc] = am * (1.0f / 127.0f); }
    }
};

struct NormArgs {
    const float* xin; const float* x0; const float* ctx0;
    const bf16* delta; const float* dsc;
    const bf16* mout; const float* msc; const int* toks; const float* g2mod;
    const float* mod; int shi, sci;
    float* xout; bf16* hout; signed char* h8; float* hs;
    const bf16* wsm; const float* sbias;
    float* mg;
    int* toke; float* tokg; int* ghist; int* bhist;
    const float* fnorm; float* out;
    int gs;
};
template <int MODE>
DI void norm_phase(LAS unsigned char* lds, const NormArgs& a) {
    constexpr int NS = (MODE == 0) ? 16 : 32, NBK = NS / 16, TP = 2064, RP = 36;
    const int tid = opaque_tid(), wid = __builtin_amdgcn_readfirstlane(tid >> 6), lane = tid & 63, fr = lane & 15, fq = lane >> 4;
    const GAS float* gxin = (const GAS float*)a.xin; const GAS float* gx0 = (const GAS float*)a.x0; const GAS float* gctx0 = (const GAS float*)a.ctx0; const GAS bf16* gdelta = (const GAS bf16*)a.delta;
    const GAS float* gdsc = (const GAS float*)a.dsc; const GAS float* gmsc = (const GAS float*)a.msc; const GAS bf16* gmout = (const GAS bf16*)a.mout; const GAS int* gtoks = (const GAS int*)a.toks; const GAS float* gg2mod = (const GAS float*)a.g2mod; const GAS float* gmod = (const GAS float*)a.mod;
    GAS float* gxout = (GAS float*)a.xout; GAS signed char* gh8 = (GAS signed char*)a.h8; GAS float* ghs = (GAS float*)a.hs; const GAS float* gfnorm = (const GAS float*)a.fnorm; GAS float* gout = (GAS float*)a.out;
    LAS unsigned char* Thi = lds; LAS unsigned char* Tlo = lds + 16 * TP;
    LAS float* red = (LAS float*)(lds + 2 * 16 * TP);
    LAS int* hist = (LAS int*)(lds + 2 * 16 * TP + 8 * 16 * RP * 4);
    const int G = gridDim.x, bid = opaque_bid(), per = (NGRP - a.gs + G - 1) / G, g0 = a.gs + bid * per, g1 = (g0 + per < NGRP) ? g0 + per : NGRP;
    bf16x8 Bh[4][NBK], Bl[4][NBK];
    if (MODE == 1) {
#pragma unroll
        for (int s = 0; s < 4; ++s)
#pragma unroll
            for (int nb = 0; nb < NBK; ++nb) { const size_t o = (size_t)(nb * 16 + fr) * D + 128 * wid + 32 * s + 8 * fq;
                Bh[s][nb] = *(const bf16x8*)(a.wsm + o); Bl[s][nb] = *(const bf16x8*)(a.wsm + (size_t)NS * D + o); }
    }
    int blk = 0;
    if (MODE == 1) { if (tid < 32) hist[tid] = 0; }
    f32x4 xv[2][4]; unsigned dv[2][4]; float ds[2][2]; i32x4 tk[2];
#define NCOL(j) (512 * ((j) >> 1) + 8 * lane + 4 * ((j) & 1))
#define NORM_LOAD(gg) do { _Pragma("unroll") for (int rr = 0; rr < 2; ++rr) { const int row_ = 16 * (gg) + 2 * wid + rr; \
        if (a.xin) { const GAS bf16* xr_ = uni((const GAS bf16*)gxin + (size_t)row_ * D); _Pragma("unroll") for (int h_ = 0; h_ < 2; ++h_) { const u32x4 xb_ = __builtin_nontemporal_load((const GAS u32x4*)(xr_ + 512 * h_ + 8 * lane)); \
            xv[rr][2 * h_] = (f32x4){bflo(xb_.x), bfhi(xb_.x), bflo(xb_.y), bfhi(xb_.y)}; xv[rr][2 * h_ + 1] = (f32x4){bflo(xb_.z), bfhi(xb_.z), bflo(xb_.w), bfhi(xb_.w)}; } } \
        else { const GAS float* xp_ = uni(row_ < NCTX ? gctx0 + (size_t)row_ * D : gx0 + (size_t)(row_ - NCTX) * D); \
            _Pragma("unroll") for (int j = 0; j < 4; ++j) xv[rr][j] = __builtin_nontemporal_load((const GAS f32x4*)(xp_ + NCOL(j))); } \
        if (a.delta) { const GAS signed char* dr_ = uni((const GAS signed char*)gdelta + (size_t)row_ * D); const GAS float* sr_ = uni(gdsc + (size_t)row_ * 16); _Pragma("unroll") for (int h_ = 0; h_ < 2; ++h_) { const u32x2 d_ = __builtin_nontemporal_load((const GAS u32x2*)(dr_ + 512 * h_ + 8 * lane)); \
            dv[rr][2 * h_] = d_.x; dv[rr][2 * h_ + 1] = d_.y; ds[rr][h_] = sr_[8 * h_ + (lane >> 3)]; } } } } while (0)
    unsigned mo[2][4][4]; float ms[2][4][2];
#define TK_LOAD(gg) do { _Pragma("unroll") for (int rr = 0; rr < 2; ++rr) tk[rr] = *(const GAS i32x4*)(uni(gtoks + (size_t)(16 * (gg) + 2 * wid + rr) * 4)); } while (0)
#define MOE_LOAD() do { _Pragma("unroll") for (int rr = 0; rr < 2; ++rr) { const int sl_[4] = {__builtin_amdgcn_readfirstlane(tk[rr][0]), __builtin_amdgcn_readfirstlane(tk[rr][1]), __builtin_amdgcn_readfirstlane(tk[rr][2]), __builtin_amdgcn_readfirstlane(tk[rr][3])}; \
        _Pragma("unroll") for (int k = 0; k < 4; ++k) { const GAS signed char* mr_ = (const GAS signed char*)gmout + (size_t)sl_[k] * D; const GAS float* cr_ = gmsc + (size_t)sl_[k] * 16; \
          _Pragma("unroll") for (int h_ = 0; h_ < 2; ++h_) { const u32x2 m_ = __builtin_nontemporal_load((const GAS u32x2*)(mr_ + 512 * h_ + 8 * lane)); \
            mo[rr][k][2 * h_] = m_.x; mo[rr][k][2 * h_ + 1] = m_.y; ms[rr][k][h_] = cr_[8 * h_ + (lane >> 3)]; } } } } while (0)
    if (g0 < g1) { NORM_LOAD(g0); if (a.mout) { TK_LOAD(g0); MOE_LOAD(); if (g0 + 1 < g1) TK_LOAD(g0 + 1); } }
    for (int g = g0; g < g1; ++g) {
        f32x4 v[2][4];
#pragma unroll
        for (int rr = 0; rr < 2; ++rr) {
#pragma unroll
            for (int j = 0; j < 4; ++j) { v[rr][j] = xv[rr][j];
                if (a.delta) { const int w = (int)dv[rr][j]; const float sc = ds[rr][j >> 1];
                    v[rr][j][0] += (float)((int)((unsigned)w << 24) >> 24) * sc; v[rr][j][1] += (float)((int)((unsigned)w << 16) >> 24) * sc; v[rr][j][2] += (float)((int)((unsigned)w << 8) >> 24) * sc; v[rr][j][3] += (float)(w >> 24) * sc; } }
        }
        if (a.mout) {
#pragma unroll
            for (int rr = 0; rr < 2; ++rr) { const int row = 16 * g + 2 * wid + rr; const GAS float* g2 = gg2mod + (size_t)mod_row(row) * 6 * D + 5 * D;
#pragma unroll
                for (int j = 0; j < 4; ++j) { const f32x4 gg = *(const GAS f32x4*)(g2 + NCOL(j));
                    f32x4 sm = (f32x4){0.f, 0.f, 0.f, 0.f};
#pragma unroll
                    for (int k = 0; k < 4; ++k) { const int w = (int)mo[rr][k][j]; const float sc = ms[rr][k][j >> 1];
                        sm[0] += (float)((int)((unsigned)w << 24) >> 24) * sc; sm[1] += (float)((int)((unsigned)w << 16) >> 24) * sc; sm[2] += (float)((int)((unsigned)w << 8) >> 24) * sc; sm[3] += (float)(w >> 24) * sc; }
                    v[rr][j] = v[rr][j] + gg * sm; } }
        }
        if (g + 1 < g1) { NORM_LOAD(g + 1); if (a.mout) { MOE_LOAD(); if (g + 2 < g1) TK_LOAD(g + 2); } }
#pragma unroll
        for (int rr = 0; rr < 2; ++rr) {
            const int r = 2 * wid + rr, row = 16 * g + r;
            const int mrow = mod_row(row);
            if (MODE == 0) {
#pragma unroll
                for (int h_ = 0; h_ < 2; ++h_) { u32x4 xb; xb.x = pk2(v[rr][2 * h_][0], v[rr][2 * h_][1]); xb.y = pk2(v[rr][2 * h_][2], v[rr][2 * h_][3]); xb.z = pk2(v[rr][2 * h_ + 1][0], v[rr][2 * h_ + 1][1]); xb.w = pk2(v[rr][2 * h_ + 1][2], v[rr][2 * h_ + 1][3]);
                    *(GAS u32x4*)((GAS bf16*)gxout + (size_t)row * D + 512 * h_ + 8 * lane) = xb;
                    v[rr][2 * h_] = (f32x4){bflo(xb.x), bfhi(xb.x), bflo(xb.y), bfhi(xb.y)}; v[rr][2 * h_ + 1] = (f32x4){bflo(xb.z), bfhi(xb.z), bflo(xb.w), bfhi(xb.w)}; }
            }
            float ss = 0.f;
#pragma unroll
            for (int j = 0; j < 4; ++j) ss += (v[rr][j][0] * v[rr][j][0] + v[rr][j][1] * v[rr][j][1]) + (v[rr][j][2] * v[rr][j][2] + v[rr][j][3] * v[rr][j][3]);
            const float rstd = 1.0f / sqrtf(wave_sum(ss) * (1.0f / D) + EPS);
            if (MODE == 2) {
                if (row >= NCTX) {
#pragma unroll
                    for (int j = 0; j < 4; ++j) { const int c = NCOL(j); const f32x4 fn = *(const GAS f32x4*)(gfnorm + c); *(GAS f32x4*)(gout + (size_t)(row - NCTX) * D + c) = v[rr][j] * rstd * fn; }
                }
            } else {
                const GAS float* shp = gmod + (size_t)mrow * 6 * D + a.shi * D; const GAS float* scp = gmod + (size_t)mrow * 6 * D + a.sci * D;
                f32x4 h[4]; float am = 0.f;
#pragma unroll
                for (int j = 0; j < 4; ++j) { const int c = NCOL(j); const f32x4 sh = *(const GAS f32x4*)(shp + c), sc = *(const GAS f32x4*)(scp + c);
                    h[j] = v[rr][j] * rstd * (sc + 1.0f) + sh;
                    u32x2 hi; hi.x = pk2(h[j][0], h[j][1]); hi.y = pk2(h[j][2], h[j][3]);
                    u32x2 lo; lo.x = pk2(h[j][0] - bflo(hi.x), h[j][1] - bfhi(hi.x)); lo.y = pk2(h[j][2] - bflo(hi.y), h[j][3] - bfhi(hi.y));
                    am = fmaxf(am, fmaxf(fmaxf(fabsf(h[j][0]), fabsf(h[j][1])), fmaxf(fabsf(h[j][2]), fabsf(h[j][3]))));
                    *(LAS u32x2*)(Thi + r * TP + c * 2) = hi; *(LAS u32x2*)(Tlo + r * TP + c * 2) = lo; }
                {
                    am = wave_max(am);
                    am = fmaxf(am, 1e-20f); const float qs = 127.0f / am;
#pragma unroll
                    for (int h_ = 0; h_ < 2; ++h_) { u32x2 qw;
#pragma unroll
                        for (int q_ = 0; q_ < 2; ++q_) { const int j = 2 * h_ + q_; const int q0 = (int)rintf(h[j][0] * qs), q1 = (int)rintf(h[j][1] * qs), q2 = (int)rintf(h[j][2] * qs), q3 = (int)rintf(h[j][3] * qs);
                            qw[q_] = (unsigned)(q0 & 255) | ((unsigned)(q1 & 255) << 8) | ((unsigned)(q2 & 255) << 16) | ((unsigned)(q3 & 255) << 24); }
                        *(GAS u32x2*)(gh8 + (size_t)row * D + 512 * h_ + 8 * lane) = qw; }
                    if (lane == 0) ghs[row] = am * (1.0f / 127.0f);
                }
            }
        }
        if (MODE == 2) continue;
        if (MODE == 0) {
#pragma unroll
            for (int s = 0; s < 4; ++s)
#pragma unroll
                for (int nb = 0; nb < NBK; ++nb) { const size_t o = (size_t)(nb * 16 + fr) * D + 128 * wid + 32 * s + 8 * fq;
                    Bh[s][nb] = *(const bf16x8*)(a.wsm + o); Bl[s][nb] = *(const bf16x8*)(a.wsm + (size_t)NS * D + o); }
        }
        __syncthreads();
        f32x4 pacc[NBK];
#pragma unroll
        for (int nb = 0; nb < NBK; ++nb) pacc[nb] = (f32x4){0.f, 0.f, 0.f, 0.f};
#pragma unroll
        for (int s = 0; s < 4; ++s) { const int ko = (128 * wid + 32 * s + 8 * fq) * 2;
            const bf16x8 ah = *(const LAS bf16x8*)(Thi + fr * TP + ko), al = *(const LAS bf16x8*)(Tlo + fr * TP + ko);
#pragma unroll
            for (int nb = 0; nb < NBK; ++nb) { pacc[nb] = __builtin_amdgcn_mfma_f32_16x16x32_bf16(ah, Bh[s][nb], pacc[nb], 0, 0, 0);
                pacc[nb] = __builtin_amdgcn_mfma_f32_16x16x32_bf16(ah, Bl[s][nb], pacc[nb], 0, 0, 0); pacc[nb] = __builtin_amdgcn_mfma_f32_16x16x32_bf16(al, Bh[s][nb], pacc[nb], 0, 0, 0); } }
#pragma unroll
        for (int nb = 0; nb < NBK; ++nb)
#pragma unroll
            for (int i = 0; i < 4; ++i) red[(wid * 16 + 4 * fq + i) * RP + nb * 16 + fr] = pacc[nb][i];
        __syncthreads();
        if (tid < 16 * NS) {
            const int rw = tid / NS, n = tid % NS;
            float val = a.sbias[n];
#pragma unroll
            for (int w = 0; w < 8; ++w) val += red[(w * 16 + rw) * RP + n];
            const int row = 16 * g + rw;
            if (MODE == 0) {
                if ((n >> 2) & 1) val = log_sigmoid(val);
                a.mg[(size_t)row * 16 + n] = val;
            } else {
                float vv = val; int ei[4]; float tv[4];
#pragma unroll
                for (int it = 0; it < 4; ++it) { float bvv = vv; int bi = n;
                    {
#define TOPSTEP(CTRL) { const float ov = dpp_f<CTRL>(bvv); const int oi = dpp_i<CTRL>(bi); if (ov > bvv || (ov == bvv && oi < bi)) { bvv = ov; bi = oi; } }
                        TOPSTEP(0xB1) TOPSTEP(0x4E) TOPSTEP(0x141) TOPSTEP(0x140)
#undef TOPSTEP
                        const auto rv = __builtin_amdgcn_permlane16_swap(__float_as_uint(bvv), __float_as_uint(bvv), false, false); const auto ri = __builtin_amdgcn_permlane16_swap((unsigned)bi, (unsigned)bi, false, false);
                        const float v0 = __uint_as_float(rv[0]), v1 = __uint_as_float(rv[1]); const int i0 = (int)ri[0], i1 = (int)ri[1];
                        if (v0 > v1 || (v0 == v1 && i0 < i1)) { bvv = v0; bi = i0; } else { bvv = v1; bi = i1; } }
                    ei[it] = bi; tv[it] = bvv; if (n == bi) vv = -INFINITY; }
                if (n == 0) {
                    const float e1 = __expf(tv[1] - tv[0]), e2 = __expf(tv[2] - tv[0]), e3 = __expf(tv[3] - tv[0]); const float inv = 1.0f / (1.0f + e1 + e2 + e3);
                    *(int4*)(a.toke + (size_t)row * 4) = make_int4(ei[0], ei[1], ei[2], ei[3]);
                    *(float4*)(a.tokg + (size_t)row * 4) = make_float4(inv, e1 * inv, e2 * inv, e3 * inv);
                    atomicAdd((int*)&hist[ei[0]], 1); atomicAdd((int*)&hist[ei[1]], 1); atomicAdd((int*)&hist[ei[2]], 1); atomicAdd((int*)&hist[ei[3]], 1);
                }
            }
        }
        if (MODE == 1) { __syncthreads(); if (tid < 32) { const int h = hist[tid]; a.ghist[(size_t)g * 32 + tid] = h; blk += h; hist[tid] = 0; } }
    }
    if (MODE == 1) { if (tid < 32) a.bhist[(size_t)bid * 32 + tid] = blk; }
    __syncthreads();
}

#undef NORM_LOAD
#undef NCOL
#undef TK_LOAD
#undef MOE_LOAD
struct ScatterArgs { const int* toke; const float* tokg; const int* ghist; const int* bhist; int* toks; int* sltok; float* slg; int* rte; const float* hs; float* sls; int gs; unsigned char* rteb; };
DI void scatter_phase(LAS unsigned char* lds, const ScatterArgs& a) {
    const int tid = opaque_tid(), wid = __builtin_amdgcn_readfirstlane(tid >> 6), lane = tid & 63;
    LAS int* ptot = (LAS int*)lds; LAS int* ppre = ptot + 512; LAS int* stt = ppre + 512; LAS int* tot = stt + 32; LAS int* pre = tot + 32; LAS int* padv = pre + 32;
    const int G = gridDim.x, B = opaque_bid(), per = (NGRP - a.gs + G - 1) / G, g0 = a.gs + B * per, g1 = (g0 + per < NGRP) ? g0 + per : NGRP;
    { const int e = tid & 31, seg = tid >> 5; int t = 0, p = 0;
      for (int b = seg; b < G; b += 16) { const int h = a.bhist[(size_t)b * 32 + e]; t += h; if (b < B) p += h; }
      ptot[seg * 32 + e] = t; ppre[seg * 32 + e] = p; }
    __syncthreads();
    if (tid < 32) { int t = 0, p = 0;
#pragma unroll
        for (int s = 0; s < 16; ++s) { t += ptot[s * 32 + tid]; p += ppre[s * 32 + tid]; }
        const int pd = (t + 255) & ~255; int sc = pd;
#pragma unroll
        for (int o = 1; o < 32; o <<= 1) { const int x = __shfl_up(sc, o); if (tid >= o) sc += x; }
        stt[tid] = sc - pd; tot[tid] = t; pre[tid] = p; padv[tid] = pd;
        if (B == 0 && tid == 31) a.rte[0] = sc >> 8; }
    __syncthreads();
    if (B == 0) {
        for (int e = 0; e < 32; ++e) { const int s0 = stt[e], t = tot[e], pd = padv[e];
            for (int s = t + tid; s < pd; s += 512) { a.sltok[s0 + s] = 0; a.slg[s0 + s] = 0.f; a.sls[s0 + s] = 0.f; }
            for (int rt = (s0 >> 8) + tid; rt < ((s0 + pd) >> 8); rt += 512) { a.rte[32 + rt] = e; a.rteb[rt] = (unsigned char)e; } }
    }
    for (int g = g0 + wid; g < g1; g += 8) {
        int base = 0;
        if (lane < 32) { base = stt[lane] + pre[lane]; for (int gg = g0; gg < g; ++gg) base += a.ghist[(size_t)gg * 32 + lane]; }
        const int ti = lane >> 2, tok = 16 * g + ti;
        const int e = a.toke[(size_t)tok * 4 + (lane & 3)]; const float gt = a.tokg[(size_t)tok * 4 + (lane & 3)];
        const unsigned long long below = (ti == 0) ? 0ull : ((1ull << (4 * ti)) - 1ull);
        int rank = 0;
        for (int ee = 0; ee < 32; ++ee) { const unsigned long long m = __ballot(e == ee); if (e == ee) rank = __popcll(m & below); }
        const int slot = __shfl(base, e) + rank;
        a.sltok[slot] = tok; a.slg[slot] = gt; a.sls[slot] = a.hs[tok]; a.toks[(size_t)tok * 4 + (lane & 3)] = slot;
    }
    __syncthreads();
}

namespace attn_body {
using f32x16 = __attribute__((ext_vector_type(16))) float;
using s16x4 = __attribute__((ext_vector_type(4))) short;
constexpr int NW = 8, QBLK = 32, KVBLK = 64;
constexpr int QP = 512, KP = 64, OP = 1024;
DI int crow(int r, int hi) { return (r & 3) + 8 * (r >> 2) + 4 * hi; }
#define SBAR() __builtin_amdgcn_sched_barrier(0)
constexpr int NSLOT = 3, SLOTB = 8192;
constexpr int LDS_K = 0, LDS_V = NSLOT * SLOTB, LDS_WS = 2 * NSLOT * SLOTB, LDS_OST = LDS_WS + NW * 64 * 4, ATT_LDS_BYTES = LDS_OST + NW * 4096;
DI void glds16(const void* gsrc, unsigned lds_dst) { unsigned keep;
    asm volatile("s_mov_b32 %0, m0\n\ts_mov_b32 m0, %2\n\ts_nop 0\n\tglobal_load_lds_dwordx4 %1, off\n\ts_mov_b32 m0, %0" : "=&s"(keep) : "v"(gsrc), "s"(lds_dst) : "memory"); }
DI float max3f(float a, float b, float c) { float r; asm("v_max3_f32 %0, %1, %2, %3" : "=v"(r) : "v"(a), "v"(b), "v"(c)); return r; }
DI float max2f(float a, float b) { float r; asm("v_max_f32_e32 %0, %1, %2" : "=v"(r) : "v"(a), "v"(b)); return r; }
DI float fadd_s(float a, float b) { float r; asm("v_add_f32_e32 %0, %1, %2" : "=v"(r) : "v"(a), "v"(b)); return r; }
DI float fsub_s(float a, float b) { float r; asm("v_sub_f32_e32 %0, %1, %2" : "=v"(r) : "v"(a), "v"(b)); return r; }
DI unsigned cvtpk_s(float lo, float hi) { return pk2(lo, hi); }
#define WAIT_BAR(N) asm volatile("s_waitcnt vmcnt(" #N ") lgkmcnt(0)\n\ts_barrier" ::: "memory")
typedef LAS const char* lds_cptr;
typedef short v4i16_t __attribute__((ext_vector_type(4)));
typedef int i32x8 __attribute__((ext_vector_type(8)));
DI i32x8 cat8i(i32x4 x0, i32x4 x1) { return __builtin_shufflevector(x0, x1, 0, 1, 2, 3, 4, 5, 6, 7); }
DI i32x8 kload1(lds_cptr kp, int kh) { return cat8i(*(const LAS i32x4*)(kp + kh * 512), *(const LAS i32x4*)(kp + 1024 + kh * 512)); }
DI f32x16 mfq(i32x8 a, i32x8 b, f32x16 c) { return __builtin_amdgcn_mfma_scale_f32_32x32x64_f8f6f4(a, b, c, 0, 0, 0, 0, 0, 0); }
DI s16x4 vtr(lds_cptr p) { return __builtin_bit_cast(s16x4, __builtin_amdgcn_ds_read_tr16_b64_v4i16((LAS v4i16_t*)p)); }
DI float rowmax(const f32x16& p0, const f32x16& p1) {
    float a = max3f(p0[0], p0[1], p1[0]), b = max3f(p0[2], p0[3], p1[1]); a = max3f(a, p1[2], p1[3]);
#pragma unroll
    for (int r = 4; r < 16; r += 4) { a = max3f(a, p0[r], p0[r + 1]); b = max3f(b, p0[r + 2], p0[r + 3]); a = max3f(a, p1[r], p1[r + 1]); b = max3f(b, p1[r + 2], p1[r + 3]); }
    const float m = max2f(a, b);
    auto rr = __builtin_amdgcn_permlane32_swap(__float_as_uint(m), __float_as_uint(m), false, false);
    return max2f(__uint_as_float(rr[0]), __uint_as_float(rr[1]));
}
DI void pv(f32x16* o, int vb, bf16x8 pa0, bf16x8 pa1, bf16x8 pa2, bf16x8 pa3) {
#pragma unroll
    for (int d0 = 0; d0 < 2; ++d0) { s16x4 lo[4], hi[4];
#pragma unroll
        for (int ks = 0; ks < 4; ++ks) {
            asm volatile("ds_read_b64_tr_b16 %0,%1 offset:%c2" : "=&v"(lo[ks]) : "v"(vb), "i"(d0 * 4096 + ks * 1024) : "memory");
            asm volatile("ds_read_b64_tr_b16 %0,%1 offset:%c2" : "=&v"(hi[ks]) : "v"(vb), "i"(d0 * 4096 + ks * 1024 + 512) : "memory"); }
        asm volatile("s_waitcnt lgkmcnt(0)" ::: "memory"); SBAR();
#define PK(k) (bf16x8){lo[k][0], lo[k][1], lo[k][2], lo[k][3], hi[k][0], hi[k][1], hi[k][2], hi[k][3]}
        o[d0] = __builtin_amdgcn_mfma_f32_32x32x16_bf16(pa0, PK(0), o[d0], 0, 0, 0);
        o[d0] = __builtin_amdgcn_mfma_f32_32x32x16_bf16(pa1, PK(1), o[d0], 0, 0, 0);
        o[d0] = __builtin_amdgcn_mfma_f32_32x32x16_bf16(pa2, PK(2), o[d0], 0, 0, 0);
        o[d0] = __builtin_amdgcn_mfma_f32_32x32x16_bf16(pa3, PK(3), o[d0], 0, 0, 0);
#undef PK
    }
}
template <int THRL, bool NOMAX> DI void attn_unit(const unsigned char* Qu, const unsigned char* __restrict__ Kh, const bf16* __restrict__ Vh, const int NT, unsigned char* Ou, const float* gain, char* shm) {
    const int tid = opaque_tid(), lane = tid & 63, r32 = lane & 31, hi = lane >> 5; const int wid = __builtin_amdgcn_readfirstlane(tid >> 6);
    const unsigned char* Qw = Qu + (long)(wid * QBLK) * QP;
    const unsigned lds0 = (unsigned)(uintptr_t)shm;
    float* wsf = (float*)(shm + LDS_WS) + wid * 64;
    const unsigned char* ksrc = Kh + (long)lane * KP + (wid & 3) * 16;
    const bf16* vsrc = Vh + (long)(16 * (wid & 3) + (lane >> 2)) * KP + (wid >> 2) * 32 + (lane & 3) * 8;
    const unsigned kdst = lds0 + LDS_K + (wid & 3) * 1024, vdst = lds0 + LDS_V + wid * 1024;
#define DMA_K(t, slot) glds16(ksrc + (long)(t) * KVBLK * KP, (unsigned)__builtin_amdgcn_readfirstlane(kdst + (slot)))
#define DMA_V(t, slot) glds16(vsrc + (long)(t) * KVBLK * KP, (unsigned)__builtin_amdgcn_readfirstlane(vdst + (slot)))
    const int vb0 = (int)(lds0 + LDS_V) + ((lane >> 4) & 1) * 32 + (lane & 3) * 8 + (4 * hi + ((lane & 15) >> 2)) * 64;
    i32x8 kf[2];
    const lds_cptr shm3 = (lds_cptr)shm; const lds_cptr kp0 = shm3 + LDS_K + hi * 2048 + r32 * 16; const lds_cptr vp0 = shm3 + LDS_V + ((lane >> 4) & 1) * 32 + (lane & 3) * 8 + (4 * hi + ((lane & 15) >> 2)) * 64;
    DMA_K(0, 0); DMA_V(0, 0); DMA_K(1, SLOTB);
    const i32x8 qr = cat8i(*reinterpret_cast<const i32x4*>(Qw + (long)r32 * QP + hi * 32), *reinterpret_cast<const i32x4*>(Qw + (long)r32 * QP + hi * 32 + 16));
    float mhat = 0.f, l_reg = 0.f; f32x16 o[2]; o[0] = f32x16{}; o[1] = f32x16{}; f32x16 negm = f32x16{}; asm volatile("" : "+v"(negm));
    bool resc = false;
#define START(P0, P1) do { resc = false; \
    if constexpr (!NOMAX) { const float rm = rowmax(P0, P1); const float dl = rm; mhat = fadd_s(mhat, dl); \
      _Pragma("unroll") for (int r = 0; r < 16; ++r) { P0[r] = fsub_s(P0[r], dl); P1[r] = fsub_s(P1[r], dl); } \
      _Pragma("unroll") for (int r = 0; r < 16; ++r) negm[r] = -mhat; asm volatile("" : "+v"(negm)); } \
    _Pragma("unroll") for (int r = 0; r < 16; ++r) P0[r] = __builtin_amdgcn_exp2f(P0[r]); } while (0)
#define RESC() do { if (resc) { asm volatile("s_waitcnt lgkmcnt(0)" ::: "memory"); \
      _Pragma("unroll") for (int d_ = 0; d_ < 2; ++d_) _Pragma("unroll") for (int r = 0; r < 16; ++r) o[d_][r] *= wsf[crow(r, hi)]; } } while (0)
    f32x16 pA0, pA1, pB0, pB1;
    int sl_prev = 0, sl_cur = 0, sl_next = SLOTB;
#define ROT() do { sl_prev = sl_cur; sl_cur = sl_next; sl_next = (sl_next == (NSLOT - 1) * SLOTB) ? 0 : sl_next + SLOTB; } while (0)
    DMA_K(2, 2 * SLOTB);
    WAIT_BAR(3);
    pA0 = mfq(kload1(kp0, 0), qr, negm); pA1 = mfq(kload1(kp0, 1), qr, negm);
    if constexpr (!NOMAX) asm volatile("s_nop 15\n\ts_nop 15" : "+v"(pA0), "+v"(pA1));
    START(pA0, pA1);
    _Pragma("unroll") for (int r = 0; r < 16; ++r) pA1[r] = __builtin_amdgcn_exp2f(pA1[r]);
    WAIT_BAR(0);
    DMA_K(3, 0); DMA_V(1, SLOTB);
    ROT();
    kf[0] = kload1(kp0 + sl_cur, 0); kf[1] = kload1(kp0 + sl_cur, 1);
    WAIT_BAR(2);
    s16x4 vlo[8], vhi[8]; u32x4 pw0, pw1, pw2, pw3;
#define PKW(P, B) cvtpk_s(P[B], P[B + 1])
#define PAF(k) __builtin_bit_cast(bf16x8, pw##k)
#define VFR(i) (bf16x8){vlo[i][0], vlo[i][1], vlo[i][2], vlo[i][3], vhi[i][0], vhi[i][1], vhi[i][2], vhi[i][3]}
#define PIN(x) asm volatile("" : "+v"(x))
#define MX3(a, b, c) __builtin_fmaxf(__builtin_fmaxf((a), (b)), (c))
#define GAPA(MF, A0, A1, A2, A3, W0, W1, PW) do { MF; sacc += A0; sacc += A1; sacc += A2; sacc += A3; PIN(sacc); W0; W1; PIN(PW); SBAR(); } while (0)
#define EX(v) __builtin_amdgcn_exp2f(v)
#define GAPB(MF, X, B) do { MF; X[B] = EX(X[B]); X[B + 1] = EX(X[B + 1]); X[B + 2] = EX(X[B + 2]); X[B + 3] = EX(X[B + 3]); PIN(X); SBAR(); } while (0)
#define VRD(i) do { vlo[i] = vtr(vp_ + (((i) >> 2) * 4096 + ((i) & 3) * 1024)); vhi[i] = vtr(vp_ + (((i) >> 2) * 4096 + ((i) & 3) * 1024 + 512)); } while (0)
#define KRD(G, j) do { if (G) { kf[j] = kload1(kp0 + sl_next, j); SBAR(); } } while (0)
#define STEP(C0, C1, P0, P1, t, GK, GV, GL) do { SBAR(); \
    const lds_cptr vp_ = vp0 + sl_prev; \
    VRD(0); SBAR(); float sacc = (P0[0] + P0[1]); \
    GAPA(C0 = mfq(kf[0], qr, negm), P0[2], P0[3], P0[4], P0[5],     pw0[0] = PKW(P0, 0), pw0[1] = PKW(P0, 2), pw0); \
    VRD(4); SBAR(); GAPA((void)0, P0[6], P0[7], P0[8], P0[9],     pw0[2] = PKW(P0, 4), pw0[3] = PKW(P0, 6), pw0); \
    VRD(1); SBAR(); GAPA((void)0, P0[10], P0[11], P0[12], P0[13], pw1[0] = PKW(P0, 8), pw1[1] = PKW(P0, 10), pw1); \
    VRD(5); SBAR(); GAPA((void)0, P0[14], P0[15], P1[0], P1[1],   pw1[2] = PKW(P0, 12), pw1[3] = PKW(P0, 14), pw1); \
    VRD(2); SBAR(); GAPA(C1 = mfq(kf[1], qr, negm), P1[2], P1[3], P1[4], P1[5],     pw2[0] = PKW(P1, 0), pw2[1] = PKW(P1, 2), pw2); \
    VRD(6); SBAR(); GAPA((void)0, P1[6], P1[7], P1[8], P1[9],     pw2[2] = PKW(P1, 4), pw2[3] = PKW(P1, 6), pw2); \
    VRD(3); SBAR(); GAPA((void)0, P1[10], P1[11], P1[12], P1[13], pw3[0] = PKW(P1, 8), pw3[1] = PKW(P1, 10), pw3); \
    VRD(7); SBAR(); GAPA((void)0, P1[14], P1[15], 0.f, 0.f,       pw3[2] = PKW(P1, 12), pw3[3] = PKW(P1, 14), pw3); \
    l_reg += sacc; \
    if (GK) { DMA_K((t) + 3, sl_cur); } if (GV) { DMA_V((t) + 1, sl_next); } \
    if constexpr (!NOMAX) { float a = MX3(C0[0], C0[1], C1[0]), b = MX3(C0[2], C0[3], C1[1]); a = MX3(a, C1[2], C1[3]); \
      _Pragma("unroll") for (int r = 4; r < 16; r += 4) { a = MX3(a, C0[r], C0[r + 1]); b = MX3(b, C0[r + 2], C0[r + 3]); a = MX3(a, C1[r], C1[r + 1]); b = MX3(b, C1[r + 2], C1[r + 3]); } \
      float rm = __builtin_fmaxf(a, b); { auto rr = __builtin_amdgcn_permlane32_swap(__float_as_uint(rm), __float_as_uint(rm), false, false); rm = __builtin_fmaxf(__uint_as_float(rr[0]), __uint_as_float(rr[1])); } \
      resc = false; \
      if (__builtin_expect(__any(rm > (float)THRL), 0)) { const float dl = __builtin_fmaxf(rm, 0.f); mhat += dl; \
        _Pragma("unroll") for (int r = 0; r < 16; ++r) { C0[r] -= dl; C1[r] -= dl; } \
        _Pragma("unroll") for (int r = 0; r < 16; ++r) negm[r] = -mhat; asm volatile("" : "+v"(negm)); \
        const float f = __builtin_amdgcn_exp2f(-dl); l_reg *= f; if (hi == 0) wsf[r32] = f; resc = true; } } \
    SBAR(); \
    GAPB(o[0] = __builtin_amdgcn_mfma_f32_32x32x16_bf16(PAF(0), VFR(0), o[0], 0, 0, 0), C0, 0); \
    GAPB(o[1] = __builtin_amdgcn_mfma_f32_32x32x16_bf16(PAF(0), VFR(4), o[1], 0, 0, 0), C0, 4); \
    KRD(GL, 0); GAPB(o[0] = __builtin_amdgcn_mfma_f32_32x32x16_bf16(PAF(1), VFR(1), o[0], 0, 0, 0), C0, 8); \
    GAPB(o[1] = __builtin_amdgcn_mfma_f32_32x32x16_bf16(PAF(1), VFR(5), o[1], 0, 0, 0), C0, 12); \
    KRD(GL, 1); GAPB(o[0] = __builtin_amdgcn_mfma_f32_32x32x16_bf16(PAF(2), VFR(2), o[0], 0, 0, 0), C1, 0); \
    GAPB(o[1] = __builtin_amdgcn_mfma_f32_32x32x16_bf16(PAF(2), VFR(6), o[1], 0, 0, 0), C1, 4); \
    GAPB(o[0] = __builtin_amdgcn_mfma_f32_32x32x16_bf16(PAF(3), VFR(3), o[0], 0, 0, 0), C1, 8); \
    GAPB(o[1] = __builtin_amdgcn_mfma_f32_32x32x16_bf16(PAF(3), VFR(7), o[1], 0, 0, 0), C1, 12); \
    } while (0)
    int t = 1;
    for (; t + 5 < NT; t += 2) {
        STEP(pB0, pB1, pA0, pA1, t, true, true, true);     WAIT_BAR(2); RESC(); ROT();
        STEP(pA0, pA1, pB0, pB1, t + 1, true, true, true); WAIT_BAR(2); RESC(); ROT();
    }
#define ENDW(tt) do { if ((tt) + 3 < NT) { WAIT_BAR(2); } else if ((tt) + 2 < NT) { WAIT_BAR(1); } else { WAIT_BAR(0); } } while (0)
    for (; t + 1 < NT; t += 2) {
        STEP(pB0, pB1, pA0, pA1, t, (t + 3 < NT), (t + 1 < NT), (t + 1 < NT));         ENDW(t);     RESC(); ROT();
        STEP(pA0, pA1, pB0, pB1, t + 1, (t + 4 < NT), (t + 2 < NT), (t + 2 < NT));     ENDW(t + 1); RESC(); ROT();
    }
    STEP(pB0, pB1, pA0, pA1, NT - 1, false, false, false); RESC();
    { float sacc = pB0[0] + pB0[1]; _Pragma("unroll") for (int r = 2; r < 16; ++r) sacc += pB0[r]; _Pragma("unroll") for (int r = 0; r < 16; ++r) sacc += pB1[r]; l_reg += sacc;
      pw0 = (u32x4){PKW(pB0, 0), PKW(pB0, 2), PKW(pB0, 4), PKW(pB0, 6)}; pw1 = (u32x4){PKW(pB0, 8), PKW(pB0, 10), PKW(pB0, 12), PKW(pB0, 14)}; pw2 = (u32x4){PKW(pB1, 0), PKW(pB1, 2), PKW(pB1, 4), PKW(pB1, 6)}; pw3 = (u32x4){PKW(pB1, 8), PKW(pB1, 10), PKW(pB1, 12), PKW(pB1, 14)};
      SBAR(); pv(o, vb0 + sl_cur, PAF(0), PAF(1), PAF(2), PAF(3)); }
#undef PKW
#undef PAF
#undef VFR
#undef PIN
#undef MX3
#undef GAPA
#undef GAPB
#undef EX
#undef VRD
#undef KRD
#undef STEP
#undef ENDW
    { auto rr = __builtin_amdgcn_permlane32_swap(__float_as_uint(l_reg), __float_as_uint(l_reg), false, false); l_reg = __uint_as_float(rr[0]) + __uint_as_float(rr[1]); }
    if (hi == 0) wsf[32 + r32] = l_reg; asm volatile("s_waitcnt lgkmcnt(0)" ::: "memory");
    float rli[16];
#pragma unroll
    for (int r = 0; r < 16; ++r) rli[r] = __builtin_amdgcn_rcpf(wsf[32 + crow(r, hi)]);
    unsigned char* Ow = Ou + (long)(wid * QBLK) * OP;
    { bf16* stg = (bf16*)(shm + LDS_OST) + wid * 2048;
#pragma unroll
      for (int r = 0; r < 16; ++r) { const int orow = crow(r, hi);
#pragma unroll
          for (int d0 = 0; d0 < 2; ++d0) stg[orow * 64 + d0 * 32 + r32] = f2bf(o[d0][r] * rli[r]); }
      asm volatile("s_waitcnt lgkmcnt(0)" ::: "memory");
      const int ch = lane & 7;
#pragma unroll
      for (int i = 0; i < 4; ++i) { const int row = i * 8 + (lane >> 3); const u32x4 v = *(const u32x4*)(stg + row * 64 + ch * 8);
          float x[8] = {bflo(v.x), bfhi(v.x), bflo(v.y), bfhi(v.y), bflo(v.z), bfhi(v.z), bflo(v.w), bfhi(v.w)};
          float ss = 0.f;
#pragma unroll
          for (int k = 0; k < 8; ++k) ss += x[k] * x[k];
          ss = sum_oct(ss);
          const float rs = __builtin_amdgcn_rsqf(ss * (1.0f / 64.0f) + EPS);
          const float rq = rs * YS; u32x2 w; w.x = pk_i8x4(x[0] * rq, x[1] * rq, x[2] * rq, x[3] * rq); w.y = pk_i8x4(x[4] * rq, x[5] * rq, x[6] * rq, x[7] * rq);
          *(u32x2*)(Ow + (long)row * OP + ch * 8) = w; } }
    asm volatile("s_waitcnt lgkmcnt(0)\n\ts_barrier" ::: "memory");
#undef DMA_K
#undef DMA_V
#undef START
#undef RESC
#undef ROT
}
#undef SBAR
#undef WAIT_BAR
}

namespace mlstm {
constexpr int P2 = 144;
constexpr int TILE = 64 * P2;
constexpr int O_Q = 0, O_K = TILE, O_KT = 2 * TILE, O_VT = 3 * TILE, O_P = 4 * TILE, O_CT = 5 * TILE  , O_N = 7 * TILE  , O_SC = O_N + 512  , DIRB = O_SC + 2048;
static_assert(2 * DIRB <= SCR_BYTES, "mLSTM LDS");
struct Args { const bf16 *MQ, *MK, *MV, *MO; const float* MG; float* HFB; bf16* Y; const float* mixn; };
DI int chunk_mc(int dir, int j) { return dir == 0 ? j : (j < 4 ? 3 - j : 71 - j); }
DI int tok_row(int b, int p) { return p < TC ? b * TC + p : NCTX + b * T + (p - TC); }
DI void item(LAS unsigned char* lds, const Args& a, int b, int h) {
    const int tid = opaque_tid(), wid = __builtin_amdgcn_readfirstlane(tid >> 6), lane = tid & 63, fr = lane & 15, fq = lane >> 4;
    const int dir = wid >> 2, w4 = wid & 3;
    LAS unsigned char* L = lds + dir * DIRB;
    LAS float* sa = (LAS float*)(L + O_SC + w4 * 512); LAS float* sg = sa + 64;
    for (int i = (tid & 255); i < TILE / 4; i += 256) ((LAS unsigned*)(L + O_CT))[i] = 0u;
    if ((tid & 255) < 64) ((LAS float*)(L + O_N))[tid & 255] = 0.f;
    f32x4 Cacc[4];
#pragma unroll
    for (int c = 0; c < 4; ++c) Cacc[c] = (f32x4){0.f, 0.f, 0.f, 0.f};
    float n_reg = 0.f, m_prev = 0.f;
    const GAS bf16* gMQ = (const GAS bf16*)a.MQ; const GAS bf16* gMK = (const GAS bf16*)a.MK; const GAS bf16* gMV = (const GAS bf16*)a.MV; const GAS float* gMG = (const GAS float*)a.MG;
    GAS float* HF = (GAS float*)a.HFB + ((size_t)((b * 4 + h) * 2 + dir)) * TKV * 64;
    u32x4 qA[2], kA[2], vA[2]; float li, lf;
    const unsigned psel = (lane & 1) ? 0x07060302u : 0x01000504u; const int tb = (lane & 1) ? (P2 + 2 * (lane - 1)) : 2 * lane;
#define MLOAD(j) do { const int mc_ = chunk_mc(dir, (j)); const int p_ = 64 * mc_ + (dir == 0 ? lane : 63 - lane); const size_t row_ = (size_t)tok_row(b, p_); \
        li = gMG[row_ * 16 + dir * 8 + h]; lf = gMG[row_ * 16 + dir * 8 + 4 + h]; \
        _Pragma("unroll") for (int m_ = 0; m_ < 2; ++m_) { const int tr_ = 16 * w4 + 8 * m_ + (lane >> 3); const size_t o_ = (size_t)tok_row(b, 64 * mc_ + (dir == 0 ? tr_ : 63 - tr_)) * 256 + h * 64 + 8 * (lane & 7); \
            qA[m_] = *(const GAS u32x4*)(gMQ + o_); kA[m_] = *(const GAS u32x4*)(gMK + o_); vA[m_] = *(const GAS u32x4*)(gMV + o_); } } while (0)
    MLOAD(0);
    __syncthreads();
    for (int j = 0; j < 68; ++j) {
        const int cb = j & 1;
        const float bcs = scan_sum64(lf);
        const float av = li - bcs;
        const float pmx = scan_max64(av);
        const float gv = fmaxf(m_prev, pmx);
        const float G63 = __builtin_bit_cast(float, __builtin_amdgcn_readlane(__builtin_bit_cast(int, gv), 63)), bend = __builtin_bit_cast(float, __builtin_amdgcn_readlane(__builtin_bit_cast(int, bcs), 63));
        const float wsv = __expf(av - G63), w_prev = __expf(m_prev - G63);
        const float w_int = __expf(m_prev - gv), emt = __expf(-(bcs + gv));
#pragma unroll
        for (int m = 0; m < 2; ++m) { const int tr = 16 * w4 + 8 * m + (lane >> 3), po = tr * P2 + 16 * (lane & 7);
            *(LAS u32x4*)(L + O_Q + po) = qA[m]; *(LAS u32x4*)(L + O_K + po) = kA[m]; *(LAS u32x4*)(L + O_P + po) = vA[m]; }
        if (j + 1 < 68) MLOAD(j + 1);
        __syncthreads();
        const u32x4 k0 = *(const LAS u32x4*)(L + O_K + lane * P2 + 16 * w4), k1 = *(const LAS u32x4*)(L + O_K + lane * P2 + 16 * w4 + 64), v0 = *(const LAS u32x4*)(L + O_P + lane * P2 + 16 * w4), v1 = *(const LAS u32x4*)(L + O_P + lane * P2 + 16 * w4 + 64);
        {
            const unsigned kw[8] = {k0.x, k0.y, k0.z, k0.w, k1.x, k1.y, k1.z, k1.w}, vw[8] = {v0.x, v0.y, v0.z, v0.w, v1.x, v1.y, v1.z, v1.w};
#pragma unroll
            for (int pp = 0; pp < 2; ++pp)
#pragma unroll
                for (int i = 0; i < 4; ++i) { const int d = 8 * w4 + 32 * pp + 2 * i;
                    const unsigned kk = pk2(bflo(kw[pp * 4 + i]) * wsv, bfhi(kw[pp * 4 + i]) * wsv), vv = vw[pp * 4 + i];
                    const unsigned kn = (unsigned)dpp_i<0xB1>((int)kk), vn = (unsigned)dpp_i<0xB1>((int)vv);
                    *(LAS unsigned*)(L + O_KT + d * P2 + tb) = __builtin_amdgcn_perm(kk, kn, psel); *(LAS unsigned*)(L + O_VT + d * P2 + tb) = __builtin_amdgcn_perm(vv, vn, psel); }
        }
        sa[lane] = av; sg[lane] = gv;
        __syncthreads();
        bf16x8 qf[2];
#pragma unroll
        for (int ks = 0; ks < 2; ++ks) qf[ks] = *(const LAS bf16x8*)(L + O_Q + (16 * w4 + fr) * P2 + (32 * ks + 8 * fq) * 2);
        const int tt = 16 * w4 + fr;
        const float g_t = sg[tt];
        float rsum = 0.f;
#pragma unroll
        for (int c = 0; c < 4; ++c) {
            f32x4 s = (f32x4){0.f, 0.f, 0.f, 0.f};
#pragma unroll
            for (int ks = 0; ks < 2; ++ks) { const bf16x8 kf = *(const LAS bf16x8*)(L + O_K + (16 * c + fr) * P2 + (32 * ks + 8 * fq) * 2); s = __builtin_amdgcn_mfma_f32_16x16x32_bf16(kf, qf[ks], s, 0, 0, 0); }
            const f32x4 as4 = *(const LAS f32x4*)(sa + 16 * c + 4 * fq);
            float p[4];
#pragma unroll
            for (int i = 0; i < 4; ++i) { const int ss = 16 * c + 4 * fq + i; p[i] = (ss <= tt) ? s[i] * __expf(as4[i] - g_t) : 0.f; rsum += p[i]; }
            u32x2 pw; pw.x = pk2(p[0], p[1]); pw.y = pk2(p[2], p[3]);
            *(LAS u32x2*)(L + O_P + tt * P2 + (16 * c + 4 * fq) * 2) = pw;
        }
        rsum = sum_x16x32(rsum);
        float qn = 0.f;
        { const u32x4 qa = *(const LAS u32x4*)(L + O_Q + tt * P2 + (16 * fq) * 2), qb = *(const LAS u32x4*)(L + O_Q + tt * P2 + (16 * fq + 8) * 2);
          const LAS float* nv = (const LAS float*)(L + O_N + cb * 256) + 16 * fq;
          const f32x4 n0 = *(const LAS f32x4*)(nv), n1 = *(const LAS f32x4*)(nv + 4), n2 = *(const LAS f32x4*)(nv + 8), n3 = *(const LAS f32x4*)(nv + 12);
          qn = bflo(qa.x) * n0[0] + bfhi(qa.x) * n0[1] + bflo(qa.y) * n0[2] + bfhi(qa.y) * n0[3] + bflo(qa.z) * n1[0] + bfhi(qa.z) * n1[1] + bflo(qa.w) * n1[2] + bfhi(qa.w) * n1[3]
             + bflo(qb.x) * n2[0] + bfhi(qb.x) * n2[1] + bflo(qb.y) * n2[2] + bfhi(qb.y) * n2[3] + bflo(qb.z) * n3[0] + bfhi(qb.z) * n3[1] + bflo(qb.w) * n3[2] + bfhi(qb.w) * n3[3];
          qn = sum_x16x32(qn); }
        const float wi_t = __shfl(w_int, tt), em_t = __shfl(emt, tt);
        const float den = rsum + wi_t * qn;
        const float rden = 1.0f / fmaxf(fabsf(den), em_t);
        LDS_WAIT();
        bf16x8 pf[2];
#pragma unroll
        for (int ks = 0; ks < 2; ++ks) pf[ks] = *(const LAS bf16x8*)(L + O_P + tt * P2 + (32 * ks + 8 * fq) * 2);
        const int pos = 64 * chunk_mc(dir, j) + (dir == 0 ? tt : 63 - tt);
#pragma unroll
        for (int c = 0; c < 4; ++c) {
            f32x4 qc = (f32x4){0.f, 0.f, 0.f, 0.f}, pvv = (f32x4){0.f, 0.f, 0.f, 0.f};
#pragma unroll
            for (int ks = 0; ks < 2; ++ks) { const bf16x8 cf = *(const LAS bf16x8*)(L + O_CT + cb * TILE + (16 * c + fr) * P2 + (32 * ks + 8 * fq) * 2); qc = __builtin_amdgcn_mfma_f32_16x16x32_bf16(cf, qf[ks], qc, 0, 0, 0);
                const bf16x8 vf = *(const LAS bf16x8*)(L + O_VT + (16 * c + fr) * P2 + (32 * ks + 8 * fq) * 2); pvv = __builtin_amdgcn_mfma_f32_16x16x32_bf16(vf, pf[ks], pvv, 0, 0, 0); }
            const f32x4 hv = (pvv + qc * wi_t) * rden;
            *(GAS f32x4*)(HF + (size_t)pos * 64 + 16 * c + 4 * fq) = hv;
        }
        { bf16x8 vf[2];
#pragma unroll
          for (int ks = 0; ks < 2; ++ks) vf[ks] = *(const LAS bf16x8*)(L + O_VT + (16 * w4 + fr) * P2 + (32 * ks + 8 * fq) * 2);
#pragma unroll
          for (int c = 0; c < 4; ++c) { Cacc[c] = Cacc[c] * w_prev;
#pragma unroll
              for (int ks = 0; ks < 2; ++ks) { const bf16x8 kt = *(const LAS bf16x8*)(L + O_KT + (16 * c + fr) * P2 + (32 * ks + 8 * fq) * 2); Cacc[c] = __builtin_amdgcn_mfma_f32_16x16x32_bf16(kt, vf[ks], Cacc[c], 0, 0, 0); }
              u32x2 cw; cw.x = pk2(Cacc[c][0], Cacc[c][1]); cw.y = pk2(Cacc[c][2], Cacc[c][3]);
              *(LAS u32x2*)(L + O_CT + (cb ^ 1) * TILE + (16 * w4 + fr) * P2 + (16 * c + 4 * fq) * 2) = cw; }
          const u32x4 ka = *(const LAS u32x4*)(L + O_KT + (16 * w4 + fr) * P2 + (16 * fq) * 2), kb = *(const LAS u32x4*)(L + O_KT + (16 * w4 + fr) * P2 + (16 * fq + 8) * 2);
          float ksum = ((bflo(ka.x) + bfhi(ka.x)) + (bflo(ka.y) + bfhi(ka.y))) + ((bflo(ka.z) + bfhi(ka.z)) + (bflo(ka.w) + bfhi(ka.w)))
                     + ((bflo(kb.x) + bfhi(kb.x)) + (bflo(kb.y) + bfhi(kb.y))) + ((bflo(kb.z) + bfhi(kb.z)) + (bflo(kb.w) + bfhi(kb.w)));
          ksum = sum_x16x32(ksum);
          n_reg = w_prev * n_reg + ksum;
          if (fq == 0) ((LAS float*)(L + O_N + (cb ^ 1) * 256))[16 * w4 + fr] = n_reg; }
        m_prev = bend + G63;
        __syncthreads();
    }
#undef MLOAD
    VM_WAIT(); __threadfence_block(); __syncthreads();
    const GAS float* HF0 = (const GAS float*)a.HFB + ((size_t)((b * 4 + h) * 2)) * TKV * 64; const GAS float* HF1 = HF0 + (size_t)TKV * 64; const GAS bf16* gMO = (const GAS bf16*)a.MO; GAS unsigned char* gY = (GAS unsigned char*)a.Y;
    const int ch = tid & 7;
    for (int it0 = 0; it0 < TKV * 8 / 512; it0 += 4) {
        f32x4 a0[4], a1[4], b0[4], b1[4]; u32x4 ov[4];
#pragma unroll
        for (int u = 0; u < 4; ++u) { const int p = ((it0 + u) * 512 + tid) >> 3; const size_t row = (size_t)tok_row(b, p);
            a0[u] = *(const GAS f32x4*)(HF0 + (size_t)p * 64 + ch * 8); a1[u] = *(const GAS f32x4*)(HF0 + (size_t)p * 64 + ch * 8 + 4); b0[u] = *(const GAS f32x4*)(HF1 + (size_t)p * 64 + ch * 8); b1[u] = *(const GAS f32x4*)(HF1 + (size_t)p * 64 + ch * 8 + 4);
            ov[u] = *(const GAS u32x4*)(gMO + row * 256 + h * 64 + ch * 8); }
#pragma unroll
        for (int u = 0; u < 4; ++u) { const int p = ((it0 + u) * 512 + tid) >> 3; const size_t row = (size_t)tok_row(b, p);
            float y[8] = {bflo(ov[u].x) * (a0[u][0] + b0[u][0]), bfhi(ov[u].x) * (a0[u][1] + b0[u][1]), bflo(ov[u].y) * (a0[u][2] + b0[u][2]), bfhi(ov[u].y) * (a0[u][3] + b0[u][3]),
                          bflo(ov[u].z) * (a1[u][0] + b1[u][0]), bfhi(ov[u].z) * (a1[u][1] + b1[u][1]), bflo(ov[u].w) * (a1[u][2] + b1[u][2]), bfhi(ov[u].w) * (a1[u][3] + b1[u][3])};
            float ss = 0.f;
#pragma unroll
            for (int k = 0; k < 8; ++k) ss += y[k] * y[k];
            ss = sum_oct(ss);
            const float rs = __builtin_amdgcn_rsqf(ss * (1.0f / 64.0f) + EPS);
            const float rq = rs * YS; u32x2 w; w.x = pk_i8x4(y[0] * rq, y[1] * rq, y[2] * rq, y[3] * rq); w.y = pk_i8x4(y[4] * rq, y[5] * rq, y[6] * rq, y[7] * rq);
            *(GAS u32x2*)(gY + row * D + h * 64 + ch * 8) = w; }
    }
    __syncthreads();
}
}

namespace gmlp {
constexpr int VP = 272;
struct Args { const bf16* GU; const bf16* GV; const bf16* W; const float* gb; const float* gnorm; const float* mixn; bf16* Y; };
DI void item(LAS unsigned char* lds, const Args& a, size_t row0) {
    const int tid = opaque_tid(), wid = __builtin_amdgcn_readfirstlane(tid >> 6), lane = tid & 63, fr = lane & 15, fq = lane >> 4;
    { const int p = tid >> 2, part = tid & 3;
      const bf16* src = a.GV + (row0 + p) * 256 + 64 * part;
      u32x4 v[8]; float ss = 0.f;
#pragma unroll
      for (int i = 0; i < 8; ++i) { v[i] = *(const u32x4*)(src + 8 * i);
          ss += bflo(v[i].x) * bflo(v[i].x) + bfhi(v[i].x) * bfhi(v[i].x) + bflo(v[i].y) * bflo(v[i].y) + bfhi(v[i].y) * bfhi(v[i].y)
              + bflo(v[i].z) * bflo(v[i].z) + bfhi(v[i].z) * bfhi(v[i].z) + bflo(v[i].w) * bflo(v[i].w) + bfhi(v[i].w) * bfhi(v[i].w); }
      ss = sum_quad(ss);
      const float rs = __builtin_amdgcn_rsqf(ss * (1.0f / 256.0f) + EPS);
#pragma unroll
      for (int i = 0; i < 8; ++i) { const unsigned w[4] = {v[i].x, v[i].y, v[i].z, v[i].w};
#pragma unroll
          for (int k = 0; k < 4; ++k) { const int ch = 64 * part + 8 * i + 2 * k;
              const unsigned o = pk2(bflo(w[k]) * rs * a.gnorm[ch], bfhi(w[k]) * rs * a.gnorm[ch + 1]);
              *(LAS bf16*)(lds + ch * VP + 2 * p) = (bf16)(o & 0xffffu); *(LAS bf16*)(lds + (ch + 1) * VP + 2 * p) = (bf16)(o >> 16); } }
    }
    __syncthreads();
    const size_t row = row0 + 16 * wid + fr;
#pragma unroll 1
    for (int g = 0; g < 4; ++g) {
        bf16x8 wf[4];
#pragma unroll
        for (int ks = 0; ks < 4; ++ks) wf[ks] = *(const bf16x8*)(a.W + ((size_t)(g * 128 + 16 * wid + fr)) * 128 + 32 * ks + 8 * fq);
        const float bias = a.gb[g * 128 + 16 * wid + fr];
        f32x4 y[4]; float ss = 0.f;
#pragma unroll
        for (int ct = 0; ct < 4; ++ct) {
            f32x4 acc = (f32x4){0.f, 0.f, 0.f, 0.f};
#pragma unroll
            for (int ks = 0; ks < 4; ++ks) { const bf16x8 vf = *(const LAS bf16x8*)(lds + (64 * g + 16 * ct + fr) * VP + (32 * ks + 8 * fq) * 2); acc = __builtin_amdgcn_mfma_f32_16x16x32_bf16(vf, wf[ks], acc, 0, 0, 0); }
            const u32x2 uu = *(const u32x2*)(a.GU + row * 256 + 64 * g + 16 * ct + 4 * fq);
            y[ct][0] = bflo(uu.x) * (acc[0] + bias); y[ct][1] = bfhi(uu.x) * (acc[1] + bias); y[ct][2] = bflo(uu.y) * (acc[2] + bias); y[ct][3] = bfhi(uu.y) * (acc[3] + bias);
            ss += (y[ct][0] * y[ct][0] + y[ct][1] * y[ct][1]) + (y[ct][2] * y[ct][2] + y[ct][3] * y[ct][3]);
        }
        ss = sum_x16x32(ss);
        const float rs = __builtin_amdgcn_rsqf(ss * (1.0f / 64.0f) + EPS);
#pragma unroll
        for (int ct = 0; ct < 4; ++ct) { const float rq = rs * YS;
            *(unsigned*)((unsigned char*)a.Y + row * D + 256 + 64 * g + 16 * ct + 4 * fq) = pk_i8x4(y[ct][0] * rq, y[ct][1] * rq, y[ct][2] * rq, y[ct][3] * rq); }
    }
    __syncthreads();
}
}

DI int phys_head(int l) { return 128 * ((l >> 5) & 1) + 32 * (l >> 6) + 16 * ((l >> 2) & 1) + 4 * ((l >> 3) & 3) + (l & 3); }
DI int phys_glu(int c) { return 128 * ((c >> 3) & 1) + 32 * (c >> 6) + 16 * (c & 1) + 4 * ((c >> 4) & 3) + ((c >> 1) & 3); }
DI void tr_item_f8(const float* W, size_t ldw, int k0, size_t c0, unsigned char* WT8tile, int l0, LAS bf16* scr, int lane) {
    { const int kr = lane >> 4, c4 = lane & 15; const GAS float* Wg = (const GAS float*)W;
#pragma unroll 8
      for (int it = 0; it < 16; ++it) { const int kk = 4 * it + kr; const f32x4 v = *(const GAS f32x4*)(Wg + (size_t)(k0 + kk) * ldw + c0 + 4 * c4) * 64.0f;
          *(LAS unsigned*)(scr + kk * 66 + 4 * c4) = pk2(v[0], v[1]); *(LAS unsigned*)(scr + kk * 66 + 4 * c4 + 2) = pk2(v[2], v[3]); } }
    LDS_WAIT(); asm volatile("" ::: "memory");
    const int c = lane & 7;
#pragma unroll
    for (int jj = 0; jj < 8; ++jj) { const int o = (lane >> 3) + 8 * jj; const LAS bf16* s = scr + (8 * c) * 66 + o;
        u32x2 w; w.x = pk_fp8x4(bf2f(s[0]), bf2f(s[66]), bf2f(s[2 * 66]), bf2f(s[3 * 66])); w.y = pk_fp8x4(bf2f(s[4 * 66]), bf2f(s[5 * 66]), bf2f(s[6 * 66]), bf2f(s[7 * 66]));
        *(GAS u32x2*)((GAS unsigned char*)WT8tile + (size_t)phys_head(l0 + o) * 1024 + k0 + 8 * c) = w; }
    LDS_WAIT(); asm volatile("" ::: "memory");
}
DI void tr_item(const float* W, size_t ldw, int k0, size_t c0, bf16* WTtile, int l0, bool glu, LAS bf16* scr, int lane) {
#pragma unroll 8
    for (int kk = 0; kk < 64; ++kk) scr[kk * 66 + lane] = f2bf(W[(size_t)(k0 + kk) * ldw + c0 + lane]);
    LDS_WAIT(); asm volatile("" ::: "memory");
    const int c = lane & 7;
#pragma unroll
    for (int jj = 0; jj < 8; ++jj) { const int o = (lane >> 3) + 8 * jj; const LAS bf16* s = scr + (8 * c) * 66 + o;
        u32x4 w; w.x = (unsigned)s[0] | ((unsigned)s[66] << 16); w.y = (unsigned)s[2 * 66] | ((unsigned)s[3 * 66] << 16); w.z = (unsigned)s[4 * 66] | ((unsigned)s[5 * 66] << 16); w.w = (unsigned)s[6 * 66] | ((unsigned)s[7 * 66] << 16);
        const int pr = glu ? phys_glu(l0 + o) : phys_head(l0 + o);
        *(u32x4*)(WTtile + (size_t)pr * D + k0 + 8 * c) = w; }
    LDS_WAIT(); asm volatile("" ::: "memory");
}
DI void gu_item_i8(LAS unsigned char* lds, const float* W, size_t ldw, size_t c0, int cbk, bool glu, signed char* W8, float* CS, int tid, int wid, int lane, const float* rg = nullptr) {
    LAS bf16* scr = (LAS bf16*)lds; LAS float* cmx = (LAS float*)(lds + LDSCTL_OFF + 1024);
    { const int kr = lane >> 4, c4 = lane & 15; const GAS float* Wg = (const GAS float*)W;
      f32x4 mx = (f32x4){0.f, 0.f, 0.f, 0.f};
#pragma unroll 8
      for (int it = 0; it < 32; ++it) { const int k = 128 * wid + 4 * it + kr; f32x4 v = *(const GAS f32x4*)(Wg + (size_t)k * ldw + c0 + 4 * c4); if (rg) v = v * rg[k];
          mx[0] = fmaxf(mx[0], fabsf(v[0])); mx[1] = fmaxf(mx[1], fabsf(v[1])); mx[2] = fmaxf(mx[2], fabsf(v[2])); mx[3] = fmaxf(mx[3], fabsf(v[3]));
          *(LAS unsigned*)(scr + k * 66 + 4 * c4) = pk2(v[0], v[1]); *(LAS unsigned*)(scr + k * 66 + 4 * c4 + 2) = pk2(v[2], v[3]); }
#pragma unroll
      for (int j = 0; j < 4; ++j) mx[j] = max_x16x32(mx[j]);
      if (kr == 0) *(LAS f32x4*)(cmx + wid * 64 + 4 * c4) = mx; }
    __syncthreads();
    if (tid < 64) { float m = cmx[tid];
#pragma unroll
        for (int w = 1; w < 8; ++w) m = fmaxf(m, cmx[w * 64 + tid]);
        m = fmaxf(m, 1e-30f); cmx[512 + tid] = m; CS[(cbk >> 2) * 256 + (glu ? phys_glu((cbk & 3) * 64 + tid) : phys_head((cbk & 3) * 64 + tid))] = m * (1.0f / 127.0f); }
    __syncthreads();
#pragma unroll 2
    for (int it = 0; it < 8; ++it) { const int r = (it * 512 + tid) >> 6, o = 16 * (r & 3) + ((tid >> 2) & 15), kc = 4 * (r >> 2) + (tid & 3);
        const float qs = 127.0f / cmx[512 + o]; const LAS bf16* sp = scr + (16 * kc) * 66 + o;
        unsigned w[4];
#pragma unroll
        for (int g = 0; g < 4; ++g) { unsigned acc = 0;
#pragma unroll
            for (int i = 0; i < 4; ++i) { int q = (int)rintf(bf2f(sp[(4 * g + i) * 66]) * qs); q = q > 127 ? 127 : (q < -127 ? -127 : q); acc |= (unsigned)(q & 255) << (8 * i); }
            w[g] = acc; }
        *(GAS u32x4*)((GAS signed char*)W8 + ((size_t)((cbk >> 2) * 256 + (glu ? phys_glu((cbk & 3) * 64 + o) : phys_head((cbk & 3) * 64 + o)))) * 1024 + 16 * kc) = (u32x4){w[0], w[1], w[2], w[3]}; }
    __syncthreads();
}
DI void prologue(LAS unsigned char* lds, unsigned char* ws) {
    const KArgP ka = kargs();
#define in (ka->in)
    const int tid = opaque_tid(), wid = __builtin_amdgcn_readfirstlane(tid >> 6), lane = tid & 63;
    const int G = gridDim.x, B = opaque_bid();
    float* MOD = (float*)(ws + WS_MOD);
    if (B < 192) {
        LAS float* sl = (LAS float*)lds;
        LAS float* red = (LAS float*)(lds + 17 * 1024 * 4);
        for (int i = tid; i < 17 * 1024; i += 512) { const int r = i >> 10, k = i & 1023; const float v = r < 16 ? in.c[r * 1024 + k] : in.c_ctx[k]; sl[i] = v / (1.0f + __expf(-v)); }
        __syncthreads();
        for (int it = B; it < 192; it += G) {
            const int l = it / 48, cb = it % 48; const float* wp = in.w_ada + ((size_t)l * 1024 + 128 * wid) * 6144 + 128 * cb + 2 * lane;
            f32x2 acc[17];
#pragma unroll
            for (int r = 0; r < 17; ++r) acc[r] = (f32x2){0.f, 0.f};
#pragma unroll 4
            for (int k = 0; k < 128; ++k) { const f32x2 w = *(const f32x2*)(wp + (size_t)k * 6144);
#pragma unroll
                for (int r = 0; r < 17; ++r) { const float s = sl[r * 1024 + 128 * wid + k]; acc[r] = acc[r] + w * s; } }
            if (wid > 0) {
#pragma unroll
                for (int r = 0; r < 17; ++r) *(LAS f32x2*)(red + ((wid - 1) * 17 + r) * 128 + 2 * lane) = acc[r]; }
            __syncthreads();
            if (wid == 0) {
#pragma unroll
                for (int r = 0; r < 17; ++r) { f32x2 s = acc[r];
#pragma unroll
                    for (int w = 0; w < 7; ++w) s = s + *(const LAS f32x2*)(red + (w * 17 + r) * 128 + 2 * lane);
                    const f32x2 bb = *(const f32x2*)(in.b_ada + (size_t)l * 6144 + 128 * cb + 2 * lane);
                    *(f32x2*)(MOD + ((size_t)l * 17 + r) * 6144 + 128 * cb + 2 * lane) = s + bb; } }
            __syncthreads();
        }
    }
    __syncthreads();
    const size_t gt = (size_t)B * 512 + tid, gs = (size_t)G * 512;
    { float* rc = (float*)(ws + WS_ROPE); float* rs = rc + 65 * 16;
      if (gt < 16) { rc[64 * 16 + gt] = 1.0f; rs[64 * 16 + gt] = 0.0f; }
      for (size_t i = gt; i < (size_t)64 * 16; i += gs) { const int pos = (int)(i >> 4), k = (int)(i & 15); const float invf = powf(10000.0f, -(float)k / 16.0f);
          const float ang = (float)pos * invf; rc[i] = cosf(ang); rs[i] = sinf(ang); } }
    { bf16* WG = (bf16*)(ws + WS_WG);
      for (size_t i = gt; i < (size_t)DEPTH * 16 * 1024; i += gs) { const int l = (int)(i >> 14), n = (int)((i >> 10) & 15), k = (int)(i & 1023);
          const float v = in.w_in[((size_t)l * 1024 + k) * DIN + 1024 + n]; const bf16 hi = f2bf(v); WG[((size_t)(l * 2) * 16 + n) * 1024 + k] = hi; WG[((size_t)(l * 2 + 1) * 16 + n) * 1024 + k] = f2bf(v - bf2f(hi)); } }
    { bf16* WR = (bf16*)(ws + WS_WR);
      for (size_t i = gt; i < (size_t)DEPTH * 32 * 1024; i += gs) { const int l = (int)(i >> 15), n = (int)((i >> 10) & 31), k = (int)(i & 1023);
          const float v = in.router_w[((size_t)l * 1024 + k) * 32 + n]; const bf16 hi = f2bf(v); WR[((size_t)(l * 2) * 32 + n) * 1024 + k] = hi; WR[((size_t)(l * 2 + 1) * 32 + n) * 1024 + k] = f2bf(v - bf2f(hi)); } }
    { bf16* GW = (bf16*)(ws + WS_GWS);
      for (size_t i = gt; i < (size_t)DEPTH * 4 * 128 * 128; i += gs) GW[i] = f2bf(in.gmlp_ws[i]); }
    __syncthreads();
    for (int it = B; it < DEPTH * NE * 32; it += G) { const int le = it >> 5, cbk = it & 31;
        gu_item_i8(lds, in.w_gate_up + (size_t)le * 1024 * 2048, 2048, (size_t)cbk * 64, cbk, true, (signed char*)(ws + WS_WGU) + (size_t)le * 2048 * 1024, (float*)(ws + WS_CSGU) + (size_t)le * 2048, tid, wid, lane); }
    for (int it = B; it < DEPTH * 36; it += G) { const int l = it / 36, cbk = it % 36;
        gu_item_i8(lds, in.w_in + (size_t)l * 1024 * DIN, DIN, (size_t)cbk * 64 + (cbk >= 16 ? 16 : 0), cbk, false, (signed char*)(ws + WS_WIN) + (size_t)l * NPROJ * 1024, (float*)(ws + WS_CSIN) + (size_t)l * NPROJ, tid, wid, lane); }
    for (int it = B; it < DEPTH * 16; it += G) { const int l = it >> 4, cbk = it & 15;
        gu_item_i8(lds, in.w_out + (size_t)l * 1024 * 1024, 1024, (size_t)cbk * 64, cbk, false, (signed char*)(ws + WS_WOUT) + (size_t)l * 1024 * 1024, (float*)(ws + WS_CSOUT) + (size_t)l * 1024, tid, wid, lane, in.mix_norm + (size_t)l * 1024); }
    {
        LAS bf16* scr = (LAS bf16*)(lds + wid * (64 * 66 * 2));
        const int vcu = (G % 8 == 0) ? (B % 8) * (G / 8) + B / 8 : B;
        const long gw = (long)vcu * 8 + wid, NGW = (long)G * 8;
        constexpr long I_IN = 0, I_OUT = 0, I_GU = 0, I_DN = (long)DEPTH * NE * 16 * 16;
        for (long it = gw; it < I_IN + I_OUT + I_GU + I_DN; it += NGW) {
            long r = it;
            if (r < I_IN) { const int l = (int)(r / (36 * 16)), q = (int)(r % (36 * 16)), cbk = q >> 4, kb = q & 15;
                const size_t c0 = (size_t)cbk * 64 + (cbk >= 16 ? 16 : 0);
                tr_item(in.w_in + (size_t)l * 1024 * DIN, DIN, 64 * kb, c0, (bf16*)(ws + WS_WIN) + ((size_t)l * NPROJ + (size_t)(cbk >> 2) * 256) * D, (cbk & 3) * 64, false, scr, lane); continue; }
            r -= I_IN;
            if (r < I_OUT) { const int l = (int)(r >> 8), q = (int)(r & 255), cbk = q >> 4, kb = q & 15;
                tr_item_f8(in.w_out + (size_t)l * 1024 * 1024, 1024, 64 * kb, (size_t)cbk * 64, (unsigned char*)(ws + WS_WOUT) + ((size_t)l * 1024 + (size_t)(cbk >> 2) * 256) * D, (cbk & 3) * 64, scr, lane); continue; }
            r -= I_OUT;
            if (r < I_GU) { const int le = (int)(r >> 9), q = (int)(r & 511), cbk = q >> 4, kb = q & 15;
                tr_item(in.w_gate_up + (size_t)le * 1024 * 2048, 2048, 64 * kb, (size_t)cbk * 64, (bf16*)(ws + WS_WGU) + ((size_t)le * 2048 + (size_t)(cbk >> 2) * 256) * D, (cbk & 3) * 64, true, scr, lane); continue; }
            r -= I_GU;
            { const int le = (int)(r >> 8), q = (int)(r & 255), cbk = q >> 4, kb = q & 15;
                tr_item_f8(in.w_down + (size_t)le * 1024 * 1024, 1024, 64 * kb, (size_t)cbk * 64, (unsigned char*)(ws + WS_WDN) + ((size_t)le * 1024 + (size_t)(cbk >> 2) * 256) * D, (cbk & 3) * 64, scr, lane); }
        }
    }
    __syncthreads();
#undef in
}

DI void moe_convert_item(LAS unsigned char* lds, unsigned char* ws, int l, int it) {
    const int tid = opaque_tid(), wid = __builtin_amdgcn_readfirstlane(tid >> 6), lane = tid & 63;
    const KArgP ka = kargs();
    if (it < 1024) { const int le = l * NE + (it >> 5), cbk = it & 31;
        gu_item_i8(lds, (const float*)ka->in.w_gate_up + (size_t)le * 1024 * 2048, 2048, (size_t)cbk * 64, cbk, true, (signed char*)(ws + WS_WGU) + (size_t)le * 2048 * 1024, (float*)(ws + WS_CSGU) + (size_t)le * 2048, tid, wid, lane); }
    else { const int r = it - 1024, le = l * NE + (r >> 5), q = r & 31, cbk = q >> 1, kb = (q & 1) * 8 + wid;
        tr_item_f8((const float*)ka->in.w_down + (size_t)le * 1024 * 1024, 1024, 64 * kb, (size_t)cbk * 64, (unsigned char*)(ws + WS_WDN) + ((size_t)le * 1024 + (size_t)(cbk >> 2) * 256) * D, (cbk & 3) * 64, (LAS bf16*)(lds + wid * (64 * 66 * 2)), lane); }
}

constexpr int N_PHASES = 2 + 8 * DEPTH;
DI int q_next(unsigned* head, LAS int* bc) {
    if (opaque_tid() == 0) bc[0] = (int)__hip_atomic_fetch_add(head, 1u, RLX_AGENT);
    __syncthreads(); const int v = bc[0]; __syncthreads(); return v;
}
__global__ void __launch_bounds__(512, 2) mega_fwd(Args args) {
    extern __shared__ __attribute__((aligned(16))) unsigned char lds_raw[];
    LAS unsigned char* lds = (LAS unsigned char*)lds_raw;
    const int tid = threadIdx.x;
    volatile LAS unsigned* MISC = (volatile LAS unsigned*)(lds + LDSCTL_OFF);
    for (int u = tid; u < 64; u += 512) MISC[u] = 0u;
    __syncthreads();
    unsigned char* ws = kargs()->ws;
    unsigned* ctl = (unsigned*)(ws + WS_CTL);
    const int lo = kargs()->ph_lo, hi = kargs()->ph_hi;
    XcdBarrier bar; bar.bar = ctl + CW_BAR; bar.x = 0; bar.st = nullptr;
    if (hi - lo > 1) bar = xcd_barrier_post(ctl + CW_BAR, MISC + 8);
    LAS int* qbc = (LAS int*)(lds + LDSCTL_OFF + 128);
    const int G = gridDim.x;
#define IN(k) (lo <= (k) && (k) < hi)
#define SEAM(k) do { if (IN(k) && IN((k) + 1)) xcd_barrier(bar); } while (0)

#ifndef EN_MASK
#define EN_MASK 0xFFFF
#endif
#define EN(b) ((EN_MASK >> (b)) & 1)
#ifndef REP_MASK
#define REP_MASK 0
#endif
#ifndef DUP_MASK
#define DUP_MASK 0
#endif
#define NREP(b) (((REP_MASK >> (b)) & 1) ? 2 : 1)
    if (EN(0) && IN(0)) { for (int rep = 0; rep < NREP(0); ++rep) { prologue(lds, ws); SEAM(0); } }

    for (int l = 0; l < DEPTH; ++l) {
        const int pb = 1 + 8 * l;
        ws = opaque_ptr(ws);
        const float* modl = (const float*)(ws + WS_MOD) + (size_t)l * 17 * 6144;
        if (EN(1) && IN(pb)) {
            NormArgs a{}; const KArgP ka = kargs();
            a.xin = l == 0 ? nullptr : (const float*)(ws + WS_XLA + (size_t)((l - 1) & 1) * XL_BYTES); a.delta = l == 0 ? nullptr : (const bf16*)(ws + WS_H); a.dsc = (const float*)(ws + WS_DSC); a.x0 = ka->in.x; a.ctx0 = ka->in.ctx;
            a.mout = l == 0 ? nullptr : (const bf16*)(ws + WS_MOUT); a.msc = (const float*)(ws + WS_MSC); a.toks = (const int*)(ws + WS_TOKS); a.g2mod = modl - 17 * 6144;
            a.mod = modl; a.shi = 0; a.sci = 1; a.xout = (float*)(ws + WS_XLA + (size_t)(l & 1) * XL_BYTES); a.hout = nullptr; a.h8 = (signed char*)(ws + WS_H8); a.hs = (float*)(ws + WS_HS);
            a.wsm = (const bf16*)(ws + WS_WG) + (size_t)l * 2 * 16 * 1024; a.sbias = ka->in.b_in + (size_t)l * DIN + 1024; a.mg = (float*)(ws + WS_MG);
            for (int rep = 0; rep < NREP(1); ++rep) { norm_phase<0>(lds, a); SEAM(pb); }
        }
        if (EN(2) && IN(pb + 1)) {
            pg8::TileOrder S; S.init(NRT, NPROJ / 256, G, opaque_bid());
            SrcPlain8 src{(const char*)(ws + WS_WIN) + (size_t)l * NPROJ * D};
            { LAS float* rl_ = (LAS float*)(lds + ROPE_LDS_OFF); const float* rg_ = (const float*)(ws + WS_ROPE); const int t_ = opaque_tid();
              for (int i = t_; i < 2080; i += 512) rl_[i] = rg_[i];
              if (t_ < 128) rl_[2080 + t_] = (t_ < 64) ? kargs()->in.q_norm[l * 64 + t_] : kargs()->in.k_norm[l * 64 + t_ - 64];
              __syncthreads(); }
            EpiInProj E{ws, l, (const LAS float*)(lds + ROPE_LDS_OFF)};
            for (int rep = 0; rep < NREP(2); ++rep) { pg8::gemm_phase<EpiInProj, SrcPlain8, false, 1>(lds, (const bf16*)(ws + WS_H8), S, src, E); SEAM(pb + 1); }
        }
        if (IN(pb + 2)) {
            const float* mixn = kargs()->in.mix_norm + (size_t)l * D;
            if (EN(3)) for (int rep = 0; rep < NREP(3); ++rep) { mlstm::Args ma{(const bf16*)(ws + WS_MQ), (const bf16*)(ws + WS_MK), (const bf16*)(ws + WS_MV), (const bf16*)(ws + WS_MO), (const float*)(ws + WS_MG), (float*)(ws + WS_HFB), (bf16*)(ws + WS_Y), mixn};
              for (;;) { const int idx = q_next(ctl + CW_Q + 64 * ((rep * 4 + l) * 3 + 0), qbc); if (idx >= NB * 4) break; mlstm::item(lds, ma, idx >> 2, idx & 3); } }
            if (EN(4)) for (int rep = 0; rep < NREP(4); ++rep) { const int nlat = NB * 8 * 16, ntot = nlat + (l < DEPTH - 1 ? NB * 8 : 0);
              const unsigned char* AQ = (const unsigned char*)(ws + WS_AQ); const unsigned char* AK = (const unsigned char*)(ws + WS_AK); const bf16* AV = (const bf16*)(ws + WS_AV); unsigned char* Y = (unsigned char*)(ws + WS_Y);
              float gq = 0.f, gk = 0.f; { const int ln = opaque_tid() & 63; gq = fabsf(((const float*)kargs()->in.q_norm)[l * 64 + ln]); gk = fabsf(((const float*)kargs()->in.k_norm)[l * 64 + ln]); }
              const float sbound = 8.0f * wave_max(gq) * wave_max(gk) * 1.4426950408889634f * 1.13f;
#define ATT_LOOP(NM) for (;;) { const int idx = q_next(ctl + CW_Q + 64 * ((rep * 4 + l) * 3 + 1), qbc); if (idx >= ntot) break; \
                  int b, h, nt; size_t qrow; \
                  if (idx < nlat) { const int qb = idx & 15, hq = (idx >> 4) & 3, kvh = (idx >> 6) & 1; b = idx >> 7; h = kvh * 4 + hq; nt = TKV / 64; qrow = (size_t)NCTX + (size_t)b * T + (size_t)qb * 256; } \
                  else { const int i2 = idx - nlat; b = i2 >> 3; h = i2 & 7; nt = TC / 64; qrow = (size_t)b * TC; } \
                  const size_t kvo = (size_t)(b * 2 + (h >> 2)) * TKV * 64; \
                  attn_body::attn_unit<8, NM>(AQ + qrow * 512 + h * 64, AK + kvo, AV + kvo, nt, Y + qrow * D + 512 + h * 64, mixn + 512 + h * 64, (char*)lds_raw); }
              if (__builtin_amdgcn_readfirstlane(sbound < 100.0f ? 1 : 0)) { ATT_LOOP(true) } else { ATT_LOOP(false) }
#undef ATT_LOOP
              }
            if (EN(5)) for (int rep = 0; rep < NREP(5); ++rep) { gmlp::Args ga{(const bf16*)(ws + WS_GU), (const bf16*)(ws + WS_GV), (const bf16*)(ws + WS_GWS) + (size_t)l * 4 * 128 * 128, kargs()->in.gmlp_b + (size_t)l * 4 * 128, kargs()->in.gmlp_norm + (size_t)l * 256, mixn, (bf16*)(ws + WS_Y)};
              const int nlat = NB * 32, ntot = nlat + (l < DEPTH - 1 ? NB * 2 : 0);
              for (;;) { const int idx = q_next(ctl + CW_Q + 64 * ((rep * 4 + l) * 3 + 2), qbc); if (idx >= ntot) break;
                  const size_t row0 = idx < nlat ? (size_t)NCTX + (size_t)(idx >> 5) * T + (size_t)(idx & 31) * 128 : (size_t)((idx - nlat) >> 1) * TC + (size_t)((idx - nlat) & 1) * 128;
                  gmlp::item(lds, ga, row0); } }
            SEAM(pb + 2);
        }
        if (EN(6) && IN(pb + 3)) {
            pg8::TileOrder S; S.init(NRT, D / 256, G, opaque_bid());
            SrcPlain8 src{(const char*)(ws + WS_WOUT) + (size_t)l * D * D};
            EpiOutProj E{ws, l};
            for (int rep = 0; rep < NREP(6); ++rep) { pg8::gemm_phase<EpiOutProj, SrcPlain8, false, 1>(lds, (const bf16*)(ws + WS_Y), S, src, E); SEAM(pb + 3); }
        }
        if (EN(7) && IN(pb + 4)) {
            NormArgs a{};
            a.xin = (const float*)(ws + WS_XLA + (size_t)(l & 1) * XL_BYTES); a.delta = (const bf16*)(ws + WS_H); a.dsc = (const float*)(ws + WS_DSC); a.mout = nullptr; a.mod = modl; a.shi = 3; a.sci = 4; a.xout = nullptr; a.hout = nullptr; a.h8 = (signed char*)(ws + WS_H8); a.hs = (float*)(ws + WS_HS);
            a.wsm = (const bf16*)(ws + WS_WR) + (size_t)l * 2 * 32 * 1024; a.sbias = kargs()->in.router_b + (size_t)l * 32;
            a.toke = (int*)(ws + WS_TOKE); a.tokg = (float*)(ws + WS_TOKG); a.ghist = (int*)(ws + WS_GHIST); a.bhist = (int*)(ws + WS_BHIST); a.gs = (l == DEPTH - 1) ? NCTX / 16 : 0;
            for (int rep = 0; rep < NREP(7); ++rep) { norm_phase<1>(lds, a); SEAM(pb + 4); }
        }
        if (EN(8) && IN(pb + 5)) {
            ScatterArgs a{(const int*)(ws + WS_TOKE), (const float*)(ws + WS_TOKG), (const int*)(ws + WS_GHIST), (const int*)(ws + WS_BHIST), (int*)(ws + WS_TOKS), (int*)(ws + WS_SLTOK), (float*)(ws + WS_SLG), (int*)(ws + WS_RTE), (const float*)(ws + WS_HS), (float*)(ws + WS_SLS), (l == DEPTH - 1) ? NCTX / 16 : 0, (unsigned char*)(ws + WS_RTEB)};
            for (int rep = 0; rep < NREP(8); ++rep) { scatter_phase(lds, a); SEAM(pb + 5); }
        }
        if (EN(9) && IN(pb + 6)) {
            const int* rte = (const int*)(ws + WS_RTE);
            pg8::TileOrder S; S.init(__builtin_amdgcn_readfirstlane(rte[0]), 2 * DFF / 256, G, opaque_bid());
            SrcMoeGather src{ws, l};
            EpiGateUp E{ws, l};
            for (int rep = 0; rep < NREP(9); ++rep) { pg8::gemm_phase<EpiGateUp, SrcMoeGather, false, 1>(lds, (const bf16*)(ws + WS_H8), S, src, E); SEAM(pb + 6); }
        }
        if (EN(10) && IN(pb + 7)) {
            const int* rte = (const int*)(ws + WS_RTE);
            pg8::TileOrder S; S.init(__builtin_amdgcn_readfirstlane(rte[0]), D / 256, G, opaque_bid());
            SrcMoePlain src{ws, l};
            EpiDown E{ws, l};
            for (int rep = 0; rep < NREP(10); ++rep) { pg8::gemm_phase<EpiDown, SrcMoePlain, false, 2>(lds, (const bf16*)(ws + WS_ACT), S, src, E); SEAM(pb + 7); }
        }
    }
    if (EN(11) && IN(N_PHASES - 1)) {
        NormArgs a{};
        a.xin = (const float*)(ws + WS_XLA + (size_t)((DEPTH - 1) & 1) * XL_BYTES); a.delta = (const bf16*)(ws + WS_H); a.dsc = (const float*)(ws + WS_DSC); a.mout = (const bf16*)(ws + WS_MOUT); a.msc = (const float*)(ws + WS_MSC); a.toks = (const int*)(ws + WS_TOKS); a.g2mod = (const float*)(ws + WS_MOD) + (size_t)(DEPTH - 1) * 17 * 6144;
        a.fnorm = kargs()->in.final_norm; a.out = kargs()->out;
        norm_phase<2>(lds, a);
    }
#undef IN
#undef SEAM
}

extern "C" void kernel_launch(void* const* d_in, const int* in_sizes, int n_in, void* d_out, int out_size, void* d_ws, size_t ws_size, hipStream_t stream) {
    static int grid = 0;
    if (grid == 0) {
        if (n_in != 22 || out_size != NLAT * D || ws_size < WS_END) { fprintf(stderr, "kernel_launch: unexpected shapes (n_in %d, out %d, ws %zu, need %zu)\n", n_in, out_size, ws_size, (size_t)WS_END); grid = -1; return; }
        int dev = 0, cus = 0, per_cu = 0;
        if (hipGetDevice(&dev) != hipSuccess || hipDeviceGetAttribute(&cus, hipDeviceAttributeMultiprocessorCount, dev) != hipSuccess) { grid = -1; return; }
        if (hipFuncSetAttribute((const void*)mega_fwd, hipFuncAttributeMaxDynamicSharedMemorySize, LDS_BYTES) != hipSuccess) { fprintf(stderr, "kernel_launch: hipFuncSetAttribute failed\n"); grid = -1; return; }
        if (hipOccupancyMaxActiveBlocksPerMultiprocessor(&per_cu, (const void*)mega_fwd, 512, LDS_BYTES) != hipSuccess || per_cu < 1) { fprintf(stderr, "kernel_launch: occupancy query says %d\n", per_cu); per_cu = 1; }
        (void)hipGetLastError();
        grid = cus;
    }
    if (grid < 0) return;
    if (hipMemsetAsync((char*)d_ws + WS_CTL, 0, CTL_ZERO_BYTES, stream) != hipSuccess) return;
    Args a{};
    const float** ip = (const float**)&a.in;
    for (int i = 0; i < 22; ++i) ip[i] = (const float*)d_in[i];
    a.out = (float*)d_out; a.ws = (unsigned char*)d_ws;
#if MK_N_LAUNCHES == 1
    a.ph_lo = 0; a.ph_hi = N_PHASES;
    hipLaunchKernelGGL(mega_fwd, dim3(grid), dim3(512), LDS_BYTES, stream, a);
#else
    for (int p = 0; p < N_PHASES; ++p) { a.ph_lo = p; a.ph_hi = p + 1; hipLaunchKernelGGL(mega_fwd, dim3(grid), dim3(512), LDS_BYTES, stream, a); }
#endif
}
```

```cpp
#include <hip/hip_runtime.h>
#include <cstdio>
#include <cstdint>

#ifndef MK_N_LAUNCHES
#define MK_N_LAUNCHES 1
#endif

#define GAS __attribute__((address_space(1)))
#define LAS __attribute__((address_space(3)))
#define DI __device__ __forceinline__
typedef unsigned short bf16;
typedef short bf16x8 __attribute__((ext_vector_type(8)));
typedef float f32x4 __attribute__((ext_vector_type(4)));
typedef float f32x2 __attribute__((ext_vector_type(2)));
typedef unsigned u32x4 __attribute__((ext_vector_type(4)));
typedef int i32x4 __attribute__((ext_vector_type(4)));
typedef unsigned u32x2 __attribute__((ext_vector_type(2)));
typedef __bf16 bf16x2_t __attribute__((ext_vector_type(2)));
typedef GAS unsigned gu32;

constexpr int D = 1024, NB = 16, T = 4096, TC = 256, DEPTH = 4;
constexpr int NCTX = NB * TC;
constexpr int NLAT = NB * T;
constexpr int NTOK = NCTX + NLAT;
constexpr int NRT = NTOK / 256;
constexpr int TKV = TC + T;
constexpr int DIN = 2320, NPROJ = 2304;
constexpr int NE = 32, TOPK = 4, DFF = 1024;
constexpr int NSLOT_MAX = NTOK * TOPK + NE * 256;
constexpr int NRT_MOE_MAX = NSLOT_MAX / 256;
constexpr int NGRP = NTOK / 16;
constexpr float EPS = 1e-6f;
constexpr float C2 = 0.125f * 1.4426950408889634f;

constexpr size_t al256(size_t x) { return (x + 255) & ~(size_t)255; }
constexpr size_t WS_CTL = 0, CTL_ZERO_BYTES = 1u << 20;
constexpr size_t WS_WIN = CTL_ZERO_BYTES;
constexpr size_t WS_WOUT = WS_WIN + (size_t)DEPTH * NPROJ * D * 2;
constexpr size_t WS_WGU = WS_WOUT + (size_t)DEPTH * D * D * 2;
constexpr size_t WS_WDN = WS_WGU + (size_t)DEPTH * NE * 2 * DFF * D * 2;
constexpr size_t WS_WG = WS_WDN + (size_t)DEPTH * NE * D * DFF * 2;
constexpr size_t WS_WR = WS_WG + (size_t)DEPTH * 2 * 16 * D * 2;
constexpr size_t WS_GWS = WS_WR + (size_t)DEPTH * 2 * 32 * D * 2;
constexpr size_t WS_MOD = WS_GWS + (size_t)DEPTH * 4 * 128 * 128 * 2;
constexpr size_t WS_ROPE = al256(WS_MOD + (size_t)DEPTH * 17 * 6 * D * 4);
constexpr size_t WS_XLA = al256(WS_ROPE + (size_t)2 * 65 * 16 * 4);
constexpr size_t XL_BYTES = (size_t)NTOK * D * 2;
constexpr size_t WS_XLB = WS_XLA + (size_t)NTOK * D * 4;
constexpr size_t WS_H = WS_XLB + (size_t)NTOK * D * 4;
constexpr size_t WS_Y = WS_H + (size_t)NTOK * D * 2;
constexpr size_t WS_MQ = WS_Y + (size_t)NTOK * D * 2;
constexpr size_t WS_MK = WS_MQ + (size_t)NTOK * 256 * 2;
constexpr size_t WS_MV = WS_MK + (size_t)NTOK * 256 * 2;
constexpr size_t WS_MO = WS_MV + (size_t)NTOK * 256 * 2;
constexpr size_t WS_MG = WS_MO + (size_t)NTOK * 256 * 2;
constexpr size_t WS_GU = WS_MG + (size_t)NTOK * 16 * 4;
constexpr size_t WS_GV = WS_GU + (size_t)NTOK * 256 * 2;
constexpr size_t WS_AQ = WS_GV + (size_t)NTOK * 256 * 2;
constexpr size_t WS_AK = WS_AQ + (size_t)NTOK * 512 * 2;
constexpr size_t WS_AV = WS_AK + (size_t)NB * 2 * TKV * 64 * 2;
constexpr size_t WS_HFB = WS_AV + (size_t)NB * 2 * TKV * 64 * 2;
constexpr size_t WS_TOKE = WS_HFB + (size_t)NB * 4 * 2 * TKV * 64 * 4;
constexpr size_t WS_TOKG = WS_TOKE + (size_t)NTOK * 4 * 4;
constexpr size_t WS_TOKS = WS_TOKG + (size_t)NTOK * 4 * 4;
constexpr size_t WS_GHIST = WS_TOKS + (size_t)NTOK * 4 * 4;
constexpr size_t WS_BHIST = WS_GHIST + (size_t)NGRP * 32 * 4;
constexpr size_t WS_SLTOK = WS_BHIST + (size_t)1024 * 32 * 4;
constexpr size_t WS_SLG = WS_SLTOK + (size_t)NSLOT_MAX * 4;
constexpr size_t WS_RTE = WS_SLG + (size_t)NSLOT_MAX * 4;
constexpr size_t WS_RTEB = al256(WS_RTE + (size_t)(NRT_MOE_MAX + 64) * 4);
constexpr size_t WS_ACT = al256(WS_RTEB + 2048);
constexpr size_t WS_MOUT = WS_ACT + (size_t)NSLOT_MAX * DFF * 2;
constexpr size_t WS_CSGU = WS_MOUT + (size_t)NSLOT_MAX * D * 2;
constexpr size_t WS_H8 = WS_CSGU + (size_t)DEPTH * NE * 2 * DFF * 4;
constexpr size_t WS_HS = WS_H8 + (size_t)NTOK * D;
constexpr size_t WS_SLS = WS_HS + (size_t)NTOK * 4;
constexpr size_t WS_CSIN = al256(WS_SLS + (size_t)NSLOT_MAX * 4);
constexpr size_t WS_MSC = al256(WS_CSIN + (size_t)DEPTH * NPROJ * 4);
constexpr size_t WS_DSC = al256(WS_MSC + (size_t)NSLOT_MAX * 16 * 4);
constexpr size_t WS_CSOUT = al256(WS_DSC + (size_t)NTOK * 16 * 4);
constexpr size_t WS_END = al256(WS_CSOUT + (size_t)DEPTH * D * 4);
static_assert(WS_END < (size_t)4200 * 1000 * 1000, "workspace map exceeds 4x the largest input");

constexpr int CW_TMO = 0;
constexpr int CW_Q = 64;
constexpr int CW_BAR = 4096;

constexpr int SCR_BYTES = 135168;
constexpr int LDSCTL_OFF = SCR_BYTES;
constexpr int ROPE_LDS_OFF = LDSCTL_OFF + 4096 + 6144;
constexpr int LDS_BYTES = 155648;

#define LDS_WAIT() asm volatile("s_waitcnt lgkmcnt(0)" ::: "memory")
#define VM_WAIT() asm volatile("s_waitcnt vmcnt(0)" ::: "memory")
#define RLX_AGENT __ATOMIC_RELAXED, __HIP_MEMORY_SCOPE_AGENT
DI unsigned pk2(float lo, float hi) { f32x2 v = {lo, hi}; bf16x2_t b = __builtin_convertvector(v, bf16x2_t); return __builtin_bit_cast(unsigned, b); }
DI bf16 f2bf(float f) { return (bf16)(pk2(f, 0.f) & 0xffffu); }
DI float bf2f(unsigned b) { return __uint_as_float(b << 16); }
DI float bflo(unsigned w) { return __uint_as_float(w << 16); }
DI float bfhi(unsigned w) { return __uint_as_float(w & 0xffff0000u); }
DI int opaque_tid() { int t = threadIdx.x; asm volatile("" : "+v"(t)); return t; }
DI int opaque_bid() { int b = blockIdx.x; asm volatile("" : "+s"(b)); return b; }
template <class Tp> DI Tp* opaque_ptr(Tp* p) { asm volatile("" : "+s"(p)); return p; }
template <class Tp> DI const GAS Tp* uni(const GAS Tp* p) { const unsigned long long v = (unsigned long long)p; const unsigned lo = (unsigned)__builtin_amdgcn_readfirstlane((int)(unsigned)v), hi = (unsigned)__builtin_amdgcn_readfirstlane((int)(unsigned)(v >> 32)); return (const GAS Tp*)(((unsigned long long)hi << 32) | lo); }
template <class Tp> DI GAS Tp* uni(GAS Tp* p) { const unsigned long long v = (unsigned long long)p; const unsigned lo = (unsigned)__builtin_amdgcn_readfirstlane((int)(unsigned)v), hi = (unsigned)__builtin_amdgcn_readfirstlane((int)(unsigned)(v >> 32)); return (GAS Tp*)(((unsigned long long)hi << 32) | lo); }
DI unsigned pk_fp8x4(float a, float b, float c, float d) { int p = __builtin_amdgcn_cvt_pk_fp8_f32(fminf(fmaxf(a, -448.f), 448.f), fminf(fmaxf(b, -448.f), 448.f), 0, false); p = __builtin_amdgcn_cvt_pk_fp8_f32(fminf(fmaxf(c, -448.f), 448.f), fminf(fmaxf(d, -448.f), 448.f), p, true); return (unsigned)p; }
DI unsigned pk_i8x4(float a, float b, float c, float d) { const int q0 = (int)rintf(a), q1 = (int)rintf(b), q2 = (int)rintf(c), q3 = (int)rintf(d); return (unsigned)(q0 & 255) | ((unsigned)(q1 & 255) << 8) | ((unsigned)(q2 & 255) << 16) | ((unsigned)q3 << 24); }
constexpr float YS = 127.0f / 8.0f;
DI unsigned pk_fp8x4_nc(float a, float b, float c, float d) { int p = __builtin_amdgcn_cvt_pk_fp8_f32(a, b, 0, false); p = __builtin_amdgcn_cvt_pk_fp8_f32(c, d, p, true); return (unsigned)p; }
template <int CTRL> DI float dpp_f(float v) { return __builtin_bit_cast(float, __builtin_amdgcn_update_dpp(0, __builtin_bit_cast(int, v), CTRL, 0xF, 0xF, true)); }
template <int CTRL> DI int dpp_i(int v) { return __builtin_amdgcn_update_dpp(0, v, CTRL, 0xF, 0xF, true); }
DI float sum_x16(float v) { auto r = __builtin_amdgcn_permlane16_swap(__float_as_uint(v), __float_as_uint(v), false, false); return __uint_as_float(r[0]) + __uint_as_float(r[1]); }
DI float sum_x32(float v) { auto r = __builtin_amdgcn_permlane32_swap(__float_as_uint(v), __float_as_uint(v), false, false); return __uint_as_float(r[0]) + __uint_as_float(r[1]); }
DI float max_x16(float v) { auto r = __builtin_amdgcn_permlane16_swap(__float_as_uint(v), __float_as_uint(v), false, false); return fmaxf(__uint_as_float(r[0]), __uint_as_float(r[1])); }
DI float max_x32(float v) { auto r = __builtin_amdgcn_permlane32_swap(__float_as_uint(v), __float_as_uint(v), false, false); return fmaxf(__uint_as_float(r[0]), __uint_as_float(r[1])); }
DI float sum_x16x32(float v) { return sum_x32(sum_x16(v)); }
DI float max_x16x32(float v) { return max_x32(max_x16(v)); }
DI float sum_row16(float v) { v += dpp_f<0xB1>(v); v += dpp_f<0x4E>(v); v += dpp_f<0x141>(v); v += dpp_f<0x140>(v); return v; }
DI float max_row16(float v) { v = fmaxf(v, dpp_f<0xB1>(v)); v = fmaxf(v, dpp_f<0x4E>(v)); v = fmaxf(v, dpp_f<0x141>(v)); v = fmaxf(v, dpp_f<0x140>(v)); return v; }
DI float sum_oct(float v) { v += dpp_f<0xB1>(v); v += dpp_f<0x4E>(v); v += dpp_f<0x141>(v); return v; }
DI float sum_quad(float v) { v += dpp_f<0xB1>(v); v += dpp_f<0x4E>(v); return v; }
template <int CTRL, int RMASK> DI float dpp_id(float idv, float v) { return __builtin_bit_cast(float, __builtin_amdgcn_update_dpp(__builtin_bit_cast(int, idv), __builtin_bit_cast(int, v), CTRL, RMASK, 0xF, false)); }
DI float scan_sum64(float v) { v += dpp_id<0x111, 0xF>(0.f, v); v += dpp_id<0x112, 0xF>(0.f, v); v += dpp_id<0x114, 0xF>(0.f, v); v += dpp_id<0x118, 0xF>(0.f, v); v += dpp_id<0x142, 0xA>(0.f, v); v += dpp_id<0x143, 0xC>(0.f, v); return v; }
DI float scan_max64(float v) { const float ni = -INFINITY; v = fmaxf(v, dpp_id<0x111, 0xF>(ni, v)); v = fmaxf(v, dpp_id<0x112, 0xF>(ni, v)); v = fmaxf(v, dpp_id<0x114, 0xF>(ni, v)); v = fmaxf(v, dpp_id<0x118, 0xF>(ni, v));
    v = fmaxf(v, dpp_id<0x142, 0xA>(ni, v)); v = fmaxf(v, dpp_id<0x143, 0xC>(ni, v)); return v; }
DI float wave_sum(float v) { return sum_x16x32(sum_row16(v)); }
DI float wave_max(float v) { return max_x16x32(max_row16(v)); }
DI float fast_exp(float x) { return __builtin_amdgcn_exp2f(x * 1.4426950408889634f); }
DI float fast_sigmoid(float x) { return __builtin_amdgcn_rcpf(1.0f + fast_exp(-x)); }
DI float gelu_tanh(float x) { const float u = 0.7978845608028654f * (x + 0.044715f * x * x * x); return x * fast_sigmoid(2.0f * u); }
DI float log_sigmoid(float x) { return fminf(x, 0.f) - __builtin_amdgcn_logf(1.0f + fast_exp(-fabsf(x))) * 0.6931471805599453f; }
DI int mod_row(int row) { return row < NCTX ? 16 : ((row - NCTX) >> 12); }

#define XB_TMO      128
#define XB_XCNT(j)  (256  + 64 * (j))
#define XB_XSUB(j)  (1280 + 64 * (j))
#define XB_XGEN(j)  (2304 + 64 * (j))
#define XB_TOP      3328
#define XB_TOPGEN   3392
#define XCD_BAR_WORDS 3456
#define XB_SPIN_CAP (1u << 22)
DI unsigned xb_ld(unsigned* p)              { return __hip_atomic_load(p, __ATOMIC_RELAXED, __HIP_MEMORY_SCOPE_AGENT); }
DI unsigned xb_add(unsigned* p, unsigned v) { return __hip_atomic_fetch_add(p, v, __ATOMIC_RELAXED, __HIP_MEMORY_SCOPE_AGENT); }
DI unsigned xb_xcc_id() { return (unsigned)__builtin_amdgcn_s_getreg((3 << 11) | 20) & 0xFu; }
#define XB_SPIN(cond, bar) do { unsigned _sp = 0; while (cond) { __builtin_amdgcn_s_sleep(1); \
    if ((++_sp & 255u) == 0u) { if (xb_ld(&(bar)[XB_TMO])) break; if (_sp > XB_SPIN_CAP) { atomicAdd(&(bar)[XB_TMO], 1u); break; } } } } while (0)
struct XcdBarrier { unsigned* bar; unsigned x; volatile LAS unsigned* st; };
DI XcdBarrier xcd_barrier_post(unsigned* bar, volatile LAS unsigned* st) {
    XcdBarrier b; b.bar = bar; b.x = xb_xcc_id(); b.st = st;
    if (threadIdx.x == 0) (void)xb_add(&bar[XB_XCNT(b.x)], 1u);
    return b;
}
DI void xcd_barrier_complete(unsigned* bar, unsigned x, unsigned& nloc, unsigned& nx) {
    const unsigned G = gridDim.x * gridDim.y * gridDim.z;
    unsigned sum, cnt, mine, sp = 0u;
    for (;;) {
        sum = 0u; cnt = 0u; mine = 0u;
#pragma unroll
        for (unsigned j = 0; j < 16; ++j) { const unsigned c = xb_ld(&bar[XB_XCNT(j)]); sum += c; cnt += (c > 0u) ? 1u : 0u; mine = (j == x) ? c : mine; }
        if (sum == G) break;
        __builtin_amdgcn_s_sleep(1);
        if ((++sp & 255u) == 0u) { if (xb_ld(&bar[XB_TMO])) break; if (sp > XB_SPIN_CAP) { atomicAdd(&bar[XB_TMO], 1u); break; } }
    }
    nloc = mine > 0u ? mine : 1u; nx = cnt > 0u ? cnt : 1u;
}
DI void xcd_barrier(const XcdBarrier& b) {
    asm volatile("s_waitcnt vmcnt(0)" ::: "memory");
    __syncthreads();
    if (threadIdx.x == 0) {
        unsigned* bar = b.bar;
        __builtin_amdgcn_s_waitcnt(0);
        unsigned nloc = b.st[0], nx = b.st[1];
        if (nloc == 0u) { xcd_barrier_complete(bar, b.x, nloc, nx); b.st[0] = nloc; b.st[1] = nx; }
        const unsigned old = xb_add(&bar[XB_XSUB(b.x)], 1u);
        const unsigned gen = old / nloc;
        if (old + 1u == (gen + 1u) * nloc) {
            __builtin_amdgcn_fence(__ATOMIC_RELEASE, "agent");
            asm volatile("s_waitcnt vmcnt(0)" ::: "memory");
            const unsigned og = xb_add(&bar[XB_TOP], 1u);
            const unsigned tg = og / nx;
            if (og + 1u == (tg + 1u) * nx) xb_add(&bar[XB_TOPGEN], 1u);
            else XB_SPIN(xb_ld(&bar[XB_TOPGEN]) == tg, bar);
            __builtin_amdgcn_fence(__ATOMIC_ACQUIRE, "agent");
            xb_add(&bar[XB_XGEN(b.x)], 1u);
            asm volatile("s_waitcnt vmcnt(0)" ::: "memory");
        } else {
            XB_SPIN(xb_ld(&bar[XB_XGEN(b.x)]) == gen, bar);
            __builtin_amdgcn_fence(__ATOMIC_ACQUIRE, "agent");
            asm volatile("s_waitcnt vmcnt(0)" ::: "memory");
        }
    }
    __syncthreads();
}

namespace pg8 {
constexpr int BM = 256, BK = 64, HALF = 128, HTB = HALF * BK * 2, STAGE_BYTES = 8 * HTB, NXCD = 8, WGM = 8;
DI int lds_byte(int r, int c) { const int st = (r >> 4) * 2 + (c >> 5), rr = r & 15, cc = c & 31, ob = rr * 64 + cc * 2; return st * 1024 + (ob ^ (((ob >> 9) & 1) << 5)); }
DI void stage_rc(int b, int& R, int& C) { const int st = b / 1024, sb = b % 1024, swz = sb ^ (((sb >> 9) & 1) << 5); R = (st >> 1) * 16 + swz / 64; C = (st & 1) * 32 + (swz % 64) / 2; }
struct Unit { int pm, pn, e; };
DI void glds_s(const char* sbase_, unsigned voff, unsigned lds_dst) { unsigned keep; const unsigned long long sbase = (unsigned long long)sbase_;
    asm volatile("s_mov_b32 %0, m0\n\ts_mov_b32 m0, %3\n\ts_nop 0\n\tglobal_load_lds_dwordx4 %1, %2\n\ts_mov_b32 m0, %0" : "=&s"(keep) : "v"(voff), "s"(sbase), "s"(lds_dst) : "memory"); }
struct TileOrder {
    int nM, nN, nwg, G, c, pm0;
    DI void init(int nM_, int nN_, int G_, int c_, int pm0_ = 0) { nM = nM_; nN = nN_; nwg = nM * nN; G = G_; c = c_; pm0 = pm0_; }
    DI bool next(int i, Unit& u) const {
        const long L = (long)i * G + c; if (L >= nwg) return false;
        int wgid = (int)L; { const int q = nwg / NXCD, r = nwg % NXCD, xcd = wgid % NXCD, off = wgid / NXCD; wgid = (xcd < r ? xcd * (q + 1) : r * (q + 1) + (xcd - r) * q) + off; }
        const int nig = WGM * nN, gid = wgid / nig, fm = gid * WGM, gsz = (nM - fm) < WGM ? (nM - fm) : WGM;
        u.pm = pm0 + fm + ((wgid % nig) % gsz); u.pn = (wgid % nig) / gsz; return true;
    }
};
typedef int i32x8 __attribute__((ext_vector_type(8)));
DI f32x4 mma1(bf16x8 a, bf16x8 b, f32x4 c) { return __builtin_amdgcn_mfma_f32_16x16x32_bf16(a, b, c, 0, 0, 0); }
DI i32x4 mma1(bf16x8 a, bf16x8 b, i32x4 c) { return __builtin_amdgcn_mfma_i32_16x16x64_i8(__builtin_bit_cast(i32x4, a), __builtin_bit_cast(i32x4, b), c, 0, 0, 0); }
DI i32x8 cat8(bf16x8 a0, bf16x8 a1) { const i32x4 x0 = __builtin_bit_cast(i32x4, a0), x1 = __builtin_bit_cast(i32x4, a1); return __builtin_shufflevector(x0, x1, 0, 1, 2, 3, 4, 5, 6, 7); }
DI f32x4 mma_f8(i32x8 a, i32x8 b, f32x4 c) { asm volatile("v_mfma_f32_16x16x128_f8f6f4 %0, %1, %2, %0" : "+v"(c) : "v"(a), "v"(b)); return c; }
template <int QM> struct AccT { typedef f32x4 type; };
template <> struct AccT<1> { typedef i32x4 type; };
template <class Epi, class Src, bool DUP = false, int QM = 0>
DI void gemm_phase(LAS unsigned char* lds, const bf16* Abase, const TileOrder& S, const Src& src, const Epi& E) {
    const int tid = opaque_tid(), wid = __builtin_amdgcn_readfirstlane(tid >> 6), lane = tid & 63, wr = wid >> 2, wc = wid & 3, fr = lane & 15, fq = lane >> 4;
    unsigned voffB[2];
    constexpr unsigned RPB = QM ? 1024u : 2048u;
    constexpr int NT = QM ? 8 : 16;
    typedef typename AccT<QM>::type acc_t;
#pragma unroll
    for (int i = 0; i < 2; ++i) { int R_, C_; stage_rc(tid * 16 + i * 8192, R_, C_); voffB[i] = (unsigned)R_ * RPB + (unsigned)C_ * 2u; }
    constexpr size_t kstep = (size_t)(BK * 2), hstep = (size_t)HALF * RPB;
    const unsigned ldsb = (unsigned)(uintptr_t)lds + (unsigned)wid * 1024u;
    const int aoff = lds_byte(wr * 64 + fr, fq * 8), boff = lds_byte(wc * 32 + fr, fq * 8);
    const LAS unsigned char* ldsA = lds + aoff; const LAS unsigned char* ldsB = lds + 4 * HTB + boff;
    asm volatile("" : "+v"(ldsA), "+v"(ldsB));
#define PG8_SA(b, h) (((b) * 2 + (h)) * HTB)
#define PG8_SB(b, h) ((4 + (b) * 2 + (h)) * HTB)
#define PG8_SBR(b, h) (((b) * 2 + (h)) * HTB)
#define PG8_STAGEB(bufoff, gbase) do { _Pragma("unroll") for (int _i = 0; _i < 2; ++_i) \
        glds_s((const char*)(gbase), voffB[_i], ldsb + (unsigned)((bufoff) + _i * 8192)); } while (0)
#define PG8_STAGEA(bufoff, arr, hf, koff) do { _Pragma("unroll") for (int _i = 0; _i < 2; ++_i) \
        glds_s((const char*)Abase + (koff) + (Src::GATHER ? (size_t)0 : (size_t)(hf) * hstep), (arr)[Src::GATHER ? (hf) : 0][_i], ldsb + (unsigned)((bufoff) + _i * 8192)); } while (0)
#define PG8_LDA(dst, b, h) do { _Pragma("unroll") for (int m = 0; m < 4; ++m) { if constexpr (QM == 2) dst##8[m] = cat8(*(const LAS bf16x8*)(ldsA + PG8_SA(b, h) + m * 2048), *(const LAS bf16x8*)(ldsA + PG8_SA(b, h) + m * 2048 + 1024)); \
        else { _Pragma("unroll") for (int k = 0; k < 2; ++k) dst[m][k] = *(const LAS bf16x8*)(ldsA + PG8_SA(b, h) + m * 2048 + k * 1024); } } } while (0)
#define PG8_LDB(dst, b, h) do { _Pragma("unroll") for (int n = 0; n < 2; ++n) { if constexpr (QM == 2) dst##8[n] = cat8(*(const LAS bf16x8*)(ldsB + PG8_SBR(b, h) + n * 2048), *(const LAS bf16x8*)(ldsB + PG8_SBR(b, h) + n * 2048 + 1024)); \
        else { _Pragma("unroll") for (int k = 0; k < 2; ++k) dst[n][k] = *(const LAS bf16x8*)(ldsB + PG8_SBR(b, h) + n * 2048 + k * 1024); } } } while (0)
#define PG8_MMA(ai, bj, At, Bt) do { __builtin_amdgcn_s_setprio(1); _Pragma("unroll") for (int m = 0; m < 4; ++m) _Pragma("unroll") for (int n = 0; n < 2; ++n) { \
        if constexpr (QM == 2) acc[ai][bj][m][n] = mma_f8(Bt##8[n], At##8[m], acc[ai][bj][m][n]); \
        else { _Pragma("unroll") for (int k = 0; k < 2; ++k) acc[ai][bj][m][n] = mma1(Bt[n][k], At[m][k], acc[ai][bj][m][n]); } } __builtin_amdgcn_s_setprio(0); } while (0)
#define PG8_WAIT_V(n) asm volatile("s_waitcnt vmcnt(" #n ")" ::: "memory")
#define PG8_WAIT_L(n) asm volatile("s_waitcnt lgkmcnt(" #n ")" ::: "memory")
#define PG8_BAR __builtin_amdgcn_s_barrier()
#define PG8_SCHED __builtin_amdgcn_sched_barrier(0)
#define PG8_OFFS(dst, u) do { _Pragma("unroll") for (int _i = 0; _i < 2; ++_i) { int R_, C_; stage_rc(tid * 16 + _i * 8192, R_, C_); _Pragma("unroll") for (int _h = 0; _h < NH; ++_h) \
        dst[_h][_i] = (unsigned)src.arow(u, _h * HALF + R_) * RPB + (unsigned)C_ * 2u; } } while (0)
    Unit cur, nxt; int ui = 0;
    if (!S.next(0, cur)) return;
    LAS unsigned char* xtab = lds + STAGE_BYTES;
    const unsigned xtabb = (unsigned)(uintptr_t)lds + (unsigned)STAGE_BYTES;
#define PG8_IDXDMA(u, buf) do { if (wid == 0) glds_s(src.idx_base(), (unsigned)((u).pm * 1024 + lane * 16), xtabb + (unsigned)(buf) * 1024u); } while (0)
#define PG8_OFFS_LDS(dst, buf) do { _Pragma("unroll") for (int _i = 0; _i < 2; ++_i) { int R_, C_; stage_rc(tid * 16 + _i * 8192, R_, C_); _Pragma("unroll") for (int _h = 0; _h < 2; ++_h) \
        dst[_h][_i] = (unsigned)(*(const LAS int*)(xtab + (buf) * 1024 + (_h * HALF + R_) * 4)) * RPB + (unsigned)C_ * 2u; } } while (0)
#define PG8_EXPERT(u) (Src::EXPERT ? __builtin_amdgcn_readfirstlane((int)*(const LAS unsigned char*)(xtab + 2048 + (u).pm)) : 0)
    if constexpr (Src::EXPERT) {
        if (wid < 2) glds_s(src.rteb_base(), (unsigned)(wid * 1024 + lane * 16), xtabb + 2048u + (unsigned)wid * 1024u);
        if constexpr (Src::GATHER) { PG8_IDXDMA(cur, 0); Unit u1_; if (S.next(1, u1_)) PG8_IDXDMA(u1_, 1); }
        asm volatile("s_waitcnt vmcnt(0)" ::: "memory"); __builtin_amdgcn_s_barrier(); asm volatile("" ::: "memory");
    }
    cur.e = PG8_EXPERT(cur);
    const LAS unsigned char* etab = lds + LDSCTL_OFF + 4096; const unsigned etabb = (unsigned)(uintptr_t)lds + (unsigned)(LDSCTL_OFF + 4096);
#define PG8_ETAB(u, par) do { if constexpr (Epi::NTAB > 0) { if (wid >= 1 && wid <= Epi::NTAB) glds_s(E.tab(wid - 1, u), (unsigned)(lane * 16), etabb + (unsigned)(par) * 3072u + (unsigned)(wid - 1) * 1024u); } } while (0)
    acc_t acc[2][2][4][2];
#pragma unroll
    for (int a = 0; a < 2; ++a)
#pragma unroll
        for (int b = 0; b < 2; ++b)
#pragma unroll
            for (int m = 0; m < 4; ++m)
#pragma unroll
                for (int n = 0; n < 2; ++n) acc[a][b][m][n] = (acc_t){0, 0, 0, 0};
    bf16x8 At[4][2], B0[2][2], B1[2][2]; i32x8 At8[4], B08[2], B18[2];
    constexpr int NH = Src::GATHER ? 2 : 1;
    unsigned oA[NH][2], nO[NH][2];
    if constexpr (Src::GATHER) { PG8_OFFS_LDS(oA, 0); } else { PG8_OFFS(oA, cur); }
    const char* cB = src.bt(cur);
#define PG8_KOF(r, t) ((size_t)((((t) + (r)) & (NT - 1))) * kstep)
    int rc = (cur.pm + cur.pn) & (NT - 1), rn = rc;
    PG8_STAGEB(PG8_SB(0, 0), cB + PG8_KOF(rc, 0)); PG8_STAGEB(PG8_SB(0, 1), cB + hstep + PG8_KOF(rc, 0)); PG8_STAGEA(PG8_SA(0, 0), oA, 0, PG8_KOF(rc, 0)); PG8_STAGEA(PG8_SA(0, 1), oA, 1, PG8_KOF(rc, 0));
    if (wr == 1) PG8_BAR;
    PG8_WAIT_V(2); PG8_BAR;
    PG8_STAGEB(PG8_SB(1, 0), cB + PG8_KOF(rc, 1)); PG8_STAGEA(PG8_SA(1, 0), oA, 0, PG8_KOF(rc, 1)); PG8_STAGEB(PG8_SB(1, 1), cB + hstep + PG8_KOF(rc, 1));
    PG8_WAIT_V(6); PG8_BAR;
    for (;;) {
        const bool has_next = S.next(DUP ? ((ui + 1) >> 1) : (ui + 1), nxt);
        const char* nB = cB; rn = has_next ? ((nxt.pm + nxt.pn) & (NT - 1)) : rc;
        if (has_next) { nxt.e = PG8_EXPERT(nxt); if constexpr (Src::GATHER) { PG8_OFFS_LDS(nO, (ui + 1) & 1); } else { PG8_OFFS(nO, nxt); } nB = src.bt(nxt); }
        else {
#pragma unroll
            for (int h = 0; h < NH; ++h)
#pragma unroll
                for (int i = 0; i < 2; ++i) nO[h][i] = oA[h][i];
        }
        if constexpr (Src::GATHER) { Unit u2_; if (S.next(ui + 2, u2_)) PG8_IDXDMA(u2_, ui & 1); }
        PG8_ETAB(cur, ui & 1);
#pragma unroll 1
        for (int t = 0; t < NT; t += 2) {
            const bool last = (t == NT - 2);
            const size_t k1 = PG8_KOF(rc, t + 1), k2 = last ? PG8_KOF(rn, 0) : PG8_KOF(rc, t + 2), k3 = last ? PG8_KOF(rn, 1) : PG8_KOF(rc, t + 3);
            unsigned sx[NH][2];
#pragma unroll
            for (int h = 0; h < NH; ++h)
#pragma unroll
                for (int i = 0; i < 2; ++i) sx[h][i] = last ? nO[h][i] : oA[h][i];
            const char* b2 = (last ? nB : cB) + k2; const char* b3 = (last ? nB : cB) + k3;
            PG8_LDB(B0, 0, 0); PG8_LDB(B1, 0, 1); PG8_SCHED; PG8_LDA(At, 0, 0); PG8_STAGEA(PG8_SA(1, 1), oA, 1, k1);
            PG8_WAIT_V(8); PG8_WAIT_L(0); PG8_BAR; PG8_MMA(0, 0, At, B0); PG8_MMA(0, 1, At, B1); PG8_BAR; PG8_SCHED;
            PG8_LDA(At, 0, 1); PG8_STAGEB(PG8_SB(0, 0), b2); PG8_STAGEB(PG8_SB(0, 1), b2 + hstep); PG8_STAGEA(PG8_SA(0, 0), sx, 0, k2);
            PG8_WAIT_V(8); PG8_WAIT_L(0); PG8_BAR; PG8_MMA(1, 0, At, B0); PG8_MMA(1, 1, At, B1); PG8_BAR; PG8_SCHED;
            PG8_LDB(B0, 1, 0); PG8_LDB(B1, 1, 1); PG8_SCHED; PG8_LDA(At, 1, 0); PG8_STAGEA(PG8_SA(0, 1), sx, 1, k2);
            PG8_WAIT_V(8); PG8_WAIT_L(0); PG8_BAR; PG8_MMA(0, 0, At, B0); PG8_MMA(0, 1, At, B1); PG8_BAR; PG8_SCHED;
            PG8_LDA(At, 1, 1); PG8_STAGEB(PG8_SB(1, 0), b3); PG8_STAGEB(PG8_SB(1, 1), b3 + hstep); PG8_STAGEA(PG8_SA(1, 0), sx, 0, k3);
            PG8_WAIT_V(8); PG8_WAIT_L(0); PG8_BAR; PG8_MMA(1, 0, At, B0); PG8_MMA(1, 1, At, B1); PG8_BAR; PG8_SCHED;
        }
        if (wr == 0) PG8_BAR;
        if constexpr (QM == 2) asm volatile("s_nop 15\n\ts_nop 15" ::: "memory");
        if (!DUP || (ui & 1)) {
            if (DUP) {
#pragma unroll
                for (int a = 0; a < 2; ++a)
#pragma unroll
                    for (int b = 0; b < 2; ++b)
#pragma unroll
                        for (int m = 0; m < 4; ++m)
#pragma unroll
                            for (int n = 0; n < 2; ++n) acc[a][b][m][n] = acc[a][b][m][n] / 2;
            }
            E(acc, cur, wr, wc, fr, fq, etab + (ui & 1) * 3072);
        }
        if (!has_next) break;
        if (!DUP || (ui & 1)) {
#pragma unroll
        for (int a = 0; a < 2; ++a)
#pragma unroll
            for (int b = 0; b < 2; ++b)
#pragma unroll
                for (int m = 0; m < 4; ++m)
#pragma unroll
                    for (int n = 0; n < 2; ++n) acc[a][b][m][n] = (acc_t){0, 0, 0, 0};
        }
        cur = nxt; cB = nB; rc = rn; ++ui;
#pragma unroll
        for (int h = 0; h < NH; ++h)
#pragma unroll
            for (int i = 0; i < 2; ++i) oA[h][i] = nO[h][i];
        if (wr == 1) PG8_BAR;
    }
    PG8_WAIT_V(0);
    PG8_BAR;
#undef PG8_SA
#undef PG8_SB
#undef PG8_KOF
#undef PG8_SBR
#undef PG8_STAGEA
#undef PG8_STAGEB
#undef PG8_LDA
#undef PG8_LDB
#undef PG8_MMA
#undef PG8_WAIT_V
#undef PG8_WAIT_L
#undef PG8_BAR
#undef PG8_SCHED
#undef PG8_OFFS
#undef PG8_IDXDMA
#undef PG8_ETAB
#undef PG8_OFFS_LDS
#undef PG8_EXPERT
}
}

struct In { const float *x, *c, *ctx, *c_ctx, *w_ada, *b_ada, *w_in, *b_in, *q_norm, *k_norm, *gmlp_norm, *gmlp_ws, *gmlp_b, *mix_norm, *w_out, *router_w, *router_b, *w_gate_up, *b_gate_up, *w_down, *b_down, *final_norm; };
struct Args { In in; float* out; unsigned char* ws; int ph_lo, ph_hi; };
typedef const __attribute__((address_space(4))) Args* KArgP;
DI KArgP kargs() { KArgP p = (KArgP)__builtin_amdgcn_kernarg_segment_ptr(); asm volatile("" : "+s"(p)); return p; }

constexpr size_t TSTEP = (size_t)256 * D * 2;
template <size_t TS> struct SrcPlainT { static constexpr bool GATHER = false, EXPERT = false; const char* Bt;
    DI const char* idx_base() const { return nullptr; } DI const char* rteb_base() const { return nullptr; }
    DI int arow(const pg8::Unit& u, int r) const { return u.pm * 256 + r; }
    DI int expert(const pg8::Unit&) const { return 0; }
    DI const char* bt(const pg8::Unit& u) const { return Bt + (size_t)u.pn * TS; } };
typedef SrcPlainT<TSTEP> SrcPlain; typedef SrcPlainT<TSTEP / 2> SrcPlain8;
struct SrcMoeGather { static constexpr bool GATHER = true, EXPERT = true; unsigned char* ws; int l;
    DI const char* idx_base() const { return (const char*)(ws + WS_SLTOK); } DI const char* rteb_base() const { return (const char*)(ws + WS_RTEB); }
    DI int arow(const pg8::Unit& u, int r) const { return ((const int*)(ws + WS_SLTOK))[u.pm * 256 + r]; }
    DI int expert(const pg8::Unit& u) const { return __builtin_amdgcn_readfirstlane(((const int*)(ws + WS_RTE))[32 + u.pm]); }
    DI const char* bt(const pg8::Unit& u) const { return (const char*)(ws + WS_WGU) + ((size_t)(l * NE + u.e) * 8 + (size_t)u.pn) * (TSTEP / 2); } };
struct SrcMoePlain { static constexpr bool GATHER = false, EXPERT = true; unsigned char* ws; int l;
    DI const char* idx_base() const { return nullptr; } DI const char* rteb_base() const { return (const char*)(ws + WS_RTEB); }
    DI int arow(const pg8::Unit& u, int r) const { return u.pm * 256 + r; }
    DI int expert(const pg8::Unit& u) const { return __builtin_amdgcn_readfirstlane(((const int*)(ws + WS_RTE))[32 + u.pm]); }
    DI const char* bt(const pg8::Unit& u) const { return (const char*)(ws + WS_WDN) + ((size_t)(l * NE + u.e) * 4 + (size_t)u.pn) * (TSTEP / 2); } };

struct EpiInProj {
    unsigned char* ws; int l; const LAS float* rl;
    static constexpr int NTAB = 3;
    DI const char* tab(int k, const pg8::Unit& u) const {
        const char* t0 = (const char*)(kargs()->in.b_in + (size_t)l * DIN + (size_t)u.pn * 256 + (u.pn >= 4 ? 16 : 0));
        const char* t1 = (const char*)((const float*)(ws + WS_CSIN) + (size_t)l * NPROJ + (size_t)u.pn * 256);
        const char* t2 = (const char*)((const float*)(ws + WS_HS) + (size_t)u.pm * 256);
        return k == 0 ? t0 : (k == 1 ? t1 : t2); }
    DI void operator()(const i32x4 (&acc)[2][2][4][2], const pg8::Unit& u, int wr, int wc, int fr, int fq, const LAS unsigned char* et) const {
        const KArgP ka = kargs();
        const LAS float* bias = (const LAS float*)et;
        const LAS float* csp = (const LAS float*)(et + 1024) + 32 * wc + 4 * fq;
        const LAS float* hs = (const LAS float*)(et + 2048);
        f32x4 cs[2][2];
#pragma unroll
        for (int bj = 0; bj < 2; ++bj)
#pragma unroll
            for (int n = 0; n < 2; ++n) cs[bj][n] = *(const LAS f32x4*)(csp + 128 * bj + 16 * n);
        const int hh = u.pn * 4 + wc;
        const int lcol0 = hh * 64 + 8 * fq, ocol0 = lcol0 + (lcol0 >= 1024 ? 16 : 0);
        f32x4 bv[2][2];
#pragma unroll
        for (int bj = 0; bj < 2; ++bj)
#pragma unroll
            for (int n = 0; n < 2; ++n) bv[bj][n] = *(const LAS f32x4*)(bias + 64 * wc + 8 * fq + 32 * bj + 4 * n);
        const bool latent = u.pm >= 16;
        int op; bf16* base; int pitch, colb; bool kv = false;
        if (hh < 24) { const int ty = hh >> 2; op = (ty == 1) ? 1 : (ty == 3) ? 2 : (ty >= 4) ? 3 : 0;
            base = (bf16*)(ws + ((ty == 0) ? WS_MQ : (ty == 1) ? WS_MK : (ty == 2) ? WS_MV : (ty == 3) ? WS_MO : (ty == 4) ? WS_GU : WS_GV)); pitch = 256; colb = (hh & 3) * 64; }
        else if (hh < 32) { op = 4; base = (bf16*)(ws + WS_AQ); pitch = 512; colb = (hh - 24) * 64; }
        else { op = (hh < 34) ? 5 : 0; base = (bf16*)(ws + ((hh < 34) ? WS_AK : WS_AV)); pitch = 64; colb = 0; kv = true; }
        const int kvh = hh & 1;
        float rscs[2][4];
#pragma unroll
        for (int ai = 0; ai < 2; ++ai)
#pragma unroll
            for (int m = 0; m < 4; ++m) rscs[ai][m] = hs[ai * 128 + wr * 64 + m * 16 + fr];
        f32x4 xf[2][2][4][2];
#pragma unroll
        for (int ai = 0; ai < 2; ++ai)
#pragma unroll
            for (int m = 0; m < 4; ++m)
#pragma unroll
                for (int bj = 0; bj < 2; ++bj)
#pragma unroll
                    for (int n = 0; n < 2; ++n)
#pragma unroll
                        for (int j = 0; j < 4; ++j) xf[ai][bj][m][n][j] = (float)acc[ai][bj][m][n][j] * (rscs[ai][m] * cs[bj][n][j]) + bv[bj][n][j];
        asm volatile("" ::: "memory");
        f32x4 gn[2][2];
        if (op >= 4) { const LAS float* g = rl + 2080 + ((op == 4) ? 0 : 64);
#pragma unroll
            for (int bj = 0; bj < 2; ++bj)
#pragma unroll
                for (int n = 0; n < 2; ++n) gn[bj][n] = *(const LAS f32x4*)(g + 32 * bj + 8 * fq + 4 * n); }
#pragma unroll
        for (int ai = 0; ai < 2; ++ai)
#pragma unroll
            for (int m = 0; m < 4; ++m) {
                const int row = u.pm * 256 + ai * 128 + wr * 64 + m * 16 + fr;
                f32x4 v[2][2];
#pragma unroll
                for (int bj = 0; bj < 2; ++bj)
#pragma unroll
                    for (int n = 0; n < 2; ++n) v[bj][n] = xf[ai][bj][m][n];
                if (op == 1) {
#pragma unroll
                    for (int bj = 0; bj < 2; ++bj)
#pragma unroll
                        for (int n = 0; n < 2; ++n) v[bj][n] = v[bj][n] * 0.125f;
                } else if (op == 2) {
#pragma unroll
                    for (int bj = 0; bj < 2; ++bj)
#pragma unroll
                        for (int n = 0; n < 2; ++n)
#pragma unroll
                            for (int j = 0; j < 4; ++j) v[bj][n][j] = fast_sigmoid(v[bj][n][j]);
                } else if (op == 3) {
#pragma unroll
                    for (int bj = 0; bj < 2; ++bj)
#pragma unroll
                        for (int n = 0; n < 2; ++n)
#pragma unroll
                            for (int j = 0; j < 4; ++j) v[bj][n][j] = gelu_tanh(v[bj][n][j]);
                } else if (op >= 4) {
                    float ss = 0.f;
#pragma unroll
                    for (int bj = 0; bj < 2; ++bj)
#pragma unroll
                        for (int n = 0; n < 2; ++n) ss += (v[bj][n][0] * v[bj][n][0] + v[bj][n][1] * v[bj][n][1]) + (v[bj][n][2] * v[bj][n][2] + v[bj][n][3] * v[bj][n][3]);
                    ss = sum_x16x32(ss);
                    const float rs = __builtin_amdgcn_rsqf(ss * (1.0f / 64.0f) + EPS);
#pragma unroll
                    for (int bj = 0; bj < 2; ++bj)
#pragma unroll
                        for (int n = 0; n < 2; ++n) v[bj][n] = v[bj][n] * rs * gn[bj][n];
                    { const int t = (row - NCTX) & (T - 1); const int pos = latent ? ((fq < 2) ? (t >> 6) : (t & 63)) : 64;
                        const LAS float* rp = rl + pos * 16 + 8 * (fq & 1);
#pragma unroll
                        for (int n = 0; n < 2; ++n) { const f32x4 c = *(const LAS f32x4*)(rp + 4 * n), s = *(const LAS f32x4*)(rp + 1040 + 4 * n);
                            const f32x4 x1 = v[0][n], x2 = v[1][n]; v[0][n] = x1 * c - x2 * s; v[1][n] = x2 * c + x1 * s; } }
                    if (op == 4) {
#pragma unroll
                        for (int bj = 0; bj < 2; ++bj)
#pragma unroll
                            for (int n = 0; n < 2; ++n) v[bj][n] = v[bj][n] * C2; }
                }
                size_t drow;
                if (kv) { int b, p; if (latent) { const int r2 = row - NCTX; b = r2 >> 12; p = TC + (r2 & (T - 1)); } else { b = row >> 8; p = row & 255; }
                    drow = (size_t)((b * 2 + kvh) * TKV + p); }
                else drow = (size_t)row;
                if (op >= 4) {
                    unsigned char* dp8 = (unsigned char*)base + drow * pitch + colb + 8 * fq;
#pragma unroll
                    for (int bj = 0; bj < 2; ++bj) { u32x2 w; w.x = pk_fp8x4(v[bj][0][0], v[bj][0][1], v[bj][0][2], v[bj][0][3]); w.y = pk_fp8x4(v[bj][1][0], v[bj][1][1], v[bj][1][2], v[bj][1][3]);
                        *(u32x2*)(dp8 + 32 * bj) = w; }
                } else {
                bf16* dp = base + drow * pitch + colb + 8 * fq;
#pragma unroll
                for (int bj = 0; bj < 2; ++bj) { u32x4 w; w.x = pk2(v[bj][0][0], v[bj][0][1]); w.y = pk2(v[bj][0][2], v[bj][0][3]); w.z = pk2(v[bj][1][0], v[bj][1][1]); w.w = pk2(v[bj][1][2], v[bj][1][3]);
                    *(u32x4*)(dp + 32 * bj) = w; }
                }
                asm volatile("" ::: "memory");
            }
    }
};
struct EpiOutProj {
    unsigned char* ws; int l;
    static constexpr int NTAB = 2;
    DI const char* tab(int k, const pg8::Unit& u) const { const int mrow = u.pm < 16 ? 16 : ((u.pm - 16) >> 4);
        const char* t0 = (const char*)((const float*)(ws + WS_MOD) + (size_t)l * 17 * 6144 + (size_t)mrow * 6 * D + 2 * D + (size_t)u.pn * 256);
        const char* t1 = (const char*)((const float*)(ws + WS_CSOUT) + (size_t)l * D + (size_t)u.pn * 256);
        return k == 0 ? t0 : t1; }
    DI void operator()(const i32x4 (&acc)[2][2][4][2], const pg8::Unit& u, int wr, int wc, int fr, int fq, const LAS unsigned char* et) const {
        GAS signed char* dout = (GAS signed char*)(ws + WS_H); GAS float* dsc = (GAS float*)(ws + WS_DSC);
        const int c0 = u.pn * 256 + 64 * wc + 8 * fq;
        const LAS float* g1 = (const LAS float*)et + 64 * wc + 8 * fq;
        f32x4 gv[2][2];
#pragma unroll
        for (int bj = 0; bj < 2; ++bj)
#pragma unroll
            for (int n = 0; n < 2; ++n) gv[bj][n] = *(const LAS f32x4*)(g1 + 32 * bj + 4 * n) * *(const LAS f32x4*)((const LAS float*)(et + 1024) + 32 * wc + 4 * fq + 128 * bj + 16 * n) * (1.0f / YS);
#pragma unroll
        for (int ai = 0; ai < 2; ++ai)
#pragma unroll
            for (int m = 0; m < 4; ++m) { const size_t row = (size_t)(u.pm * 256 + ai * 128 + wr * 64 + m * 16 + fr);
                f32x4 v[2][2]; float am = 0.f;
#pragma unroll
                for (int bj = 0; bj < 2; ++bj)
#pragma unroll
                    for (int n = 0; n < 2; ++n) { v[bj][n] = gv[bj][n] * (f32x4){(float)acc[ai][bj][m][n][0], (float)acc[ai][bj][m][n][1], (float)acc[ai][bj][m][n][2], (float)acc[ai][bj][m][n][3]};
                        am = fmaxf(am, fmaxf(fmaxf(fabsf(v[bj][n][0]), fabsf(v[bj][n][1])), fmaxf(fabsf(v[bj][n][2]), fabsf(v[bj][n][3])))); }
                am = max_x16x32(am);
                const float qs = 127.0f / fmaxf(am, 1e-30f);
#pragma unroll
                for (int bj = 0; bj < 2; ++bj) { u32x2 w;
#pragma unroll
                    for (int n = 0; n < 2; ++n) { const int q0 = (int)rintf(v[bj][n][0] * qs), q1 = (int)rintf(v[bj][n][1] * qs), q2 = (int)rintf(v[bj][n][2] * qs), q3 = (int)rintf(v[bj][n][3] * qs);
                        w[n] = (unsigned)(q0 & 255) | ((unsigned)(q1 & 255) << 8) | ((unsigned)(q2 & 255) << 16) | ((unsigned)(q3 & 255) << 24); }
                    *(GAS u32x2*)(dout + row * D + c0 + 32 * bj) = w; }
                if (fq == 0) dsc[row * 16 + u.pn * 4 + wc] = am * (1.0f / 127.0f); }
    }
};
struct EpiGateUp {
    unsigned char* ws; int l;
    static constexpr int NTAB = 3;
    DI const char* tab(int k, const pg8::Unit& u) const {
        const char* t0 = (const char*)(kargs()->in.b_gate_up + ((size_t)(l * NE + u.e) * 2 * DFF + (size_t)u.pn * 256));
        const char* t1 = (const char*)((const float*)(ws + WS_CSGU) + ((size_t)(l * NE + u.e) * 2 * DFF + (size_t)u.pn * 256));
        const char* t2 = (const char*)((const float*)(ws + WS_SLS) + (size_t)u.pm * 256);
        return k == 0 ? t0 : (k == 1 ? t1 : t2); }
    DI void operator()(const i32x4 (&acc)[2][2][4][2], const pg8::Unit& u, int wr, int wc, int fr, int fq, const LAS unsigned char* et) const {
        GAS unsigned char* act = (GAS unsigned char*)(ws + WS_ACT);
        const int f0 = u.pn * 128 + 32 * wc + 8 * fq;
        const LAS float* bp = (const LAS float*)et + 2 * (32 * wc + 8 * fq);
        const LAS float* csp = (const LAS float*)(et + 1024) + 32 * wc + 4 * fq;
        const LAS float* sls = (const LAS float*)(et + 2048);
        f32x4 bb[2][2], cs[2][2];
#pragma unroll
        for (int bj = 0; bj < 2; ++bj) { bb[bj][0] = *(const LAS f32x4*)(bp + 8 * bj); bb[bj][1] = *(const LAS f32x4*)(bp + 8 * bj + 4);
            cs[bj][0] = *(const LAS f32x4*)(csp + 128 * bj); cs[bj][1] = *(const LAS f32x4*)(csp + 128 * bj + 16); }
        float rss[2][4];
#pragma unroll
        for (int ai = 0; ai < 2; ++ai)
#pragma unroll
            for (int m = 0; m < 4; ++m) rss[ai][m] = sls[ai * 128 + wr * 64 + m * 16 + fr];
        constexpr float KE = -1.702f * 1.4426950408889634f;
#pragma unroll
        for (int ai = 0; ai < 2; ++ai)
#pragma unroll
            for (int m = 0; m < 4; ++m) { const size_t srow = (size_t)(u.pm * 256 + ai * 128 + wr * 64 + m * 16 + fr); const float rs = rss[ai][m];
                f32x2 av[2][2];
#pragma unroll
                for (int bj = 0; bj < 2; ++bj)
#pragma unroll
                    for (int jp = 0; jp < 2; ++jp) {
                        const f32x2 g = {(float)acc[ai][bj][m][0][2 * jp], (float)acc[ai][bj][m][0][2 * jp + 1]}, lv = {(float)acc[ai][bj][m][1][2 * jp], (float)acc[ai][bj][m][1][2 * jp + 1]};
                        const f32x2 sg = (f32x2){cs[bj][0][2 * jp], cs[bj][0][2 * jp + 1]} * rs, sl = (f32x2){cs[bj][1][2 * jp], cs[bj][1][2 * jp + 1]} * rs;
                        const f32x2 bg = {bb[bj][jp][0], bb[bj][jp][2]}, bl = {bb[bj][jp][1], bb[bj][jp][3]};
                        const f32x2 xg = __builtin_elementwise_min(g * sg + bg, (f32x2){7.0f, 7.0f});
                        const f32x2 xl = __builtin_elementwise_min(__builtin_elementwise_max(lv * sl + bl, (f32x2){-7.0f, -7.0f}), (f32x2){7.0f, 7.0f});
                        const f32x2 z = xg * KE; f32x2 ex; ex.x = __builtin_amdgcn_exp2f(z.x); ex.y = __builtin_amdgcn_exp2f(z.y);
                        const f32x2 dn = ex + 1.0f; f32x2 sig; sig.x = __builtin_amdgcn_rcpf(dn.x); sig.y = __builtin_amdgcn_rcpf(dn.y);
                        av[bj][jp] = (xg * sig) * (xl * 4.0f + 4.0f); }
                u32x2 w; w.x = pk_fp8x4_nc(av[0][0].x, av[0][0].y, av[0][1].x, av[0][1].y); w.y = pk_fp8x4_nc(av[1][0].x, av[1][0].y, av[1][1].x, av[1][1].y);
                *(GAS u32x2*)(act + srow * DFF + f0) = w; }
    }
};
struct EpiDown {
    unsigned char* ws; int l;
    static constexpr int NTAB = 2;
    DI const char* tab(int k, const pg8::Unit& u) const {
        const char* t0 = (const char*)(kargs()->in.b_down + ((size_t)(l * NE + u.e) * D + (size_t)u.pn * 256));
        const char* t1 = (const char*)((const float*)(ws + WS_SLG) + (size_t)u.pm * 256);
        return k == 0 ? t0 : t1; }
    DI void operator()(const f32x4 (&acc)[2][2][4][2], const pg8::Unit& u, int wr, int wc, int fr, int fq, const LAS unsigned char* et) const {
        GAS signed char* mout = (GAS signed char*)(ws + WS_MOUT); GAS float* msc = (GAS float*)(ws + WS_MSC);
        const int c0 = u.pn * 256 + 64 * wc + 8 * fq;
        const LAS float* bp = (const LAS float*)et + 64 * wc + 8 * fq; const LAS float* slg = (const LAS float*)(et + 1024);
        f32x4 bv[2][2];
#pragma unroll
        for (int bj = 0; bj < 2; ++bj)
#pragma unroll
            for (int n = 0; n < 2; ++n) bv[bj][n] = *(const LAS f32x4*)(bp + 32 * bj + 4 * n);
        float gts[2][4];
#pragma unroll
        for (int ai = 0; ai < 2; ++ai)
#pragma unroll
            for (int m = 0; m < 4; ++m) gts[ai][m] = slg[ai * 128 + wr * 64 + m * 16 + fr];
#pragma unroll
        for (int ai = 0; ai < 2; ++ai)
#pragma unroll
            for (int m = 0; m < 4; ++m) { const size_t srow = (size_t)(u.pm * 256 + ai * 128 + wr * 64 + m * 16 + fr); const float gt = gts[ai][m], g256 = gt * (1.0f / 256.0f);
                f32x4 v[2][2]; float am = 0.f;
#pragma unroll
                for (int bj = 0; bj < 2; ++bj)
#pragma unroll
                    for (int n = 0; n < 2; ++n) { v[bj][n] = acc[ai][bj][m][n] * g256 + bv[bj][n] * gt;
                        am = fmaxf(am, fmaxf(fmaxf(fabsf(v[bj][n][0]), fabsf(v[bj][n][1])), fmaxf(fabsf(v[bj][n][2]), fabsf(v[bj][n][3])))); }
                am = max_x16x32(am);
                const float qs = 127.0f / fmaxf(am, 1e-30f);
#pragma unroll
                for (int bj = 0; bj < 2; ++bj) { u32x2 w;
#pragma unroll
                    for (int n = 0; n < 2; ++n) { const int q0 = (int)rintf(v[bj][n][0] * qs), q1 = (int)rintf(v[bj][n][1] * qs), q2 = (int)rintf(v[bj][n][2] * qs), q3 = (int)rintf(v[bj][n][3] * qs);
                        w[n] = (unsigned)(q0 & 255) | ((unsigned)(q1 & 255) << 8) | ((unsigned)(q2 & 255) << 16) | ((unsigned)(q3 & 255) << 24); }
                    *(GAS u32x2*)(mout + srow * D + c0 + 32 * bj) = w; }
                if (fq == 0) msc[srow * 16 + u.pn * 4 + wc] = am * (1.0f / 127.0f); }
    }
};

struct NormArgs {
    const float* xin; const float* x0; const float* ctx0;
    const bf16* delta; const float* dsc;
    const bf16* mout; const float* msc; const int* toks; const float* g2mod;
    const float* mod; int shi, sci;
    float* xout; bf16* hout; signed char* h8; float* hs;
    const bf16* wsm; const float* sbias;
    float* mg;
    int* toke; float* tokg; int* ghist; int* bhist;
    const float* fnorm; float* out;
    int gs;
};
template <int MODE>
DI void norm_phase(LAS unsigned char* lds, const NormArgs& a) {
    constexpr int NS = (MODE == 0) ? 16 : 32, NBK = NS / 16, TP = 2064, RP = 36;
    const int tid = opaque_tid(), wid = __builtin_amdgcn_readfirstlane(tid >> 6), lane = tid & 63, fr = lane & 15, fq = lane >> 4;
    const GAS float* gxin = (const GAS float*)a.xin; const GAS float* gx0 = (const GAS float*)a.x0; const GAS float* gctx0 = (const GAS float*)a.ctx0; const GAS bf16* gdelta = (const GAS bf16*)a.delta;
    const GAS float* gdsc = (const GAS float*)a.dsc; const GAS float* gmsc = (const GAS float*)a.msc; const GAS bf16* gmout = (const GAS bf16*)a.mout; const GAS int* gtoks = (const GAS int*)a.toks; const GAS float* gg2mod = (const GAS float*)a.g2mod; const GAS float* gmod = (const GAS float*)a.mod;
    GAS float* gxout = (GAS float*)a.xout; GAS signed char* gh8 = (GAS signed char*)a.h8; GAS float* ghs = (GAS float*)a.hs; const GAS float* gfnorm = (const GAS float*)a.fnorm; GAS float* gout = (GAS float*)a.out;
    LAS unsigned char* Thi = lds; LAS unsigned char* Tlo = lds + 16 * TP;
    LAS float* red = (LAS float*)(lds + 2 * 16 * TP);
    LAS int* hist = (LAS int*)(lds + 2 * 16 * TP + 8 * 16 * RP * 4);
    const int G = gridDim.x, bid = opaque_bid(), per = (NGRP - a.gs + G - 1) / G, g0 = a.gs + bid * per, g1 = (g0 + per < NGRP) ? g0 + per : NGRP;
    bf16x8 Bh[4][NBK], Bl[4][NBK];
    if (MODE == 1) {
#pragma unroll
        for (int s = 0; s < 4; ++s)
#pragma unroll
            for (int nb = 0; nb < NBK; ++nb) { const size_t o = (size_t)(nb * 16 + fr) * D + 128 * wid + 32 * s + 8 * fq;
                Bh[s][nb] = *(const bf16x8*)(a.wsm + o); Bl[s][nb] = *(const bf16x8*)(a.wsm + (size_t)NS * D + o); }
    }
    int blk = 0;
    if (MODE == 1) { if (tid < 32) hist[tid] = 0; }
    f32x4 xv[2][4]; unsigned dv[2][4]; float ds[2][2]; i32x4 tk[2];
#define NCOL(j) (512 * ((j) >> 1) + 8 * lane + 4 * ((j) & 1))
#define NORM_LOAD(gg) do { _Pragma("unroll") for (int rr = 0; rr < 2; ++rr) { const int row_ = 16 * (gg) + 2 * wid + rr; \
        if (a.xin) { const GAS bf16* xr_ = uni((const GAS bf16*)gxin + (size_t)row_ * D); _Pragma("unroll") for (int h_ = 0; h_ < 2; ++h_) { const u32x4 xb_ = __builtin_nontemporal_load((const GAS u32x4*)(xr_ + 512 * h_ + 8 * lane)); \
            xv[rr][2 * h_] = (f32x4){bflo(xb_.x), bfhi(xb_.x), bflo(xb_.y), bfhi(xb_.y)}; xv[rr][2 * h_ + 1] = (f32x4){bflo(xb_.z), bfhi(xb_.z), bflo(xb_.w), bfhi(xb_.w)}; } } \
        else { const GAS float* xp_ = uni(row_ < NCTX ? gctx0 + (size_t)row_ * D : gx0 + (size_t)(row_ - NCTX) * D); \
            _Pragma("unroll") for (int j = 0; j < 4; ++j) xv[rr][j] = __builtin_nontemporal_load((const GAS f32x4*)(xp_ + NCOL(j))); } \
        if (a.delta) { const GAS signed char* dr_ = uni((const GAS signed char*)gdelta + (size_t)row_ * D); const GAS float* sr_ = uni(gdsc + (size_t)row_ * 16); _Pragma("unroll") for (int h_ = 0; h_ < 2; ++h_) { const u32x2 d_ = __builtin_nontemporal_load((const GAS u32x2*)(dr_ + 512 * h_ + 8 * lane)); \
            dv[rr][2 * h_] = d_.x; dv[rr][2 * h_ + 1] = d_.y; ds[rr][h_] = sr_[8 * h_ + (lane >> 3)]; } } } } while (0)
    unsigned mo[2][4][4]; float ms[2][4][2];
#define TK_LOAD(gg) do { _Pragma("unroll") for (int rr = 0; rr < 2; ++rr) tk[rr] = *(const GAS i32x4*)(uni(gtoks + (size_t)(16 * (gg) + 2 * wid + rr) * 4)); } while (0)
#define MOE_LOAD() do { _Pragma("unroll") for (int rr = 0; rr < 2; ++rr) { const int sl_[4] = {__builtin_amdgcn_readfirstlane(tk[rr][0]), __builtin_amdgcn_readfirstlane(tk[rr][1]), __builtin_amdgcn_readfirstlane(tk[rr][2]), __builtin_amdgcn_readfirstlane(tk[rr][3])}; \
        _Pragma("unroll") for (int k = 0; k < 4; ++k) { const GAS signed char* mr_ = (const GAS signed char*)gmout + (size_t)sl_[k] * D; const GAS float* cr_ = gmsc + (size_t)sl_[k] * 16; \
          _Pragma("unroll") for (int h_ = 0; h_ < 2; ++h_) { const u32x2 m_ = __builtin_nontemporal_load((const GAS u32x2*)(mr_ + 512 * h_ + 8 * lane)); \
            mo[rr][k][2 * h_] = m_.x; mo[rr][k][2 * h_ + 1] = m_.y; ms[rr][k][h_] = cr_[8 * h_ + (lane >> 3)]; } } } } while (0)
    if (g0 < g1) { NORM_LOAD(g0); if (a.mout) { TK_LOAD(g0); MOE_LOAD(); if (g0 + 1 < g1) TK_LOAD(g0 + 1); } }
    f32x4 shc[4], scc[4]; int mrow_c = -1;
    for (int g = g0; g < g1; ++g) {
        f32x4 v[2][4];
#pragma unroll
        for (int rr = 0; rr < 2; ++rr) {
#pragma unroll
            for (int j = 0; j < 4; ++j) { v[rr][j] = xv[rr][j];
                if (a.delta) { const int w = (int)dv[rr][j]; const float sc = ds[rr][j >> 1];
                    v[rr][j][0] += (float)((int)((unsigned)w << 24) >> 24) * sc; v[rr][j][1] += (float)((int)((unsigned)w << 16) >> 24) * sc; v[rr][j][2] += (float)((int)((unsigned)w << 8) >> 24) * sc; v[rr][j][3] += (float)(w >> 24) * sc; } }
        }
        if (a.mout) {
#pragma unroll
            for (int rr = 0; rr < 2; ++rr) { const int row = 16 * g + 2 * wid + rr; const GAS float* g2 = gg2mod + (size_t)mod_row(row) * 6 * D + 5 * D;
#pragma unroll
                for (int j = 0; j < 4; ++j) { const f32x4 gg = *(const GAS f32x4*)(g2 + NCOL(j));
                    f32x4 sm = (f32x4){0.f, 0.f, 0.f, 0.f};
#pragma unroll
                    for (int k = 0; k < 4; ++k) { const int w = (int)mo[rr][k][j]; const float sc = ms[rr][k][j >> 1];
                        sm[0] += (float)((int)((unsigned)w << 24) >> 24) * sc; sm[1] += (float)((int)((unsigned)w << 16) >> 24) * sc; sm[2] += (float)((int)((unsigned)w << 8) >> 24) * sc; sm[3] += (float)(w >> 24) * sc; }
                    v[rr][j] = v[rr][j] + gg * sm; } }
        }
        if (g + 1 < g1) { NORM_LOAD(g + 1); if (a.mout) { MOE_LOAD(); if (g + 2 < g1) TK_LOAD(g + 2); } }
#pragma unroll
        for (int rr = 0; rr < 2; ++rr) {
            const int r = 2 * wid + rr, row = 16 * g + r;
            const int mrow = mod_row(row);
            if (MODE == 0) {
#pragma unroll
                for (int h_ = 0; h_ < 2; ++h_) { u32x4 xb; xb.x = pk2(v[rr][2 * h_][0], v[rr][2 * h_][1]); xb.y = pk2(v[rr][2 * h_][2], v[rr][2 * h_][3]); xb.z = pk2(v[rr][2 * h_ + 1][0], v[rr][2 * h_ + 1][1]); xb.w = pk2(v[rr][2 * h_ + 1][2], v[rr][2 * h_ + 1][3]);
                    *(GAS u32x4*)((GAS bf16*)gxout + (size_t)row * D + 512 * h_ + 8 * lane) = xb;
                    v[rr][2 * h_] = (f32x4){bflo(xb.x), bfhi(xb.x), bflo(xb.y), bfhi(xb.y)}; v[rr][2 * h_ + 1] = (f32x4){bflo(xb.z), bfhi(xb.z), bflo(xb.w), bfhi(xb.w)}; }
            }
            float ss = 0.f;
#pragma unroll
            for (int j = 0; j < 4; ++j) ss += (v[rr][j][0] * v[rr][j][0] + v[rr][j][1] * v[rr][j][1]) + (v[rr][j][2] * v[rr][j][2] + v[rr][j][3] * v[rr][j][3]);
            const float rstd = 1.0f / sqrtf(wave_sum(ss) * (1.0f / D) + EPS);
            if (MODE == 2) {
                if (row >= NCTX) {
#pragma unroll
                    for (int j = 0; j < 4; ++j) { const int c = NCOL(j); const f32x4 fn = *(const GAS f32x4*)(gfnorm + c); *(GAS f32x4*)(gout + (size_t)(row - NCTX) * D + c) = v[rr][j] * rstd * fn; }
                }
            } else {
                if (MODE <= 1) {
                    if (mrow != mrow_c) { mrow_c = mrow; const GAS float* shp = gmod + (size_t)mrow * 6 * D + a.shi * D; const GAS float* scp = gmod + (size_t)mrow * 6 * D + a.sci * D;
#pragma unroll
                        for (int j = 0; j < 4; ++j) { shc[j] = *(const GAS f32x4*)(shp + NCOL(j)); scc[j] = *(const GAS f32x4*)(scp + NCOL(j)) + 1.0f; } }
                }
                const GAS float* shp = gmod + (size_t)mrow * 6 * D + a.shi * D; const GAS float* scp = gmod + (size_t)mrow * 6 * D + a.sci * D;
                f32x4 h[4]; float am = 0.f;
#pragma unroll
                for (int j = 0; j < 4; ++j) { const int c = NCOL(j); f32x4 sh, sc1; if (MODE <= 1) { sh = shc[j]; sc1 = scc[j]; } else { sh = *(const GAS f32x4*)(shp + c); sc1 = *(const GAS f32x4*)(scp + c) + 1.0f; }
                    h[j] = v[rr][j] * rstd * sc1 + sh;
                    u32x2 hi; hi.x = pk2(h[j][0], h[j][1]); hi.y = pk2(h[j][2], h[j][3]);
                    u32x2 lo; lo.x = pk2(h[j][0] - bflo(hi.x), h[j][1] - bfhi(hi.x)); lo.y = pk2(h[j][2] - bflo(hi.y), h[j][3] - bfhi(hi.y));
                    am = fmaxf(am, fmaxf(fmaxf(fabsf(h[j][0]), fabsf(h[j][1])), fmaxf(fabsf(h[j][2]), fabsf(h[j][3]))));
                    *(LAS u32x2*)(Thi + r * TP + c * 2) = hi; *(LAS u32x2*)(Tlo + r * TP + c * 2) = lo; }
                {
                    am = wave_max(am);
                    am = fmaxf(am, 1e-20f); const float qs = 127.0f / am;
#pragma unroll
                    for (int h_ = 0; h_ < 2; ++h_) { u32x2 qw;
#pragma unroll
                        for (int q_ = 0; q_ < 2; ++q_) { const int j = 2 * h_ + q_; const int q0 = (int)rintf(h[j][0] * qs), q1 = (int)rintf(h[j][1] * qs), q2 = (int)rintf(h[j][2] * qs), q3 = (int)rintf(h[j][3] * qs);
                            qw[q_] = (unsigned)(q0 & 255) | ((unsigned)(q1 & 255) << 8) | ((unsigned)(q2 & 255) << 16) | ((unsigned)(q3 & 255) << 24); }
                        *(GAS u32x2*)(gh8 + (size_t)row * D + 512 * h_ + 8 * lane) = qw; }
                    if (lane == 0) ghs[row] = am * (1.0f / 127.0f);
                }
            }
        }
        if (MODE == 2) continue;
        if (MODE == 0) {
#pragma unroll
            for (int s = 0; s < 4; ++s)
#pragma unroll
                for (int nb = 0; nb < NBK; ++nb) { const size_t o = (size_t)(nb * 16 + fr) * D + 128 * wid + 32 * s + 8 * fq;
                    Bh[s][nb] = *(const bf16x8*)(a.wsm + o); Bl[s][nb] = *(const bf16x8*)(a.wsm + (size_t)NS * D + o); }
        }
        __syncthreads();
        f32x4 pacc[NBK];
#pragma unroll
        for (int nb = 0; nb < NBK; ++nb) pacc[nb] = (f32x4){0.f, 0.f, 0.f, 0.f};
#pragma unroll
        for (int s = 0; s < 4; ++s) { const int ko = (128 * wid + 32 * s + 8 * fq) * 2;
            const bf16x8 ah = *(const LAS bf16x8*)(Thi + fr * TP + ko), al = *(const LAS bf16x8*)(Tlo + fr * TP + ko);
#pragma unroll
            for (int nb = 0; nb < NBK; ++nb) { pacc[nb] = __builtin_amdgcn_mfma_f32_16x16x32_bf16(ah, Bh[s][nb], pacc[nb], 0, 0, 0);
                pacc[nb] = __builtin_amdgcn_mfma_f32_16x16x32_bf16(ah, Bl[s][nb], pacc[nb], 0, 0, 0); pacc[nb] = __builtin_amdgcn_mfma_f32_16x16x32_bf16(al, Bh[s][nb], pacc[nb], 0, 0, 0); } }
#pragma unroll
        for (int nb = 0; nb < NBK; ++nb)
#pragma unroll
            for (int i = 0; i < 4; ++i) red[(wid * 16 + 4 * fq + i) * RP + nb * 16 + fr] = pacc[nb][i];
        __syncthreads();
        if (tid < 16 * NS) {
            const int rw = tid / NS, n = tid % NS;
            float val = a.sbias[n];
#pragma unroll
            for (int w = 0; w < 8; ++w) val += red[(w * 16 + rw) * RP + n];
            const int row = 16 * g + rw;
            if (MODE == 0) {
                if ((n >> 2) & 1) val = log_sigmoid(val);
                a.mg[(size_t)row * 16 + n] = val;
            } else {
                float vv = val; int ei[4]; float tv[4];
#pragma unroll
                for (int it = 0; it < 4; ++it) { float bvv = vv; int bi = n;
                    {
#define TOPSTEP(CTRL) { const float ov = dpp_f<CTRL>(bvv); const int oi = dpp_i<CTRL>(bi); if (ov > bvv || (ov == bvv && oi < bi)) { bvv = ov; bi = oi; } }
                        TOPSTEP(0xB1) TOPSTEP(0x4E) TOPSTEP(0x141) TOPSTEP(0x140)
#undef TOPSTEP
                        const auto rv = __builtin_amdgcn_permlane16_swap(__float_as_uint(bvv), __float_as_uint(bvv), false, false); const auto ri = __builtin_amdgcn_permlane16_swap((unsigned)bi, (unsigned)bi, false, false);
                        const float v0 = __uint_as_float(rv[0]), v1 = __uint_as_float(rv[1]); const int i0 = (int)ri[0], i1 = (int)ri[1];
                        if (v0 > v1 || (v0 == v1 && i0 < i1)) { bvv = v0; bi = i0; } else { bvv = v1; bi = i1; } }
                    ei[it] = bi; tv[it] = bvv; if (n == bi) vv = -INFINITY; }
                if (n == 0) {
                    const float e1 = __expf(tv[1] - tv[0]), e2 = __expf(tv[2] - tv[0]), e3 = __expf(tv[3] - tv[0]); const float inv = 1.0f / (1.0f + e1 + e2 + e3);
                    *(int4*)(a.toke + (size_t)row * 4) = make_int4(ei[0], ei[1], ei[2], ei[3]);
                    *(float4*)(a.tokg + (size_t)row * 4) = make_float4(inv, e1 * inv, e2 * inv, e3 * inv);
                    atomicAdd((int*)&hist[ei[0]], 1); atomicAdd((int*)&hist[ei[1]], 1); atomicAdd((int*)&hist[ei[2]], 1); atomicAdd((int*)&hist[ei[3]], 1);
                }
            }
        }
        if (MODE == 1) { __syncthreads(); if (tid < 32) { const int h = hist[tid]; a.ghist[(size_t)g * 32 + tid] = h; blk += h; hist[tid] = 0; } }
    }
    if (MODE == 1) { if (tid < 32) a.bhist[(size_t)bid * 32 + tid] = blk; }
    __syncthreads();
}

#undef NORM_LOAD
#undef NCOL
#undef TK_LOAD
#undef MOE_LOAD
struct ScatterArgs { const int* toke; const float* tokg; const int* ghist; const int* bhist; int* toks; int* sltok; float* slg; int* rte; const float* hs; float* sls; int gs; unsigned char* rteb; };
DI void scatter_phase(LAS unsigned char* lds, const ScatterArgs& a) {
    const int tid = opaque_tid(), wid = __builtin_amdgcn_readfirstlane(tid >> 6), lane = tid & 63;
    LAS int* ptot = (LAS int*)lds; LAS int* ppre = ptot + 512; LAS int* stt = ppre + 512; LAS int* tot = stt + 32; LAS int* pre = tot + 32; LAS int* padv = pre + 32;
    const int G = gridDim.x, B = opaque_bid(), per = (NGRP - a.gs + G - 1) / G, g0 = a.gs + B * per, g1 = (g0 + per < NGRP) ? g0 + per : NGRP;
    { const int e = tid & 31, seg = tid >> 5; int t = 0, p = 0;
      for (int b = seg; b < G; b += 16) { const int h = a.bhist[(size_t)b * 32 + e]; t += h; if (b < B) p += h; }
      ptot[seg * 32 + e] = t; ppre[seg * 32 + e] = p; }
    __syncthreads();
    if (tid < 32) { int t = 0, p = 0;
#pragma unroll
        for (int s = 0; s < 16; ++s) { t += ptot[s * 32 + tid]; p += ppre[s * 32 + tid]; }
        const int pd = (t + 255) & ~255; int sc = pd;
#pragma unroll
        for (int o = 1; o < 32; o <<= 1) { const int x = __shfl_up(sc, o); if (tid >= o) sc += x; }
        stt[tid] = sc - pd; tot[tid] = t; pre[tid] = p; padv[tid] = pd;
        if (B == 0 && tid == 31) a.rte[0] = sc >> 8; }
    __syncthreads();
    if (B == 0) {
        for (int e = 0; e < 32; ++e) { const int s0 = stt[e], t = tot[e], pd = padv[e];
            for (int s = t + tid; s < pd; s += 512) { a.sltok[s0 + s] = 0; a.slg[s0 + s] = 0.f; a.sls[s0 + s] = 0.f; }
            for (int rt = (s0 >> 8) + tid; rt < ((s0 + pd) >> 8); rt += 512) { a.rte[32 + rt] = e; a.rteb[rt] = (unsigned char)e; } }
    }
    for (int g = g0 + wid; g < g1; g += 8) {
        int base = 0;
        if (lane < 32) { base = stt[lane] + pre[lane]; for (int gg = g0; gg < g; ++gg) base += a.ghist[(size_t)gg * 32 + lane]; }
        const int ti = lane >> 2, tok = 16 * g + ti;
        const int e = a.toke[(size_t)tok * 4 + (lane & 3)]; const float gt = a.tokg[(size_t)tok * 4 + (lane & 3)];
        const unsigned long long below = (ti == 0) ? 0ull : ((1ull << (4 * ti)) - 1ull);
        int rank = 0;
        for (int ee = 0; ee < 32; ++ee) { const unsigned long long m = __ballot(e == ee); if (e == ee) rank = __popcll(m & below); }
        const int slot = __shfl(base, e) + rank;
        a.sltok[slot] = tok; a.slg[slot] = gt; a.sls[slot] = a.hs[tok]; a.toks[(size_t)tok * 4 + (lane & 3)] = slot;
    }
    __syncthreads();
}

namespace attn_body {
using f32x16 = __attribute__((ext_vector_type(16))) float;
using s16x4 = __attribute__((ext_vector_type(4))) short;
constexpr int NW = 8, QBLK = 32, KVBLK = 64;
constexpr int QP = 512, KP = 64, OP = 1024;
DI int crow(int r, int hi) { return (r & 3) + 8 * (r >> 2) + 4 * hi; }
#define SBAR() __builtin_amdgcn_sched_barrier(0)
constexpr int NSLOT = 3, SLOTB = 8192;
constexpr int LDS_K = 0, LDS_V = NSLOT * SLOTB, LDS_WS = 2 * NSLOT * SLOTB, LDS_OST = LDS_WS + NW * 64 * 4, ATT_LDS_BYTES = LDS_OST + NW * 4096;
DI void glds16(const void* gsrc, unsigned lds_dst) { unsigned keep;
    asm volatile("s_mov_b32 %0, m0\n\ts_mov_b32 m0, %2\n\ts_nop 0\n\tglobal_load_lds_dwordx4 %1, off\n\ts_mov_b32 m0, %0" : "=&s"(keep) : "v"(gsrc), "s"(lds_dst) : "memory"); }
DI float max3f(float a, float b, float c) { float r; asm("v_max3_f32 %0, %1, %2, %3" : "=v"(r) : "v"(a), "v"(b), "v"(c)); return r; }
DI float max2f(float a, float b) { float r; asm("v_max_f32_e32 %0, %1, %2" : "=v"(r) : "v"(a), "v"(b)); return r; }
DI float fadd_s(float a, float b) { float r; asm("v_add_f32_e32 %0, %1, %2" : "=v"(r) : "v"(a), "v"(b)); return r; }
DI float fsub_s(float a, float b) { float r; asm("v_sub_f32_e32 %0, %1, %2" : "=v"(r) : "v"(a), "v"(b)); return r; }
DI unsigned cvtpk_s(float lo, float hi) { return pk2(lo, hi); }
#define WAIT_BAR(N) asm volatile("s_waitcnt vmcnt(" #N ") lgkmcnt(0)\n\ts_barrier" ::: "memory")
typedef LAS const char* lds_cptr;
typedef short v4i16_t __attribute__((ext_vector_type(4)));
typedef int i32x8 __attribute__((ext_vector_type(8)));
DI i32x8 cat8i(i32x4 x0, i32x4 x1) { return __builtin_shufflevector(x0, x1, 0, 1, 2, 3, 4, 5, 6, 7); }
DI i32x8 kload1(lds_cptr kp, int kh) { return cat8i(*(const LAS i32x4*)(kp + kh * 512), *(const LAS i32x4*)(kp + 1024 + kh * 512)); }
DI f32x16 mfq(i32x8 a, i32x8 b, f32x16 c) { return __builtin_amdgcn_mfma_scale_f32_32x32x64_f8f6f4(a, b, c, 0, 0, 0, 0, 0, 0); }
DI s16x4 vtr(lds_cptr p) { return __builtin_bit_cast(s16x4, __builtin_amdgcn_ds_read_tr16_b64_v4i16((LAS v4i16_t*)p)); }
DI float rowmax(const f32x16& p0, const f32x16& p1) {
    float a = max3f(p0[0], p0[1], p1[0]), b = max3f(p0[2], p0[3], p1[1]); a = max3f(a, p1[2], p1[3]);
#pragma unroll
    for (int r = 4; r < 16; r += 4) { a = max3f(a, p0[r], p0[r + 1]); b = max3f(b, p0[r + 2], p0[r + 3]); a = max3f(a, p1[r], p1[r + 1]); b = max3f(b, p1[r + 2], p1[r + 3]); }
    const float m = max2f(a, b);
    auto rr = __builtin_amdgcn_permlane32_swap(__float_as_uint(m), __float_as_uint(m), false, false);
    return max2f(__uint_as_float(rr[0]), __uint_as_float(rr[1]));
}
DI void pv(f32x16* o, int vb, bf16x8 pa0, bf16x8 pa1, bf16x8 pa2, bf16x8 pa3) {
#pragma unroll
    for (int d0 = 0; d0 < 2; ++d0) { s16x4 lo[4], hi[4];
#pragma unroll
        for (int ks = 0; ks < 4; ++ks) {
            asm volatile("ds_read_b64_tr_b16 %0,%1 offset:%c2" : "=&v"(lo[ks]) : "v"(vb), "i"(d0 * 4096 + ks * 1024) : "memory");
            asm volatile("ds_read_b64_tr_b16 %0,%1 offset:%c2" : "=&v"(hi[ks]) : "v"(vb), "i"(d0 * 4096 + ks * 1024 + 512) : "memory"); }
        asm volatile("s_waitcnt lgkmcnt(0)" ::: "memory"); SBAR();
#define PK(k) (bf16x8){lo[k][0], lo[k][1], lo[k][2], lo[k][3], hi[k][0], hi[k][1], hi[k][2], hi[k][3]}
        o[d0] = __builtin_amdgcn_mfma_f32_32x32x16_bf16(pa0, PK(0), o[d0], 0, 0, 0);
        o[d0] = __builtin_amdgcn_mfma_f32_32x32x16_bf16(pa1, PK(1), o[d0], 0, 0, 0);
        o[d0] = __builtin_amdgcn_mfma_f32_32x32x16_bf16(pa2, PK(2), o[d0], 0, 0, 0);
        o[d0] = __builtin_amdgcn_mfma_f32_32x32x16_bf16(pa3, PK(3), o[d0], 0, 0, 0);
#undef PK
    }
}
template <int THRL, bool NOMAX> DI void attn_unit(const unsigned char* Qu, const unsigned char* __restrict__ Kh, const bf16* __restrict__ Vh, const int NT, unsigned char* Ou, const float* gain, char* shm) {
    const int tid = opaque_tid(), lane = tid & 63, r32 = lane & 31, hi = lane >> 5; const int wid = __builtin_amdgcn_readfirstlane(tid >> 6);
    const unsigned char* Qw = Qu + (long)(wid * QBLK) * QP;
    const unsigned lds0 = (unsigned)(uintptr_t)shm;
    float* wsf = (float*)(shm + LDS_WS) + wid * 64;
    const unsigned char* ksrc = Kh + (long)lane * KP + (wid & 3) * 16;
    const bf16* vsrc = Vh + (long)(16 * (wid & 3) + (lane >> 2)) * KP + (wid >> 2) * 32 + (lane & 3) * 8;
    const unsigned kdst = lds0 + LDS_K + (wid & 3) * 1024, vdst = lds0 + LDS_V + wid * 1024;
#define DMA_K(t, slot) glds16(ksrc + (long)(t) * KVBLK * KP, (unsigned)__builtin_amdgcn_readfirstlane(kdst + (slot)))
#define DMA_V(t, slot) glds16(vsrc + (long)(t) * KVBLK * KP, (unsigned)__builtin_amdgcn_readfirstlane(vdst + (slot)))
    const int vb0 = (int)(lds0 + LDS_V) + ((lane >> 4) & 1) * 32 + (lane & 3) * 8 + (4 * hi + ((lane & 15) >> 2)) * 64;
    i32x8 kf[2];
    const lds_cptr shm3 = (lds_cptr)shm; const lds_cptr kp0 = shm3 + LDS_K + hi * 2048 + r32 * 16; const lds_cptr vp0 = shm3 + LDS_V + ((lane >> 4) & 1) * 32 + (lane & 3) * 8 + (4 * hi + ((lane & 15) >> 2)) * 64;
    DMA_K(0, 0); DMA_V(0, 0); DMA_K(1, SLOTB);
    const i32x8 qr = cat8i(*reinterpret_cast<const i32x4*>(Qw + (long)r32 * QP + hi * 32), *reinterpret_cast<const i32x4*>(Qw + (long)r32 * QP + hi * 32 + 16));
    float mhat = 0.f, l_reg = 0.f; f32x16 o[2]; o[0] = f32x16{}; o[1] = f32x16{}; f32x16 negm = f32x16{}; asm volatile("" : "+v"(negm));
    bool resc = false;
#define START(P0, P1) do { resc = false; \
    if constexpr (!NOMAX) { const float rm = rowmax(P0, P1); const float dl = rm; mhat = fadd_s(mhat, dl); \
      _Pragma("unroll") for (int r = 0; r < 16; ++r) { P0[r] = fsub_s(P0[r], dl); P1[r] = fsub_s(P1[r], dl); } \
      _Pragma("unroll") for (int r = 0; r < 16; ++r) negm[r] = -mhat; asm volatile("" : "+v"(negm)); } \
    _Pragma("unroll") for (int r = 0; r < 16; ++r) P0[r] = __builtin_amdgcn_exp2f(P0[r]); } while (0)
#define RESC() do { if (resc) { asm volatile("s_waitcnt lgkmcnt(0)" ::: "memory"); \
      _Pragma("unroll") for (int d_ = 0; d_ < 2; ++d_) _Pragma("unroll") for (int r = 0; r < 16; ++r) o[d_][r] *= wsf[crow(r, hi)]; } } while (0)
    f32x16 pA0, pA1, pB0, pB1;
    int sl_prev = 0, sl_cur = 0, sl_next = SLOTB;
#define ROT() do { sl_prev = sl_cur; sl_cur = sl_next; sl_next = (sl_next == (NSLOT - 1) * SLOTB) ? 0 : sl_next + SLOTB; } while (0)
    DMA_K(2, 2 * SLOTB);
    WAIT_BAR(3);
    pA0 = mfq(kload1(kp0, 0), qr, negm); pA1 = mfq(kload1(kp0, 1), qr, negm);
    if constexpr (!NOMAX) asm volatile("s_nop 15\n\ts_nop 15" : "+v"(pA0), "+v"(pA1));
    START(pA0, pA1);
    _Pragma("unroll") for (int r = 0; r < 16; ++r) pA1[r] = __builtin_amdgcn_exp2f(pA1[r]);
    WAIT_BAR(0);
    DMA_K(3, 0); DMA_V(1, SLOTB);
    ROT();
    kf[0] = kload1(kp0 + sl_cur, 0); kf[1] = kload1(kp0 + sl_cur, 1);
    WAIT_BAR(2);
    s16x4 vlo[8], vhi[8]; u32x4 pw0, pw1, pw2, pw3;
#define PKW(P, B) cvtpk_s(P[B], P[B + 1])
#define PAF(k) __builtin_bit_cast(bf16x8, pw##k)
#define VFR(i) (bf16x8){vlo[i][0], vlo[i][1], vlo[i][2], vlo[i][3], vhi[i][0], vhi[i][1], vhi[i][2], vhi[i][3]}
#define PIN(x) asm volatile("" : "+v"(x))
#define MX3(a, b, c) __builtin_fmaxf(__builtin_fmaxf((a), (b)), (c))
#define GAPA(MF, A0, A1, A2, A3, W0, W1, PW) do { MF; sacc += A0; sacc += A1; sacc += A2; sacc += A3; PIN(sacc); W0; W1; PIN(PW); SBAR(); } while (0)
#define EX(v) __builtin_amdgcn_exp2f(v)
#define GAPB(MF, X, B) do { MF; X[B] = EX(X[B]); X[B + 1] = EX(X[B + 1]); X[B + 2] = EX(X[B + 2]); X[B + 3] = EX(X[B + 3]); PIN(X); SBAR(); } while (0)
#define VRD(i) do { vlo[i] = vtr(vp_ + (((i) >> 2) * 4096 + ((i) & 3) * 1024)); vhi[i] = vtr(vp_ + (((i) >> 2) * 4096 + ((i) & 3) * 1024 + 512)); } while (0)
#define KRD(G, j) do { if (G) { kf[j] = kload1(kp0 + sl_next, j); SBAR(); } } while (0)
#define STEP(C0, C1, P0, P1, t, GK, GV, GL) do { SBAR(); \
    const lds_cptr vp_ = vp0 + sl_prev; \
    VRD(0); SBAR(); float sacc = (P0[0] + P0[1]); \
    GAPA(C0 = mfq(kf[0], qr, negm), P0[2], P0[3], P0[4], P0[5],     pw0[0] = PKW(P0, 0), pw0[1] = PKW(P0, 2), pw0); \
    VRD(4); SBAR(); GAPA((void)0, P0[6], P0[7], P0[8], P0[9],     pw0[2] = PKW(P0, 4), pw0[3] = PKW(P0, 6), pw0); \
    VRD(1); SBAR(); GAPA((void)0, P0[10], P0[11], P0[12], P0[13], pw1[0] = PKW(P0, 8), pw1[1] = PKW(P0, 10), pw1); \
    VRD(5); SBAR(); GAPA((void)0, P0[14], P0[15], P1[0], P1[1],   pw1[2] = PKW(P0, 12), pw1[3] = PKW(P0, 14), pw1); \
    VRD(2); SBAR(); GAPA(C1 = mfq(kf[1], qr, negm), P1[2], P1[3], P1[4], P1[5],     pw2[0] = PKW(P1, 0), pw2[1] = PKW(P1, 2), pw2); \
    VRD(6); SBAR(); GAPA((void)0, P1[6], P1[7], P1[8], P1[9],     pw2[2] = PKW(P1, 4), pw2[3] = PKW(P1, 6), pw2); \
    VRD(3); SBAR(); GAPA((void)0, P1[10], P1[11], P1[12], P1[13], pw3[0] = PKW(P1, 8), pw3[1] = PKW(P1, 10), pw3); \
    VRD(7); SBAR(); GAPA((void)0, P1[14], P1[15], 0.f, 0.f,       pw3[2] = PKW(P1, 12), pw3[3] = PKW(P1, 14), pw3); \
    l_reg += sacc; \
    if (GK) { DMA_K((t) + 3, sl_cur); } if (GV) { DMA_V((t) + 1, sl_next); } \
    if constexpr (!NOMAX) { float a = MX3(C0[0], C0[1], C1[0]), b = MX3(C0[2], C0[3], C1[1]); a = MX3(a, C1[2], C1[3]); \
      _Pragma("unroll") for (int r = 4; r < 16; r += 4) { a = MX3(a, C0[r], C0[r + 1]); b = MX3(b, C0[r + 2], C0[r + 3]); a = MX3(a, C1[r], C1[r + 1]); b = MX3(b, C1[r + 2], C1[r + 3]); } \
      float rm = __builtin_fmaxf(a, b); { auto rr = __builtin_amdgcn_permlane32_swap(__float_as_uint(rm), __float_as_uint(rm), false, false); rm = __builtin_fmaxf(__uint_as_float(rr[0]), __uint_as_float(rr[1])); } \
      resc = false; \
      if (__builtin_expect(__any(rm > (float)THRL), 0)) { const float dl = __builtin_fmaxf(rm, 0.f); mhat += dl; \
        _Pragma("unroll") for (int r = 0; r < 16; ++r) { C0[r] -= dl; C1[r] -= dl; } \
        _Pragma("unroll") for (int r = 0; r < 16; ++r) negm[r] = -mhat; asm volatile("" : "+v"(negm)); \
        const float f = __builtin_amdgcn_exp2f(-dl); l_reg *= f; if (hi == 0) wsf[r32] = f; resc = true; } } \
    SBAR(); \
    GAPB(o[0] = __builtin_amdgcn_mfma_f32_32x32x16_bf16(PAF(0), VFR(0), o[0], 0, 0, 0), C0, 0); \
    GAPB(o[1] = __builtin_amdgcn_mfma_f32_32x32x16_bf16(PAF(0), VFR(4), o[1], 0, 0, 0), C0, 4); \
    KRD(GL, 0); GAPB(o[0] = __builtin_amdgcn_mfma_f32_32x32x16_bf16(PAF(1), VFR(1), o[0], 0, 0, 0), C0, 8); \
    GAPB(o[1] = __builtin_amdgcn_mfma_f32_32x32x16_bf16(PAF(1), VFR(5), o[1], 0, 0, 0), C0, 12); \
    KRD(GL, 1); GAPB(o[0] = __builtin_amdgcn_mfma_f32_32x32x16_bf16(PAF(2), VFR(2), o[0], 0, 0, 0), C1, 0); \
    GAPB(o[1] = __builtin_amdgcn_mfma_f32_32x32x16_bf16(PAF(2), VFR(6), o[1], 0, 0, 0), C1, 4); \
    GAPB(o[0] = __builtin_amdgcn_mfma_f32_32x32x16_bf16(PAF(3), VFR(3), o[0], 0, 0, 0), C1, 8); \
    GAPB(o[1] = __builtin_amdgcn_mfma_f32_32x32x16_bf16(PAF(3), VFR(7), o[1], 0, 0, 0), C1, 12); \
    } while (0)
    int t = 1;
    for (; t + 5 < NT; t += 2) {
        STEP(pB0, pB1, pA0, pA1, t, true, true, true);     WAIT_BAR(2); RESC(); ROT();
        STEP(pA0, pA1, pB0, pB1, t + 1, true, true, true); WAIT_BAR(2); RESC(); ROT();
    }
#define ENDW(tt) do { if ((tt) + 3 < NT) { WAIT_BAR(2); } else if ((tt) + 2 < NT) { WAIT_BAR(1); } else { WAIT_BAR(0); } } while (0)
    for (; t + 1 < NT; t += 2) {
        STEP(pB0, pB1, pA0, pA1, t, (t + 3 < NT), (t + 1 < NT), (t + 1 < NT));         ENDW(t);     RESC(); ROT();
        STEP(pA0, pA1, pB0, pB1, t + 1, (t + 4 < NT), (t + 2 < NT), (t + 2 < NT));     ENDW(t + 1); RESC(); ROT();
    }
    STEP(pB0, pB1, pA0, pA1, NT - 1, false, false, false); RESC();
    { float sacc = pB0[0] + pB0[1]; _Pragma("unroll") for (int r = 2; r < 16; ++r) sacc += pB0[r]; _Pragma("unroll") for (int r = 0; r < 16; ++r) sacc += pB1[r]; l_reg += sacc;
      pw0 = (u32x4){PKW(pB0, 0), PKW(pB0, 2), PKW(pB0, 4), PKW(pB0, 6)}; pw1 = (u32x4){PKW(pB0, 8), PKW(pB0, 10), PKW(pB0, 12), PKW(pB0, 14)}; pw2 = (u32x4){PKW(pB1, 0), PKW(pB1, 2), PKW(pB1, 4), PKW(pB1, 6)}; pw3 = (u32x4){PKW(pB1, 8), PKW(pB1, 10), PKW(pB1, 12), PKW(pB1, 14)};
      SBAR(); pv(o, vb0 + sl_cur, PAF(0), PAF(1), PAF(2), PAF(3)); }
#undef PKW
#undef PAF
#undef VFR
#undef PIN
#undef MX3
#undef GAPA
#undef GAPB
#undef EX
#undef VRD
#undef KRD
#undef STEP
#undef ENDW
    { auto rr = __builtin_amdgcn_permlane32_swap(__float_as_uint(l_reg), __float_as_uint(l_reg), false, false); l_reg = __uint_as_float(rr[0]) + __uint_as_float(rr[1]); }
    if (hi == 0) wsf[32 + r32] = l_reg; asm volatile("s_waitcnt lgkmcnt(0)" ::: "memory");
    float rli[16];
#pragma unroll
    for (int r = 0; r < 16; ++r) rli[r] = __builtin_amdgcn_rcpf(wsf[32 + crow(r, hi)]);
    unsigned char* Ow = Ou + (long)(wid * QBLK) * OP;
    { bf16* stg = (bf16*)(shm + LDS_OST) + wid * 2048;
#pragma unroll
      for (int r = 0; r < 16; ++r) { const int orow = crow(r, hi);
#pragma unroll
          for (int d0 = 0; d0 < 2; ++d0) stg[orow * 64 + d0 * 32 + r32] = f2bf(o[d0][r] * rli[r]); }
      asm volatile("s_waitcnt lgkmcnt(0)" ::: "memory");
      const int ch = lane & 7;
#pragma unroll
      for (int i = 0; i < 4; ++i) { const int row = i * 8 + (lane >> 3); const u32x4 v = *(const u32x4*)(stg + row * 64 + ch * 8);
          float x[8] = {bflo(v.x), bfhi(v.x), bflo(v.y), bfhi(v.y), bflo(v.z), bfhi(v.z), bflo(v.w), bfhi(v.w)};
          float ss = 0.f;
#pragma unroll
          for (int k = 0; k < 8; ++k) ss += x[k] * x[k];
          ss = sum_oct(ss);
          const float rs = __builtin_amdgcn_rsqf(ss * (1.0f / 64.0f) + EPS);
          const float rq = rs * YS; u32x2 w; w.x = pk_i8x4(x[0] * rq, x[1] * rq, x[2] * rq, x[3] * rq); w.y = pk_i8x4(x[4] * rq, x[5] * rq, x[6] * rq, x[7] * rq);
          *(u32x2*)(Ow + (long)row * OP + ch * 8) = w; } }
    asm volatile("s_waitcnt lgkmcnt(0)\n\ts_barrier" ::: "memory");
#undef DMA_K
#undef DMA_V
#undef START
#undef RESC
#undef ROT
}
#undef SBAR
#undef WAIT_BAR
}

namespace mlstm {
constexpr int P2 = 144;
constexpr int TILE = 64 * P2;
constexpr int O_Q = 0, O_K = TILE, O_KT = 2 * TILE, O_VT = 3 * TILE, O_P = 4 * TILE, O_CT = 5 * TILE  , O_N = 7 * TILE  , O_SC = O_N + 512  , DIRB = O_SC + 2048;
static_assert(2 * DIRB <= SCR_BYTES, "mLSTM LDS");
struct Args { const bf16 *MQ, *MK, *MV, *MO; const float* MG; float* HFB; bf16* Y; const float* mixn; };
DI int chunk_mc(int dir, int j) { return dir == 0 ? j : (j < 4 ? 3 - j : 71 - j); }
DI int tok_row(int b, int p) { return p < TC ? b * TC + p : NCTX + b * T + (p - TC); }
DI void item(LAS unsigned char* lds, const Args& a, int b, int h) {
    const int tid = opaque_tid(), wid = __builtin_amdgcn_readfirstlane(tid >> 6), lane = tid & 63, fr = lane & 15, fq = lane >> 4;
    const int dir = wid >> 2, w4 = wid & 3;
    LAS unsigned char* L = lds + dir * DIRB;
    LAS float* sa = (LAS float*)(L + O_SC + w4 * 512); LAS float* sg = sa + 64;
    for (int i = (tid & 255); i < TILE / 4; i += 256) ((LAS unsigned*)(L + O_CT))[i] = 0u;
    if ((tid & 255) < 64) ((LAS float*)(L + O_N))[tid & 255] = 0.f;
    f32x4 Cacc[4];
#pragma unroll
    for (int c = 0; c < 4; ++c) Cacc[c] = (f32x4){0.f, 0.f, 0.f, 0.f};
    float n_reg = 0.f, m_prev = 0.f;
    const GAS bf16* gMQ = (const GAS bf16*)a.MQ; const GAS bf16* gMK = (const GAS bf16*)a.MK; const GAS bf16* gMV = (const GAS bf16*)a.MV; const GAS float* gMG = (const GAS float*)a.MG;
    GAS float* HF = (GAS float*)a.HFB + ((size_t)((b * 4 + h) * 2 + dir)) * TKV * 64;
    u32x4 qA[2], kA[2], vA[2]; float li, lf;
    const unsigned psel = (lane & 1) ? 0x07060302u : 0x01000504u; const int tb = (lane & 1) ? (P2 + 2 * (lane - 1)) : 2 * lane;
#define MLOAD(j) do { const int mc_ = chunk_mc(dir, (j)); const int p_ = 64 * mc_ + (dir == 0 ? lane : 63 - lane); const size_t row_ = (size_t)tok_row(b, p_); \
        li = gMG[row_ * 16 + dir * 8 + h]; lf = gMG[row_ * 16 + dir * 8 + 4 + h]; \
        _Pragma("unroll") for (int m_ = 0; m_ < 2; ++m_) { const int tr_ = 16 * w4 + 8 * m_ + (lane >> 3); const size_t o_ = (size_t)tok_row(b, 64 * mc_ + (dir == 0 ? tr_ : 63 - tr_)) * 256 + h * 64 + 8 * (lane & 7); \
            qA[m_] = *(const GAS u32x4*)(gMQ + o_); kA[m_] = *(const GAS u32x4*)(gMK + o_); vA[m_] = *(const GAS u32x4*)(gMV + o_); } } while (0)
    MLOAD(0);
    __syncthreads();
    for (int j = 0; j < 68; ++j) {
        const int cb = j & 1;
        const float bcs = scan_sum64(lf);
        const float av = li - bcs;
        const float pmx = scan_max64(av);
        const float gv = fmaxf(m_prev, pmx);
        const float G63 = __builtin_bit_cast(float, __builtin_amdgcn_readlane(__builtin_bit_cast(int, gv), 63)), bend = __builtin_bit_cast(float, __builtin_amdgcn_readlane(__builtin_bit_cast(int, bcs), 63));
        const float wsv = __expf(av - G63), w_prev = __expf(m_prev - G63);
        const float w_int = __expf(m_prev - gv), emt = __expf(-(bcs + gv));
#pragma unroll
        for (int m = 0; m < 2; ++m) { const int tr = 16 * w4 + 8 * m + (lane >> 3), po = tr * P2 + 16 * (lane & 7);
            *(LAS u32x4*)(L + O_Q + po) = qA[m]; *(LAS u32x4*)(L + O_K + po) = kA[m]; *(LAS u32x4*)(L + O_P + po) = vA[m]; }
        if (j + 1 < 68) MLOAD(j + 1);
        __syncthreads();
        const u32x4 k0 = *(const LAS u32x4*)(L + O_K + lane * P2 + 16 * w4), k1 = *(const LAS u32x4*)(L + O_K + lane * P2 + 16 * w4 + 64), v0 = *(const LAS u32x4*)(L + O_P + lane * P2 + 16 * w4), v1 = *(const LAS u32x4*)(L + O_P + lane * P2 + 16 * w4 + 64);
        {
            const unsigned kw[8] = {k0.x, k0.y, k0.z, k0.w, k1.x, k1.y, k1.z, k1.w}, vw[8] = {v0.x, v0.y, v0.z, v0.w, v1.x, v1.y, v1.z, v1.w};
#pragma unroll
            for (int pp = 0; pp < 2; ++pp)
#pragma unroll
                for (int i = 0; i < 4; ++i) { const int d = 8 * w4 + 32 * pp + 2 * i;
                    const unsigned kk = pk2(bflo(kw[pp * 4 + i]) * wsv, bfhi(kw[pp * 4 + i]) * wsv), vv = vw[pp * 4 + i];
                    const unsigned kn = (unsigned)dpp_i<0xB1>((int)kk), vn = (unsigned)dpp_i<0xB1>((int)vv);
                    *(LAS unsigned*)(L + O_KT + d * P2 + tb) = __builtin_amdgcn_perm(kk, kn, psel); *(LAS unsigned*)(L + O_VT + d * P2 + tb) = __builtin_amdgcn_perm(vv, vn, psel); }
        }
        sa[lane] = av; sg[lane] = gv;
        __syncthreads();
        bf16x8 qf[2];
#pragma unroll
        for (int ks = 0; ks < 2; ++ks) qf[ks] = *(const LAS bf16x8*)(L + O_Q + (16 * w4 + fr) * P2 + (32 * ks + 8 * fq) * 2);
        const int tt = 16 * w4 + fr;
        const float g_t = sg[tt];
        float rsum = 0.f;
#pragma unroll
        for (int c = 0; c < 4; ++c) {
            f32x4 s = (f32x4){0.f, 0.f, 0.f, 0.f};
#pragma unroll
            for (int ks = 0; ks < 2; ++ks) { const bf16x8 kf = *(const LAS bf16x8*)(L + O_K + (16 * c + fr) * P2 + (32 * ks + 8 * fq) * 2); s = __builtin_amdgcn_mfma_f32_16x16x32_bf16(kf, qf[ks], s, 0, 0, 0); }
            const f32x4 as4 = *(const LAS f32x4*)(sa + 16 * c + 4 * fq);
            float p[4];
#pragma unroll
            for (int i = 0; i < 4; ++i) { const int ss = 16 * c + 4 * fq + i; p[i] = (ss <= tt) ? s[i] * __expf(as4[i] - g_t) : 0.f; rsum += p[i]; }
            u32x2 pw; pw.x = pk2(p[0], p[1]); pw.y = pk2(p[2], p[3]);
            *(LAS u32x2*)(L + O_P + tt * P2 + (16 * c + 4 * fq) * 2) = pw;
        }
        rsum = sum_x16x32(rsum);
        float qn = 0.f;
        { const u32x4 qa = *(const LAS u32x4*)(L + O_Q + tt * P2 + (16 * fq) * 2), qb = *(const LAS u32x4*)(L + O_Q + tt * P2 + (16 * fq + 8) * 2);
          const LAS float* nv = (const LAS float*)(L + O_N + cb * 256) + 16 * fq;
          const f32x4 n0 = *(const LAS f32x4*)(nv), n1 = *(const LAS f32x4*)(nv + 4), n2 = *(const LAS f32x4*)(nv + 8), n3 = *(const LAS f32x4*)(nv + 12);
          qn = bflo(qa.x) * n0[0] + bfhi(qa.x) * n0[1] + bflo(qa.y) * n0[2] + bfhi(qa.y) * n0[3] + bflo(qa.z) * n1[0] + bfhi(qa.z) * n1[1] + bflo(qa.w) * n1[2] + bfhi(qa.w) * n1[3]
             + bflo(qb.x) * n2[0] + bfhi(qb.x) * n2[1] + bflo(qb.y) * n2[2] + bfhi(qb.y) * n2[3] + bflo(qb.z) * n3[0] + bfhi(qb.z) * n3[1] + bflo(qb.w) * n3[2] + bfhi(qb.w) * n3[3];
          qn = sum_x16x32(qn); }
        const float wi_t = __shfl(w_int, tt), em_t = __shfl(emt, tt);
        const float den = rsum + wi_t * qn;
        const float rden = 1.0f / fmaxf(fabsf(den), em_t);
        LDS_WAIT();
        bf16x8 pf[2];
#pragma unroll
        for (int ks = 0; ks < 2; ++ks) pf[ks] = *(const LAS bf16x8*)(L + O_P + tt * P2 + (32 * ks + 8 * fq) * 2);
        const int pos = 64 * chunk_mc(dir, j) + (dir == 0 ? tt : 63 - tt);
#pragma unroll
        for (int c = 0; c < 4; ++c) {
            f32x4 qc = (f32x4){0.f, 0.f, 0.f, 0.f}, pvv = (f32x4){0.f, 0.f, 0.f, 0.f};
#pragma unroll
            for (int ks = 0; ks < 2; ++ks) { const bf16x8 cf = *(const LAS bf16x8*)(L + O_CT + cb * TILE + (16 * c + fr) * P2 + (32 * ks + 8 * fq) * 2); qc = __builtin_amdgcn_mfma_f32_16x16x32_bf16(cf, qf[ks], qc, 0, 0, 0);
                const bf16x8 vf = *(const LAS bf16x8*)(L + O_VT + (16 * c + fr) * P2 + (32 * ks + 8 * fq) * 2); pvv = __builtin_amdgcn_mfma_f32_16x16x32_bf16(vf, pf[ks], pvv, 0, 0, 0); }
            const f32x4 hv = (pvv + qc * wi_t) * rden;
            *(GAS f32x4*)(HF + (size_t)pos * 64 + 16 * c + 4 * fq) = hv;
        }
        { bf16x8 vf[2];
#pragma unroll
          for (int ks = 0; ks < 2; ++ks) vf[ks] = *(const LAS bf16x8*)(L + O_VT + (16 * w4 + fr) * P2 + (32 * ks + 8 * fq) * 2);
#pragma unroll
          for (int c = 0; c < 4; ++c) { Cacc[c] = Cacc[c] * w_prev;
#pragma unroll
              for (int ks = 0; ks < 2; ++ks) { const bf16x8 kt = *(const LAS bf16x8*)(L + O_KT + (16 * c + fr) * P2 + (32 * ks + 8 * fq) * 2); Cacc[c] = __builtin_amdgcn_mfma_f32_16x16x32_bf16(kt, vf[ks], Cacc[c], 0, 0, 0); }
              u32x2 cw; cw.x = pk2(Cacc[c][0], Cacc[c][1]); cw.y = pk2(Cacc[c][2], Cacc[c][3]);
              *(LAS u32x2*)(L + O_CT + (cb ^ 1) * TILE + (16 * w4 + fr) * P2 + (16 * c + 4 * fq) * 2) = cw; }
          const u32x4 ka = *(const LAS u32x4*)(L + O_KT + (16 * w4 + fr) * P2 + (16 * fq) * 2), kb = *(const LAS u32x4*)(L + O_KT + (16 * w4 + fr) * P2 + (16 * fq + 8) * 2);
          float ksum = ((bflo(ka.x) + bfhi(ka.x)) + (bflo(ka.y) + bfhi(ka.y))) + ((bflo(ka.z) + bfhi(ka.z)) + (bflo(ka.w) + bfhi(ka.w)))
                     + ((bflo(kb.x) + bfhi(kb.x)) + (bflo(kb.y) + bfhi(kb.y))) + ((bflo(kb.z) + bfhi(kb.z)) + (bflo(kb.w) + bfhi(kb.w)));
          ksum = sum_x16x32(ksum);
          n_reg = w_prev * n_reg + ksum;
          if (fq == 0) ((LAS float*)(L + O_N + (cb ^ 1) * 256))[16 * w4 + fr] = n_reg; }
        m_prev = bend + G63;
        __syncthreads();
    }
#undef MLOAD
    VM_WAIT(); __threadfence_block(); __syncthreads();
    const GAS float* HF0 = (const GAS float*)a.HFB + ((size_t)((b * 4 + h) * 2)) * TKV * 64; const GAS float* HF1 = HF0 + (size_t)TKV * 64; const GAS bf16* gMO = (const GAS bf16*)a.MO; GAS unsigned char* gY = (GAS unsigned char*)a.Y;
    const int ch = tid & 7;
    for (int it0 = 0; it0 < TKV * 8 / 512; it0 += 4) {
        f32x4 a0[4], a1[4], b0[4], b1[4]; u32x4 ov[4];
#pragma unroll
        for (int u = 0; u < 4; ++u) { const int p = ((it0 + u) * 512 + tid) >> 3; const size_t row = (size_t)tok_row(b, p);
            a0[u] = *(const GAS f32x4*)(HF0 + (size_t)p * 64 + ch * 8); a1[u] = *(const GAS f32x4*)(HF0 + (size_t)p * 64 + ch * 8 + 4); b0[u] = *(const GAS f32x4*)(HF1 + (size_t)p * 64 + ch * 8); b1[u] = *(const GAS f32x4*)(HF1 + (size_t)p * 64 + ch * 8 + 4);
            ov[u] = *(const GAS u32x4*)(gMO + row * 256 + h * 64 + ch * 8); }
#pragma unroll
        for (int u = 0; u < 4; ++u) { const int p = ((it0 + u) * 512 + tid) >> 3; const size_t row = (size_t)tok_row(b, p);
            float y[8] = {bflo(ov[u].x) * (a0[u][0] + b0[u][0]), bfhi(ov[u].x) * (a0[u][1] + b0[u][1]), bflo(ov[u].y) * (a0[u][2] + b0[u][2]), bfhi(ov[u].y) * (a0[u][3] + b0[u][3]),
                          bflo(ov[u].z) * (a1[u][0] + b1[u][0]), bfhi(ov[u].z) * (a1[u][1] + b1[u][1]), bflo(ov[u].w) * (a1[u][2] + b1[u][2]), bfhi(ov[u].w) * (a1[u][3] + b1[u][3])};
            float ss = 0.f;
#pragma unroll
            for (int k = 0; k < 8; ++k) ss += y[k] * y[k];
            ss = sum_oct(ss);
            const float rs = __builtin_amdgcn_rsqf(ss * (1.0f / 64.0f) + EPS);
            const float rq = rs * YS; u32x2 w; w.x = pk_i8x4(y[0] * rq, y[1] * rq, y[2] * rq, y[3] * rq); w.y = pk_i8x4(y[4] * rq, y[5] * rq, y[6] * rq, y[7] * rq);
            *(GAS u32x2*)(gY + row * D + h * 64 + ch * 8) = w; }
    }
    __syncthreads();
}
}

namespace gmlp {
constexpr int VP = 272;
struct Args { const bf16* GU; const bf16* GV; const bf16* W; const float* gb; const float* gnorm; const float* mixn; bf16* Y; };
DI void item(LAS unsigned char* lds, const Args& a, size_t row0) {
    const int tid = opaque_tid(), wid = __builtin_amdgcn_readfirstlane(tid >> 6), lane = tid & 63, fr = lane & 15, fq = lane >> 4;
    { const int p = tid >> 2, part = tid & 3;
      const bf16* src = a.GV + (row0 + p) * 256 + 64 * part;
      u32x4 v[8]; float ss = 0.f;
#pragma unroll
      for (int i = 0; i < 8; ++i) { v[i] = *(const u32x4*)(src + 8 * i);
          ss += bflo(v[i].x) * bflo(v[i].x) + bfhi(v[i].x) * bfhi(v[i].x) + bflo(v[i].y) * bflo(v[i].y) + bfhi(v[i].y) * bfhi(v[i].y)
              + bflo(v[i].z) * bflo(v[i].z) + bfhi(v[i].z) * bfhi(v[i].z) + bflo(v[i].w) * bflo(v[i].w) + bfhi(v[i].w) * bfhi(v[i].w); }
      ss = sum_quad(ss);
      const float rs = __builtin_amdgcn_rsqf(ss * (1.0f / 256.0f) + EPS);
#pragma unroll
      for (int i = 0; i < 8; ++i) { const unsigned w[4] = {v[i].x, v[i].y, v[i].z, v[i].w};
#pragma unroll
          for (int k = 0; k < 4; ++k) { const int ch = 64 * part + 8 * i + 2 * k;
              const unsigned o = pk2(bflo(w[k]) * rs * a.gnorm[ch], bfhi(w[k]) * rs * a.gnorm[ch + 1]);
              *(LAS bf16*)(lds + ch * VP + 2 * p) = (bf16)(o & 0xffffu); *(LAS bf16*)(lds + (ch + 1) * VP + 2 * p) = (bf16)(o >> 16); } }
    }
    __syncthreads();
    const size_t row = row0 + 16 * wid + fr;
#pragma unroll 1
    for (int g = 0; g < 4; ++g) {
        bf16x8 wf[4];
#pragma unroll
        for (int ks = 0; ks < 4; ++ks) wf[ks] = *(const bf16x8*)(a.W + ((size_t)(g * 128 + 16 * wid + fr)) * 128 + 32 * ks + 8 * fq);
        const float bias = a.gb[g * 128 + 16 * wid + fr];
        f32x4 y[4]; float ss = 0.f;
#pragma unroll
        for (int ct = 0; ct < 4; ++ct) {
            f32x4 acc = (f32x4){0.f, 0.f, 0.f, 0.f};
#pragma unroll
            for (int ks = 0; ks < 4; ++ks) { const bf16x8 vf = *(const LAS bf16x8*)(lds + (64 * g + 16 * ct + fr) * VP + (32 * ks + 8 * fq) * 2); acc = __builtin_amdgcn_mfma_f32_16x16x32_bf16(vf, wf[ks], acc, 0, 0, 0); }
            const u32x2 uu = *(const u32x2*)(a.GU + row * 256 + 64 * g + 16 * ct + 4 * fq);
            y[ct][0] = bflo(uu.x) * (acc[0] + bias); y[ct][1] = bfhi(uu.x) * (acc[1] + bias); y[ct][2] = bflo(uu.y) * (acc[2] + bias); y[ct][3] = bfhi(uu.y) * (acc[3] + bias);
            ss += (y[ct][0] * y[ct][0] + y[ct][1] * y[ct][1]) + (y[ct][2] * y[ct][2] + y[ct][3] * y[ct][3]);
        }
        ss = sum_x16x32(ss);
        const float rs = __builtin_amdgcn_rsqf(ss * (1.0f / 64.0f) + EPS);
#pragma unroll
        for (int ct = 0; ct < 4; ++ct) { const float rq = rs * YS;
            *(unsigned*)((unsigned char*)a.Y + row * D + 256 + 64 * g + 16 * ct + 4 * fq) = pk_i8x4(y[ct][0] * rq, y[ct][1] * rq, y[ct][2] * rq, y[ct][3] * rq); }
    }
    __syncthreads();
}
}

DI int phys_head(int l) { return 128 * ((l >> 5) & 1) + 32 * (l >> 6) + 16 * ((l >> 2) & 1) + 4 * ((l >> 3) & 3) + (l & 3); }
DI int phys_glu(int c) { return 128 * ((c >> 3) & 1) + 32 * (c >> 6) + 16 * (c & 1) + 4 * ((c >> 4) & 3) + ((c >> 1) & 3); }
DI void tr_item_f8(const float* W, size_t ldw, int k0, size_t c0, unsigned char* WT8tile, int l0, LAS bf16* scr, int lane) {
    { const int kr = lane >> 4, c4 = lane & 15; const GAS float* Wg = (const GAS float*)W;
#pragma unroll 8
      for (int it = 0; it < 16; ++it) { const int kk = 4 * it + kr; const f32x4 v = *(const GAS f32x4*)(Wg + (size_t)(k0 + kk) * ldw + c0 + 4 * c4) * 64.0f;
          *(LAS unsigned*)(scr + kk * 66 + 4 * c4) = pk2(v[0], v[1]); *(LAS unsigned*)(scr + kk * 66 + 4 * c4 + 2) = pk2(v[2], v[3]); } }
    LDS_WAIT(); asm volatile("" ::: "memory");
    const int c = lane & 7;
#pragma unroll
    for (int jj = 0; jj < 8; ++jj) { const int o = (lane >> 3) + 8 * jj; const LAS bf16* s = scr + (8 * c) * 66 + o;
        u32x2 w; w.x = pk_fp8x4(bf2f(s[0]), bf2f(s[66]), bf2f(s[2 * 66]), bf2f(s[3 * 66])); w.y = pk_fp8x4(bf2f(s[4 * 66]), bf2f(s[5 * 66]), bf2f(s[6 * 66]), bf2f(s[7 * 66]));
        *(GAS u32x2*)((GAS unsigned char*)WT8tile + (size_t)phys_head(l0 + o) * 1024 + k0 + 8 * c) = w; }
    LDS_WAIT(); asm volatile("" ::: "memory");
}
DI void tr_item(const float* W, size_t ldw, int k0, size_t c0, bf16* WTtile, int l0, bool glu, LAS bf16* scr, int lane) {
#pragma unroll 8
    for (int kk = 0; kk < 64; ++kk) scr[kk * 66 + lane] = f2bf(W[(size_t)(k0 + kk) * ldw + c0 + lane]);
    LDS_WAIT(); asm volatile("" ::: "memory");
    const int c = lane & 7;
#pragma unroll
    for (int jj = 0; jj < 8; ++jj) { const int o = (lane >> 3) + 8 * jj; const LAS bf16* s = scr + (8 * c) * 66 + o;
        u32x4 w; w.x = (unsigned)s[0] | ((unsigned)s[66] << 16); w.y = (unsigned)s[2 * 66] | ((unsigned)s[3 * 66] << 16); w.z = (unsigned)s[4 * 66] | ((unsigned)s[5 * 66] << 16); w.w = (unsigned)s[6 * 66] | ((unsigned)s[7 * 66] << 16);
        const int pr = glu ? phys_glu(l0 + o) : phys_head(l0 + o);
        *(u32x4*)(WTtile + (size_t)pr * D + k0 + 8 * c) = w; }
    LDS_WAIT(); asm volatile("" ::: "memory");
}
DI void gu_item_i8(LAS unsigned char* lds, const float* W, size_t ldw, size_t c0, int cbk, bool glu, signed char* W8, float* CS, int tid, int wid, int lane, const float* rg = nullptr) {
    LAS bf16* scr = (LAS bf16*)lds; LAS float* cmx = (LAS float*)(lds + LDSCTL_OFF + 1024);
    { const int kr = lane >> 4, c4 = lane & 15; const GAS float* Wg = (const GAS float*)W;
      f32x4 mx = (f32x4){0.f, 0.f, 0.f, 0.f};
#pragma unroll 8
      for (int it = 0; it < 32; ++it) { const int k = 128 * wid + 4 * it + kr; f32x4 v = *(const GAS f32x4*)(Wg + (size_t)k * ldw + c0 + 4 * c4); if (rg) v = v * rg[k];
          mx[0] = fmaxf(mx[0], fabsf(v[0])); mx[1] = fmaxf(mx[1], fabsf(v[1])); mx[2] = fmaxf(mx[2], fabsf(v[2])); mx[3] = fmaxf(mx[3], fabsf(v[3]));
          *(LAS unsigned*)(scr + k * 66 + 4 * c4) = pk2(v[0], v[1]); *(LAS unsigned*)(scr + k * 66 + 4 * c4 + 2) = pk2(v[2], v[3]); }
#pragma unroll
      for (int j = 0; j < 4; ++j) mx[j] = max_x16x32(mx[j]);
      if (kr == 0) *(LAS f32x4*)(cmx + wid * 64 + 4 * c4) = mx; }
    __syncthreads();
    if (tid < 64) { float m = cmx[tid];
#pragma unroll
        for (int w = 1; w < 8; ++w) m = fmaxf(m, cmx[w * 64 + tid]);
        m = fmaxf(m, 1e-30f); cmx[512 + tid] = m; CS[(cbk >> 2) * 256 + (glu ? phys_glu((cbk & 3) * 64 + tid) : phys_head((cbk & 3) * 64 + tid))] = m * (1.0f / 127.0f); }
    __syncthreads();
#pragma unroll 2
    for (int it = 0; it < 8; ++it) { const int r = (it * 512 + tid) >> 6, o = 16 * (r & 3) + ((tid >> 2) & 15), kc = 4 * (r >> 2) + (tid & 3);
        const float qs = 127.0f / cmx[512 + o]; const LAS bf16* sp = scr + (16 * kc) * 66 + o;
        unsigned w[4];
#pragma unroll
        for (int g = 0; g < 4; ++g) { unsigned acc = 0;
#pragma unroll
            for (int i = 0; i < 4; ++i) { int q = (int)rintf(bf2f(sp[(4 * g + i) * 66]) * qs); q = q > 127 ? 127 : (q < -127 ? -127 : q); acc |= (unsigned)(q & 255) << (8 * i); }
            w[g] = acc; }
        *(GAS u32x4*)((GAS signed char*)W8 + ((size_t)((cbk >> 2) * 256 + (glu ? phys_glu((cbk & 3) * 64 + o) : phys_head((cbk & 3) * 64 + o)))) * 1024 + 16 * kc) = (u32x4){w[0], w[1], w[2], w[3]}; }
    __syncthreads();
}
DI void prologue(LAS unsigned char* lds, unsigned char* ws) {
    const KArgP ka = kargs();
#define in (ka->in)
    const int tid = opaque_tid(), wid = __builtin_amdgcn_readfirstlane(tid >> 6), lane = tid & 63;
    const int G = gridDim.x, B = opaque_bid();
    float* MOD = (float*)(ws + WS_MOD);
    if (B < 192) {
        LAS float* sl = (LAS float*)lds;
        LAS float* red = (LAS float*)(lds + 17 * 1024 * 4);
        for (int i = tid; i < 17 * 1024; i += 512) { const int r = i >> 10, k = i & 1023; const float v = r < 16 ? in.c[r * 1024 + k] : in.c_ctx[k]; sl[i] = v / (1.0f + __expf(-v)); }
        __syncthreads();
        for (int it = B; it < 192; it += G) {
            const int l = it / 48, cb = it % 48; const float* wp = in.w_ada + ((size_t)l * 1024 + 128 * wid) * 6144 + 128 * cb + 2 * lane;
            f32x2 acc[17];
#pragma unroll
            for (int r = 0; r < 17; ++r) acc[r] = (f32x2){0.f, 0.f};
#pragma unroll 4
            for (int k = 0; k < 128; ++k) { const f32x2 w = *(const f32x2*)(wp + (size_t)k * 6144);
#pragma unroll
                for (int r = 0; r < 17; ++r) { const float s = sl[r * 1024 + 128 * wid + k]; acc[r] = acc[r] + w * s; } }
            if (wid > 0) {
#pragma unroll
                for (int r = 0; r < 17; ++r) *(LAS f32x2*)(red + ((wid - 1) * 17 + r) * 128 + 2 * lane) = acc[r]; }
            __syncthreads();
            if (wid == 0) {
#pragma unroll
                for (int r = 0; r < 17; ++r) { f32x2 s = acc[r];
#pragma unroll
                    for (int w = 0; w < 7; ++w) s = s + *(const LAS f32x2*)(red + (w * 17 + r) * 128 + 2 * lane);
                    const f32x2 bb = *(const f32x2*)(in.b_ada + (size_t)l * 6144 + 128 * cb + 2 * lane);
                    *(f32x2*)(MOD + ((size_t)l * 17 + r) * 6144 + 128 * cb + 2 * lane) = s + bb; } }
            __syncthreads();
        }
    }
    __syncthreads();
    const size_t gt = (size_t)B * 512 + tid, gs = (size_t)G * 512;
    { float* rc = (float*)(ws + WS_ROPE); float* rs = rc + 65 * 16;
      if (gt < 16) { rc[64 * 16 + gt] = 1.0f; rs[64 * 16 + gt] = 0.0f; }
      for (size_t i = gt; i < (size_t)64 * 16; i += gs) { const int pos = (int)(i >> 4), k = (int)(i & 15); const float invf = powf(10000.0f, -(float)k / 16.0f);
          const float ang = (float)pos * invf; rc[i] = cosf(ang); rs[i] = sinf(ang); } }
    { bf16* WG = (bf16*)(ws + WS_WG);
      for (size_t i = gt; i < (size_t)DEPTH * 16 * 1024; i += gs) { const int l = (int)(i >> 14), n = (int)((i >> 10) & 15), k = (int)(i & 1023);
          const float v = in.w_in[((size_t)l * 1024 + k) * DIN + 1024 + n]; const bf16 hi = f2bf(v); WG[((size_t)(l * 2) * 16 + n) * 1024 + k] = hi; WG[((size_t)(l * 2 + 1) * 16 + n) * 1024 + k] = f2bf(v - bf2f(hi)); } }
    { bf16* WR = (bf16*)(ws + WS_WR);
      for (size_t i = gt; i < (size_t)DEPTH * 32 * 1024; i += gs) { const int l = (int)(i >> 15), n = (int)((i >> 10) & 31), k = (int)(i & 1023);
          const float v = in.router_w[((size_t)l * 1024 + k) * 32 + n]; const bf16 hi = f2bf(v); WR[((size_t)(l * 2) * 32 + n) * 1024 + k] = hi; WR[((size_t)(l * 2 + 1) * 32 + n) * 1024 + k] = f2bf(v - bf2f(hi)); } }
    { bf16* GW = (bf16*)(ws + WS_GWS);
      for (size_t i = gt; i < (size_t)DEPTH * 4 * 128 * 128; i += gs) GW[i] = f2bf(in.gmlp_ws[i]); }
    __syncthreads();
    for (int it = B; it < DEPTH * NE * 32; it += G) { const int le = it >> 5, cbk = it & 31;
        gu_item_i8(lds, in.w_gate_up + (size_t)le * 1024 * 2048, 2048, (size_t)cbk * 64, cbk, true, (signed char*)(ws + WS_WGU) + (size_t)le * 2048 * 1024, (float*)(ws + WS_CSGU) + (size_t)le * 2048, tid, wid, lane); }
    for (int it = B; it < DEPTH * 36; it += G) { const int l = it / 36, cbk = it % 36;
        gu_item_i8(lds, in.w_in + (size_t)l * 1024 * DIN, DIN, (size_t)cbk * 64 + (cbk >= 16 ? 16 : 0), cbk, false, (signed char*)(ws + WS_WIN) + (size_t)l * NPROJ * 1024, (float*)(ws + WS_CSIN) + (size_t)l * NPROJ, tid, wid, lane); }
    for (int it = B; it < DEPTH * 16; it += G) { const int l = it >> 4, cbk = it & 15;
        gu_item_i8(lds, in.w_out + (size_t)l * 1024 * 1024, 1024, (size_t)cbk * 64, cbk, false, (signed char*)(ws + WS_WOUT) + (size_t)l * 1024 * 1024, (float*)(ws + WS_CSOUT) + (size_t)l * 1024, tid, wid, lane, in.mix_norm + (size_t)l * 1024); }
    {
        LAS bf16* scr = (LAS bf16*)(lds + wid * (64 * 66 * 2));
        const int vcu = (G % 8 == 0) ? (B % 8) * (G / 8) + B / 8 : B;
        const long gw = (long)vcu * 8 + wid, NGW = (long)G * 8;
        constexpr long I_IN = 0, I_OUT = 0, I_GU = 0, I_DN = (long)DEPTH * NE * 16 * 16;
        for (long it = gw; it < I_IN + I_OUT + I_GU + I_DN; it += NGW) {
            long r = it;
            if (r < I_IN) { const int l = (int)(r / (36 * 16)), q = (int)(r % (36 * 16)), cbk = q >> 4, kb = q & 15;
                const size_t c0 = (size_t)cbk * 64 + (cbk >= 16 ? 16 : 0);
                tr_item(in.w_in + (size_t)l * 1024 * DIN, DIN, 64 * kb, c0, (bf16*)(ws + WS_WIN) + ((size_t)l * NPROJ + (size_t)(cbk >> 2) * 256) * D, (cbk & 3) * 64, false, scr, lane); continue; }
            r -= I_IN;
            if (r < I_OUT) { const int l = (int)(r >> 8), q = (int)(r & 255), cbk = q >> 4, kb = q & 15;
                tr_item_f8(in.w_out + (size_t)l * 1024 * 1024, 1024, 64 * kb, (size_t)cbk * 64, (unsigned char*)(ws + WS_WOUT) + ((size_t)l * 1024 + (size_t)(cbk >> 2) * 256) * D, (cbk & 3) * 64, scr, lane); continue; }
            r -= I_OUT;
            if (r < I_GU) { const int le = (int)(r >> 9), q = (int)(r & 511), cbk = q >> 4, kb = q & 15;
                tr_item(in.w_gate_up + (size_t)le * 1024 * 2048, 2048, 64 * kb, (size_t)cbk * 64, (bf16*)(ws + WS_WGU) + ((size_t)le * 2048 + (size_t)(cbk >> 2) * 256) * D, (cbk & 3) * 64, true, scr, lane); continue; }
            r -= I_GU;
            { const int le = (int)(r >> 8), q = (int)(r & 255), cbk = q >> 4, kb = q & 15;
                tr_item_f8(in.w_down + (size_t)le * 1024 * 1024, 1024, 64 * kb, (size_t)cbk * 64, (unsigned char*)(ws + WS_WDN) + ((size_t)le * 1024 + (size_t)(cbk >> 2) * 256) * D, (cbk & 3) * 64, scr, lane); }
        }
    }
    __syncthreads();
#undef in
}

DI void moe_convert_item(LAS unsigned char* lds, unsigned char* ws, int l, int it) {
    const int tid = opaque_tid(), wid = __builtin_amdgcn_readfirstlane(tid >> 6), lane = tid & 63;
    const KArgP ka = kargs();
    if (it < 1024) { const int le = l * NE + (it >> 5), cbk = it & 31;
        gu_item_i8(lds, (const float*)ka->in.w_gate_up + (size_t)le * 1024 * 2048, 2048, (size_t)cbk * 64, cbk, true, (signed char*)(ws + WS_WGU) + (size_t)le * 2048 * 1024, (float*)(ws + WS_CSGU) + (size_t)le * 2048, tid, wid, lane); }
    else { const int r = it - 1024, le = l * NE + (r >> 5), q = r & 31, cbk = q >> 1, kb = (q & 1) * 8 + wid;
        tr_item_f8((const float*)ka->in.w_down + (size_t)le * 1024 * 1024, 1024, 64 * kb, (size_t)cbk * 64, (unsigned char*)(ws + WS_WDN) + ((size_t)le * 1024 + (size_t)(cbk >> 2) * 256) * D, (cbk & 3) * 64, (LAS bf16*)(lds + wid * (64 * 66 * 2)), lane); }
}

constexpr int N_PHASES = 2 + 8 * DEPTH;
DI int q_next(unsigned* head, LAS int* bc) {
    if (opaque_tid() == 0) bc[0] = (int)__hip_atomic_fetch_add(head, 1u, RLX_AGENT);
    __syncthreads(); const int v = bc[0]; __syncthreads(); return v;
}
__global__ void __launch_bounds__(512, 2) mega_fwd(Args args) {
    extern __shared__ __attribute__((aligned(16))) unsigned char lds_raw[];
    LAS unsigned char* lds = (LAS unsigned char*)lds_raw;
    const int tid = threadIdx.x;
    volatile LAS unsigned* MISC = (volatile LAS unsigned*)(lds + LDSCTL_OFF);
    for (int u = tid; u < 64; u += 512) MISC[u] = 0u;
    __syncthreads();
    unsigned char* ws = kargs()->ws;
    unsigned* ctl = (unsigned*)(ws + WS_CTL);
    const int lo = kargs()->ph_lo, hi = kargs()->ph_hi;
    XcdBarrier bar; bar.bar = ctl + CW_BAR; bar.x = 0; bar.st = nullptr;
    if (hi - lo > 1) bar = xcd_barrier_post(ctl + CW_BAR, MISC + 8);
    LAS int* qbc = (LAS int*)(lds + LDSCTL_OFF + 128);
    const int G = gridDim.x;
#define IN(k) (lo <= (k) && (k) < hi)
#define SEAM(k) do { if (IN(k) && IN((k) + 1)) xcd_barrier(bar); } while (0)

#ifndef EN_MASK
#define EN_MASK 0xFFFF
#endif
#define EN(b) ((EN_MASK >> (b)) & 1)
#ifndef REP_MASK
#define REP_MASK 0
#endif
#ifndef DUP_MASK
#define DUP_MASK 0
#endif
#define NREP(b) (((REP_MASK >> (b)) & 1) ? 2 : 1)
    if (EN(0) && IN(0)) { for (int rep = 0; rep < NREP(0); ++rep) { prologue(lds, ws); SEAM(0); } }

    for (int l = 0; l < DEPTH; ++l) {
        const int pb = 1 + 8 * l;
        ws = opaque_ptr(ws);
        const float* modl = (const float*)(ws + WS_MOD) + (size_t)l * 17 * 6144;
        if (EN(1) && IN(pb)) {
            NormArgs a{}; const KArgP ka = kargs();
            a.xin = l == 0 ? nullptr : (const float*)(ws + WS_XLA + (size_t)((l - 1) & 1) * XL_BYTES); a.delta = l == 0 ? nullptr : (const bf16*)(ws + WS_H); a.dsc = (const float*)(ws + WS_DSC); a.x0 = ka->in.x; a.ctx0 = ka->in.ctx;
            a.mout = l == 0 ? nullptr : (const bf16*)(ws + WS_MOUT); a.msc = (const float*)(ws + WS_MSC); a.toks = (const int*)(ws + WS_TOKS); a.g2mod = modl - 17 * 6144;
            a.mod = modl; a.shi = 0; a.sci = 1; a.xout = (float*)(ws + WS_XLA + (size_t)(l & 1) * XL_BYTES); a.hout = nullptr; a.h8 = (signed char*)(ws + WS_H8); a.hs = (float*)(ws + WS_HS);
            a.wsm = (const bf16*)(ws + WS_WG) + (size_t)l * 2 * 16 * 1024; a.sbias = ka->in.b_in + (size_t)l * DIN + 1024; a.mg = (float*)(ws + WS_MG);
            for (int rep = 0; rep < NREP(1); ++rep) { norm_phase<0>(lds, a); SEAM(pb); }
        }
        if (EN(2) && IN(pb + 1)) {
            pg8::TileOrder S; S.init(NRT, NPROJ / 256, G, opaque_bid());
            SrcPlain8 src{(const char*)(ws + WS_WIN) + (size_t)l * NPROJ * D};
            { LAS float* rl_ = (LAS float*)(lds + ROPE_LDS_OFF); const float* rg_ = (const float*)(ws + WS_ROPE); const int t_ = opaque_tid();
              for (int i = t_; i < 2080; i += 512) rl_[i] = rg_[i];
              if (t_ < 128) rl_[2080 + t_] = (t_ < 64) ? kargs()->in.q_norm[l * 64 + t_] : kargs()->in.k_norm[l * 64 + t_ - 64];
              __syncthreads(); }
            EpiInProj E{ws, l, (const LAS float*)(lds + ROPE_LDS_OFF)};
            for (int rep = 0; rep < NREP(2); ++rep) { pg8::gemm_phase<EpiInProj, SrcPlain8, false, 1>(lds, (const bf16*)(ws + WS_H8), S, src, E); SEAM(pb + 1); }
        }
        if (IN(pb + 2)) {
            const float* mixn = kargs()->in.mix_norm + (size_t)l * D;
            if (EN(3)) for (int rep = 0; rep < NREP(3); ++rep) { mlstm::Args ma{(const bf16*)(ws + WS_MQ), (const bf16*)(ws + WS_MK), (const bf16*)(ws + WS_MV), (const bf16*)(ws + WS_MO), (const float*)(ws + WS_MG), (float*)(ws + WS_HFB), (bf16*)(ws + WS_Y), mixn};
              for (;;) { const int idx = q_next(ctl + CW_Q + 64 * ((rep * 4 + l) * 3 + 0), qbc); if (idx >= NB * 4) break; mlstm::item(lds, ma, idx >> 2, idx & 3); } }
            if (EN(4)) for (int rep = 0; rep < NREP(4); ++rep) { const int nlat = NB * 8 * 16, ntot = nlat + (l < DEPTH - 1 ? NB * 8 : 0);
              const unsigned char* AQ = (const unsigned char*)(ws + WS_AQ); const unsigned char* AK = (const unsigned char*)(ws + WS_AK); const bf16* AV = (const bf16*)(ws + WS_AV); unsigned char* Y = (unsigned char*)(ws + WS_Y);
              float gq = 0.f, gk = 0.f; { const int ln = opaque_tid() & 63; gq = fabsf(((const float*)kargs()->in.q_norm)[l * 64 + ln]); gk = fabsf(((const float*)kargs()->in.k_norm)[l * 64 + ln]); }
              const float sbound = 8.0f * wave_max(gq) * wave_max(gk) * 1.4426950408889634f * 1.13f;
#define ATT_LOOP(NM) for (;;) { const int idx = q_next(ctl + CW_Q + 64 * ((rep * 4 + l) * 3 + 1), qbc); if (idx >= ntot) break; \
                  int b, h, nt; size_t qrow; \
                  if (idx < nlat) { const int qb = idx & 15, hq = (idx >> 4) & 3, kvh = (idx >> 6) & 1; b = idx >> 7; h = kvh * 4 + hq; nt = TKV / 64; qrow = (size_t)NCTX + (size_t)b * T + (size_t)qb * 256; } \
                  else { const int i2 = idx - nlat; b = i2 >> 3; h = i2 & 7; nt = TC / 64; qrow = (size_t)b * TC; } \
                  const size_t kvo = (size_t)(b * 2 + (h >> 2)) * TKV * 64; \
                  attn_body::attn_unit<8, NM>(AQ + qrow * 512 + h * 64, AK + kvo, AV + kvo, nt, Y + qrow * D + 512 + h * 64, mixn + 512 + h * 64, (char*)lds_raw); }
              if (__builtin_amdgcn_readfirstlane(sbound < 100.0f ? 1 : 0)) { ATT_LOOP(true) } else { ATT_LOOP(false) }
#undef ATT_LOOP
              }
            if (EN(5)) for (int rep = 0; rep < NREP(5); ++rep) { gmlp::Args ga{(const bf16*)(ws + WS_GU), (const bf16*)(ws + WS_GV), (const bf16*)(ws + WS_GWS) + (size_t)l * 4 * 128 * 128, kargs()->in.gmlp_b + (size_t)l * 4 * 128, kargs()->in.gmlp_norm + (size_t)l * 256, mixn, (bf16*)(ws + WS_Y)};
              const int nlat = NB * 32, ntot = nlat + (l < DEPTH - 1 ? NB * 2 : 0);
              for (;;) { const int idx = q_next(ctl + CW_Q + 64 * ((rep * 4 + l) * 3 + 2), qbc); if (idx >= ntot) break;
                  const size_t row0 = idx < nlat ? (size_t)NCTX + (size_t)(idx >> 5) * T + (size_t)(idx & 31) * 128 : (size_t)((idx - nlat) >> 1) * TC + (size_t)((idx - nlat) & 1) * 128;
                  gmlp::item(lds, ga, row0); } }
            SEAM(pb + 2);
        }
        if (EN(6) && IN(pb + 3)) {
            pg8::TileOrder S; S.init(NRT, D / 256, G, opaque_bid());
            SrcPlain8 src{(const char*)(ws + WS_WOUT) + (size_t)l * D * D};
            EpiOutProj E{ws, l};
            for (int rep = 0; rep < NREP(6); ++rep) { pg8::gemm_phase<EpiOutProj, SrcPlain8, false, 1>(lds, (const bf16*)(ws + WS_Y), S, src, E); SEAM(pb + 3); }
        }
        if (EN(7) && IN(pb + 4)) {
            NormArgs a{};
            a.xin = (const float*)(ws + WS_XLA + (size_t)(l & 1) * XL_BYTES); a.delta = (const bf16*)(ws + WS_H); a.dsc = (const float*)(ws + WS_DSC); a.mout = nullptr; a.mod = modl; a.shi = 3; a.sci = 4; a.xout = nullptr; a.hout = nullptr; a.h8 = (signed char*)(ws + WS_H8); a.hs = (float*)(ws + WS_HS);
            a.wsm = (const bf16*)(ws + WS_WR) + (size_t)l * 2 * 32 * 1024; a.sbias = kargs()->in.router_b + (size_t)l * 32;
            a.toke = (int*)(ws + WS_TOKE); a.tokg = (float*)(ws + WS_TOKG); a.ghist = (int*)(ws + WS_GHIST); a.bhist = (int*)(ws + WS_BHIST); a.gs = (l == DEPTH - 1) ? NCTX / 16 : 0;
            for (int rep = 0; rep < NREP(7); ++rep) { norm_phase<1>(lds, a); SEAM(pb + 4); }
        }
        if (EN(8) && IN(pb + 5)) {
            ScatterArgs a{(const int*)(ws + WS_TOKE), (const float*)(ws + WS_TOKG), (const int*)(ws + WS_GHIST), (const int*)(ws + WS_BHIST), (int*)(ws + WS_TOKS), (int*)(ws + WS_SLTOK), (float*)(ws + WS_SLG), (int*)(ws + WS_RTE), (const float*)(ws + WS_HS), (float*)(ws + WS_SLS), (l == DEPTH - 1) ? NCTX / 16 : 0, (unsigned char*)(ws + WS_RTEB)};
            for (int rep = 0; rep < NREP(8); ++rep) { scatter_phase(lds, a); SEAM(pb + 5); }
        }
        if (EN(9) && IN(pb + 6)) {
            const int* rte = (const int*)(ws + WS_RTE);
            pg8::TileOrder S; S.init(__builtin_amdgcn_readfirstlane(rte[0]), 2 * DFF / 256, G, opaque_bid());
            SrcMoeGather src{ws, l};
            EpiGateUp E{ws, l};
            for (int rep = 0; rep < NREP(9); ++rep) { pg8::gemm_phase<EpiGateUp, SrcMoeGather, false, 1>(lds, (const bf16*)(ws + WS_H8), S, src, E); SEAM(pb + 6); }
        }
        if (EN(10) && IN(pb + 7)) {
            const int* rte = (const int*)(ws + WS_RTE);
            pg8::TileOrder S; S.init(__builtin_amdgcn_readfirstlane(rte[0]), D / 256, G, opaque_bid());
            SrcMoePlain src{ws, l};
            EpiDown E{ws, l};
            for (int rep = 0; rep < NREP(10); ++rep) { pg8::gemm_phase<EpiDown, SrcMoePlain, false, 2>(lds, (const bf16*)(ws + WS_ACT), S, src, E); SEAM(pb + 7); }
        }
    }
    if (EN(11) && IN(N_PHASES - 1)) {
        NormArgs a{};
        a.xin = (const float*)(ws + WS_XLA + (size_t)((DEPTH - 1) & 1) * XL_BYTES); a.delta = (const bf16*)(ws + WS_H); a.dsc = (const float*)(ws + WS_DSC); a.mout = (const bf16*)(ws + WS_MOUT); a.msc = (const float*)(ws + WS_MSC); a.toks = (const int*)(ws + WS_TOKS); a.g2mod = (const float*)(ws + WS_MOD) + (size_t)(DEPTH - 1) * 17 * 6144;
        a.fnorm = kargs()->in.final_norm; a.out = kargs()->out;
        norm_phase<2>(lds, a);
    }
#undef IN
#undef SEAM
}

extern "C" void kernel_launch(void* const* d_in, const int* in_sizes, int n_in, void* d_out, int out_size, void* d_ws, size_t ws_size, hipStream_t stream) {
    static int grid = 0;
    if (grid == 0) {
        if (n_in != 22 || out_size != NLAT * D || ws_size < WS_END) { fprintf(stderr, "kernel_launch: unexpected shapes (n_in %d, out %d, ws %zu, need %zu)\n", n_in, out_size, ws_size, (size_t)WS_END); grid = -1; return; }
        int dev = 0, cus = 0, per_cu = 0;
        if (hipGetDevice(&dev) != hipSuccess || hipDeviceGetAttribute(&cus, hipDeviceAttributeMultiprocessorCount, dev) != hipSuccess) { grid = -1; return; }
        if (hipFuncSetAttribute((const void*)mega_fwd, hipFuncAttributeMaxDynamicSharedMemorySize, LDS_BYTES) != hipSuccess) { fprintf(stderr, "kernel_launch: hipFuncSetAttribute failed\n"); grid = -1; return; }
        if (hipOccupancyMaxActiveBlocksPerMultiprocessor(&per_cu, (const void*)mega_fwd, 512, LDS_BYTES) != hipSuccess || per_cu < 1) { fprintf(stderr, "kernel_launch: occupancy query says %d\n", per_cu); per_cu = 1; }
        (void)hipGetLastError();
        grid = cus;
    }
    if (grid < 0) return;
    if (hipMemsetAsync((char*)d_ws + WS_CTL, 0, CTL_ZERO_BYTES, stream) != hipSuccess) return;
    Args a{};
    const float** ip = (const float**)&a.in;
    for (int i = 0; i < 22; ++i) ip[i] = (const float*)d_in[i];
    a.out = (float*)d_out; a.ws = (unsigned char*)d_ws;
#if MK_N_LAUNCHES == 1
    a.ph_lo = 0; a.ph_hi = N_PHASES;
    hipLaunchKernelGGL(mega_fwd, dim3(grid), dim3(512), LDS_BYTES, stream, a);
#else
    for (int p = 0; p < N_PHASES; ++p) { a.ph_lo = p; a.ph_hi = p + 1; hipLaunchKernelGGL(mega_fwd, dim3(grid), dim3(512), LDS_BYTES, stream, a); }
#endif
}
```

```cpp
#include <hip/hip_runtime.h>
#include <cstdio>
#include <cstdint>

#ifndef MK_N_LAUNCHES
#define MK_N_LAUNCHES 1
#endif

#define GAS __attribute__((address_space(1)))
#define LAS __attribute__((address_space(3)))
#define DI __device__ __forceinline__
typedef unsigned short bf16;
typedef short bf16x8 __attribute__((ext_vector_type(8)));
typedef float f32x4 __attribute__((ext_vector_type(4)));
typedef float f32x2 __attribute__((ext_vector_type(2)));
typedef unsigned u32x4 __attribute__((ext_vector_type(4)));
typedef int i32x4 __attribute__((ext_vector_type(4)));
typedef unsigned u32x2 __attribute__((ext_vector_type(2)));
typedef __bf16 bf16x2_t __attribute__((ext_vector_type(2)));
typedef GAS unsigned gu32;

constexpr int D = 1024, NB = 16, T = 4096, TC = 256, DEPTH = 4;
constexpr int NCTX = NB * TC;
constexpr int NLAT = NB * T;
constexpr int NTOK = NCTX + NLAT;
constexpr int NRT = NTOK / 256;
constexpr int TKV = TC + T;
constexpr int DIN = 2320, NPROJ = 2304;
constexpr int NE = 32, TOPK = 4, DFF = 1024;
constexpr int NSLOT_MAX = NTOK * TOPK + NE * 256;
constexpr int NRT_MOE_MAX = NSLOT_MAX / 256;
constexpr int NGRP = NTOK / 16;
constexpr float EPS = 1e-6f;
constexpr float C2 = 0.125f * 1.4426950408889634f;

constexpr size_t al256(size_t x) { return (x + 255) & ~(size_t)255; }
constexpr size_t WS_CTL = 0, CTL_ZERO_BYTES = 1u << 20;
constexpr size_t WS_WIN = CTL_ZERO_BYTES;
constexpr size_t WS_WOUT = WS_WIN + (size_t)DEPTH * NPROJ * D * 2;
constexpr size_t WS_WGU = WS_WOUT + (size_t)DEPTH * D * D * 2;
constexpr size_t WS_WDN = WS_WGU + (size_t)DEPTH * NE * 2 * DFF * D * 2;
constexpr size_t WS_WG = WS_WDN + (size_t)DEPTH * NE * D * DFF * 2;
constexpr size_t WS_WR = WS_WG + (size_t)DEPTH * 2 * 16 * D * 2;
constexpr size_t WS_GWS = WS_WR + (size_t)DEPTH * 2 * 32 * D * 2;
constexpr size_t WS_MOD = WS_GWS + (size_t)DEPTH * 4 * 128 * 128 * 2;
constexpr size_t WS_ROPE = al256(WS_MOD + (size_t)DEPTH * 17 * 6 * D * 4);
constexpr size_t WS_XLA = al256(WS_ROPE + (size_t)2 * 65 * 16 * 4);
constexpr size_t XL_BYTES = (size_t)NTOK * D * 2;
constexpr size_t WS_XLB = WS_XLA + (size_t)NTOK * D * 4;
constexpr size_t WS_H = WS_XLB + (size_t)NTOK * D * 4;
constexpr size_t WS_Y = WS_H + (size_t)NTOK * D * 2;
constexpr size_t WS_MQ = WS_Y + (size_t)NTOK * D * 2;
constexpr size_t WS_MK = WS_MQ + (size_t)NTOK * 256 * 2;
constexpr size_t WS_MV = WS_MK + (size_t)NTOK * 256 * 2;
constexpr size_t WS_MO = WS_MV + (size_t)NTOK * 256 * 2;
constexpr size_t WS_MG = WS_MO + (size_t)NTOK * 256 * 2;
constexpr size_t WS_GU = WS_MG + (size_t)NTOK * 16 * 4;
constexpr size_t WS_GV = WS_GU + (size_t)NTOK * 256 * 2;
constexpr size_t WS_AQ = WS_GV + (size_t)NTOK * 256 * 2;
constexpr size_t WS_AK = WS_AQ + (size_t)NTOK * 512 * 2;
constexpr size_t WS_AV = WS_AK + (size_t)NB * 2 * TKV * 64 * 2;
constexpr size_t WS_HFB = WS_AV + (size_t)NB * 2 * TKV * 64 * 2;
constexpr size_t WS_TOKE = WS_HFB + (size_t)NB * 4 * 2 * TKV * 64 * 4;
constexpr size_t WS_TOKG = WS_TOKE + (size_t)NTOK * 4 * 4;
constexpr size_t WS_TOKS = WS_TOKG + (size_t)NTOK * 4 * 4;
constexpr size_t WS_GHIST = WS_TOKS + (size_t)NTOK * 4 * 4;
constexpr size_t WS_BHIST = WS_GHIST + (size_t)NGRP * 32 * 4;
constexpr size_t WS_SLTOK = WS_BHIST + (size_t)1024 * 32 * 4;
constexpr size_t WS_SLG = WS_SLTOK + (size_t)NSLOT_MAX * 4;
constexpr size_t WS_RTE = WS_SLG + (size_t)NSLOT_MAX * 4;
constexpr size_t WS_RTEB = al256(WS_RTE + (size_t)(NRT_MOE_MAX + 64) * 4);
constexpr size_t WS_ACT = al256(WS_RTEB + 2048);
constexpr size_t WS_MOUT = WS_ACT + (size_t)NSLOT_MAX * DFF * 2;
constexpr size_t WS_CSGU = WS_MOUT + (size_t)NSLOT_MAX * D * 2;
constexpr size_t WS_H8 = WS_CSGU + (size_t)DEPTH * NE * 2 * DFF * 4;
constexpr size_t WS_HS = WS_H8 + (size_t)NTOK * D;
constexpr size_t WS_SLS = WS_HS + (size_t)NTOK * 4;
constexpr size_t WS_CSIN = al256(WS_SLS + (size_t)NSLOT_MAX * 4);
constexpr size_t WS_MSC = al256(WS_CSIN + (size_t)DEPTH * NPROJ * 4);
constexpr size_t WS_DSC = al256(WS_MSC + (size_t)NSLOT_MAX * 16 * 4);
constexpr size_t WS_CSOUT = al256(WS_DSC + (size_t)NTOK * 16 * 4);
constexpr size_t WS_END = al256(WS_CSOUT + (size_t)DEPTH * D * 4);
static_assert(WS_END < (size_t)4200 * 1000 * 1000, "workspace map exceeds 4x the largest input");

constexpr int CW_TMO = 0;
constexpr int CW_Q = 64;
constexpr int CW_BAR = 4096;

constexpr int SCR_BYTES = 135168;
constexpr int LDSCTL_OFF = SCR_BYTES;
constexpr int ROPE_LDS_OFF = LDSCTL_OFF + 4096 + 6144;
constexpr int LDS_BYTES = 155648;

#define LDS_WAIT() asm volatile("s_waitcnt lgkmcnt(0)" ::: "memory")
#define VM_WAIT() asm volatile("s_waitcnt vmcnt(0)" ::: "memory")
#define RLX_AGENT __ATOMIC_RELAXED, __HIP_MEMORY_SCOPE_AGENT
DI unsigned pk2(float lo, float hi) { f32x2 v = {lo, hi}; bf16x2_t b = __builtin_convertvector(v, bf16x2_t); return __builtin_bit_cast(unsigned, b); }
DI bf16 f2bf(float f) { return (bf16)(pk2(f, 0.f) & 0xffffu); }
DI float bf2f(unsigned b) { return __uint_as_float(b << 16); }
DI float bflo(unsigned w) { return __uint_as_float(w << 16); }
DI float bfhi(unsigned w) { return __uint_as_float(w & 0xffff0000u); }
DI int opaque_tid() { int t = threadIdx.x; asm volatile("" : "+v"(t)); return t; }
DI int opaque_bid() { int b = blockIdx.x; asm volatile("" : "+s"(b)); return b; }
template <class Tp> DI Tp* opaque_ptr(Tp* p) { asm volatile("" : "+s"(p)); return p; }
template <class Tp> DI const GAS Tp* uni(const GAS Tp* p) { const unsigned long long v = (unsigned long long)p; const unsigned lo = (unsigned)__builtin_amdgcn_readfirstlane((int)(unsigned)v), hi = (unsigned)__builtin_amdgcn_readfirstlane((int)(unsigned)(v >> 32)); return (const GAS Tp*)(((unsigned long long)hi << 32) | lo); }
template <class Tp> DI GAS Tp* uni(GAS Tp* p) { const unsigned long long v = (unsigned long long)p; const unsigned lo = (unsigned)__builtin_amdgcn_readfirstlane((int)(unsigned)v), hi = (unsigned)__builtin_amdgcn_readfirstlane((int)(unsigned)(v >> 32)); return (GAS Tp*)(((unsigned long long)hi << 32) | lo); }
DI unsigned pk_fp8x4(float a, float b, float c, float d) { int p = __builtin_amdgcn_cvt_pk_fp8_f32(fminf(fmaxf(a, -448.f), 448.f), fminf(fmaxf(b, -448.f), 448.f), 0, false); p = __builtin_amdgcn_cvt_pk_fp8_f32(fminf(fmaxf(c, -448.f), 448.f), fminf(fmaxf(d, -448.f), 448.f), p, true); return (unsigned)p; }
DI unsigned pk_i8x4(float a, float b, float c, float d) { const int q0 = (int)rintf(a), q1 = (int)rintf(b), q2 = (int)rintf(c), q3 = (int)rintf(d); return (unsigned)(q0 & 255) | ((unsigned)(q1 & 255) << 8) | ((unsigned)(q2 & 255) << 16) | ((unsigned)q3 << 24); }
constexpr float YS = 127.0f / 8.0f;
DI unsigned pk_fp8x4_nc(float a, float b, float c, float d) { int p = __builtin_amdgcn_cvt_pk_fp8_f32(a, b, 0, false); p = __builtin_amdgcn_cvt_pk_fp8_f32(c, d, p, true); return (unsigned)p; }
template <int CTRL> DI float dpp_f(float v) { return __builtin_bit_cast(float, __builtin_amdgcn_update_dpp(0, __builtin_bit_cast(int, v), CTRL, 0xF, 0xF, true)); }
template <int CTRL> DI int dpp_i(int v) { return __builtin_amdgcn_update_dpp(0, v, CTRL, 0xF, 0xF, true); }
DI float sum_x16(float v) { auto r = __builtin_amdgcn_permlane16_swap(__float_as_uint(v), __float_as_uint(v), false, false); return __uint_as_float(r[0]) + __uint_as_float(r[1]); }
DI float sum_x32(float v) { auto r = __builtin_amdgcn_permlane32_swap(__float_as_uint(v), __float_as_uint(v), false, false); return __uint_as_float(r[0]) + __uint_as_float(r[1]); }
DI float max_x16(float v) { auto r = __builtin_amdgcn_permlane16_swap(__float_as_uint(v), __float_as_uint(v), false, false); return fmaxf(__uint_as_float(r[0]), __uint_as_float(r[1])); }
DI float max_x32(float v) { auto r = __builtin_amdgcn_permlane32_swap(__float_as_uint(v), __float_as_uint(v), false, false); return fmaxf(__uint_as_float(r[0]), __uint_as_float(r[1])); }
DI float sum_x16x32(float v) { return sum_x32(sum_x16(v)); }
DI float max_x16x32(float v) { return max_x32(max_x16(v)); }
DI float sum_row16(float v) { v += dpp_f<0xB1>(v); v += dpp_f<0x4E>(v); v += dpp_f<0x141>(v); v += dpp_f<0x140>(v); return v; }
DI float max_row16(float v) { v = fmaxf(v, dpp_f<0xB1>(v)); v = fmaxf(v, dpp_f<0x4E>(v)); v = fmaxf(v, dpp_f<0x141>(v)); v = fmaxf(v, dpp_f<0x140>(v)); return v; }
DI float sum_oct(float v) { v += dpp_f<0xB1>(v); v += dpp_f<0x4E>(v); v += dpp_f<0x141>(v); return v; }
DI float sum_quad(float v) { v += dpp_f<0xB1>(v); v += dpp_f<0x4E>(v); return v; }
template <int CTRL, int RMASK> DI float dpp_id(float idv, float v) { return __builtin_bit_cast(float, __builtin_amdgcn_update_dpp(__builtin_bit_cast(int, idv), __builtin_bit_cast(int, v), CTRL, RMASK, 0xF, false)); }
DI float scan_sum64(float v) { v += dpp_id<0x111, 0xF>(0.f, v); v += dpp_id<0x112, 0xF>(0.f, v); v += dpp_id<0x114, 0xF>(0.f, v); v += dpp_id<0x118, 0xF>(0.f, v); v += dpp_id<0x142, 0xA>(0.f, v); v += dpp_id<0x143, 0xC>(0.f, v); return v; }
DI float scan_max64(float v) { const float ni = -INFINITY; v = fmaxf(v, dpp_id<0x111, 0xF>(ni, v)); v = fmaxf(v, dpp_id<0x112, 0xF>(ni, v)); v = fmaxf(v, dpp_id<0x114, 0xF>(ni, v)); v = fmaxf(v, dpp_id<0x118, 0xF>(ni, v));
    v = fmaxf(v, dpp_id<0x142, 0xA>(ni, v)); v = fmaxf(v, dpp_id<0x143, 0xC>(ni, v)); return v; }
DI float wave_sum(float v) { return sum_x16x32(sum_row16(v)); }
DI float wave_max(float v) { return max_x16x32(max_row16(v)); }
DI float fast_exp(float x) { return __builtin_amdgcn_exp2f(x * 1.4426950408889634f); }
DI float fast_sigmoid(float x) { return __builtin_amdgcn_rcpf(1.0f + fast_exp(-x)); }
DI float gelu_tanh(float x) { const float u = 0.7978845608028654f * (x + 0.044715f * x * x * x); return x * fast_sigmoid(2.0f * u); }
DI float log_sigmoid(float x) { return fminf(x, 0.f) - __builtin_amdgcn_logf(1.0f + fast_exp(-fabsf(x))) * 0.6931471805599453f; }
DI int mod_row(int row) { return row < NCTX ? 16 : ((row - NCTX) >> 12); }

#define XB_TMO      128
#define XB_XCNT(j)  (256  + 64 * (j))
#define XB_XSUB(j)  (1280 + 64 * (j))
#define XB_XGEN(j)  (2304 + 64 * (j))
#define XB_TOP      3328
#define XB_TOPGEN   3392
#define XCD_BAR_WORDS 3456
#define XB_SPIN_CAP (1u << 22)
DI unsigned xb_ld(unsigned* p)              { return __hip_atomic_load(p, __ATOMIC_RELAXED, __HIP_MEMORY_SCOPE_AGENT); }
DI unsigned xb_add(unsigned* p, unsigned v) { return __hip_atomic_fetch_add(p, v, __ATOMIC_RELAXED, __HIP_MEMORY_SCOPE_AGENT); }
DI unsigned xb_xcc_id() { return (unsigned)__builtin_amdgcn_s_getreg((3 << 11) | 20) & 0xFu; }
#define XB_SPIN(cond, bar) do { unsigned _sp = 0; while (cond) { __builtin_amdgcn_s_sleep(1); \
    if ((++_sp & 255u) == 0u) { if (xb_ld(&(bar)[XB_TMO])) break; if (_sp > XB_SPIN_CAP) { atomicAdd(&(bar)[XB_TMO], 1u); break; } } } } while (0)
struct XcdBarrier { unsigned* bar; unsigned x; volatile LAS unsigned* st; };
DI XcdBarrier xcd_barrier_post(unsigned* bar, volatile LAS unsigned* st) {
    XcdBarrier b; b.bar = bar; b.x = xb_xcc_id(); b.st = st;
    if (threadIdx.x == 0) (void)xb_add(&bar[XB_XCNT(b.x)], 1u);
    return b;
}
DI void xcd_barrier_complete(unsigned* bar, unsigned x, unsigned& nloc, unsigned& nx) {
    const unsigned G = gridDim.x * gridDim.y * gridDim.z;
    unsigned sum, cnt, mine, sp = 0u;
    for (;;) {
        sum = 0u; cnt = 0u; mine = 0u;
#pragma unroll
        for (unsigned j = 0; j < 16; ++j) { const unsigned c = xb_ld(&bar[XB_XCNT(j)]); sum += c; cnt += (c > 0u) ? 1u : 0u; mine = (j == x) ? c : mine; }
        if (sum == G) break;
        __builtin_amdgcn_s_sleep(1);
        if ((++sp & 255u) == 0u) { if (xb_ld(&bar[XB_TMO])) break; if (sp > XB_SPIN_CAP) { atomicAdd(&bar[XB_TMO], 1u); break; } }
    }
    nloc = mine > 0u ? mine : 1u; nx = cnt > 0u ? cnt : 1u;
}
DI void xcd_barrier(const XcdBarrier& b) {
    asm volatile("s_waitcnt vmcnt(0)" ::: "memory");
    __syncthreads();
    if (threadIdx.x == 0) {
        unsigned* bar = b.bar;
        __builtin_amdgcn_s_waitcnt(0);
        unsigned nloc = b.st[0], nx = b.st[1];
        if (nloc == 0u) { xcd_barrier_complete(bar, b.x, nloc, nx); b.st[0] = nloc; b.st[1] = nx; }
        const unsigned old = xb_add(&bar[XB_XSUB(b.x)], 1u);
        const unsigned gen = old / nloc;
        if (old + 1u == (gen + 1u) * nloc) {
            __builtin_amdgcn_fence(__ATOMIC_RELEASE, "agent");
            asm volatile("s_waitcnt vmcnt(0)" ::: "memory");
            const unsigned og = xb_add(&bar[XB_TOP], 1u);
            const unsigned tg = og / nx;
            if (og + 1u == (tg + 1u) * nx) xb_add(&bar[XB_TOPGEN], 1u);
            else XB_SPIN(xb_ld(&bar[XB_TOPGEN]) == tg, bar);
            __builtin_amdgcn_fence(__ATOMIC_ACQUIRE, "agent");
            xb_add(&bar[XB_XGEN(b.x)], 1u);
            asm volatile("s_waitcnt vmcnt(0)" ::: "memory");
        } else {
            XB_SPIN(xb_ld(&bar[XB_XGEN(b.x)]) == gen, bar);
            __builtin_amdgcn_fence(__ATOMIC_ACQUIRE, "agent");
            asm volatile("s_waitcnt vmcnt(0)" ::: "memory");
        }
    }
    __syncthreads();
}

namespace pg8 {
constexpr int BM = 256, BK = 64, HALF = 128, HTB = HALF * BK * 2, STAGE_BYTES = 8 * HTB, NXCD = 8, WGM = 8;
DI int lds_byte(int r, int c) { const int st = (r >> 4) * 2 + (c >> 5), rr = r & 15, cc = c & 31, ob = rr * 64 + cc * 2; return st * 1024 + (ob ^ (((ob >> 9) & 1) << 5)); }
DI void stage_rc(int b, int& R, int& C) { const int st = b / 1024, sb = b % 1024, swz = sb ^ (((sb >> 9) & 1) << 5); R = (st >> 1) * 16 + swz / 64; C = (st & 1) * 32 + (swz % 64) / 2; }
struct Unit { int pm, pn, e; };
DI void glds_s(const char* sbase_, unsigned voff, unsigned lds_dst) { unsigned keep; const unsigned long long sbase = (unsigned long long)sbase_;
    asm volatile("s_mov_b32 %0, m0\n\ts_mov_b32 m0, %3\n\ts_nop 0\n\tglobal_load_lds_dwordx4 %1, %2\n\ts_mov_b32 m0, %0" : "=&s"(keep) : "v"(voff), "s"(sbase), "s"(lds_dst) : "memory"); }
struct TileOrder {
    int nM, nN, nwg, G, c, pm0;
    DI void init(int nM_, int nN_, int G_, int c_, int pm0_ = 0) { nM = nM_; nN = nN_; nwg = nM * nN; G = G_; c = c_; pm0 = pm0_; }
    DI bool next(int i, Unit& u) const {
        const long L = (long)i * G + c; if (L >= nwg) return false;
        int wgid = (int)L; { const int q = nwg / NXCD, r = nwg % NXCD, xcd = wgid % NXCD, off = wgid / NXCD; wgid = (xcd < r ? xcd * (q + 1) : r * (q + 1) + (xcd - r) * q) + off; }
        const int nig = WGM * nN, gid = wgid / nig, fm = gid * WGM, gsz = (nM - fm) < WGM ? (nM - fm) : WGM;
        u.pm = pm0 + fm + ((wgid % nig) % gsz); u.pn = (wgid % nig) / gsz; return true;
    }
};
typedef int i32x8 __attribute__((ext_vector_type(8)));
DI f32x4 mma1(bf16x8 a, bf16x8 b, f32x4 c) { return __builtin_amdgcn_mfma_f32_16x16x32_bf16(a, b, c, 0, 0, 0); }
DI i32x4 mma1(bf16x8 a, bf16x8 b, i32x4 c) { return __builtin_amdgcn_mfma_i32_16x16x64_i8(__builtin_bit_cast(i32x4, a), __builtin_bit_cast(i32x4, b), c, 0, 0, 0); }
DI i32x8 cat8(bf16x8 a0, bf16x8 a1) { const i32x4 x0 = __builtin_bit_cast(i32x4, a0), x1 = __builtin_bit_cast(i32x4, a1); return __builtin_shufflevector(x0, x1, 0, 1, 2, 3, 4, 5, 6, 7); }
DI f32x4 mma_f8(i32x8 a, i32x8 b, f32x4 c) { asm volatile("v_mfma_f32_16x16x128_f8f6f4 %0, %1, %2, %0" : "+v"(c) : "v"(a), "v"(b)); return c; }
template <int QM> struct AccT { typedef f32x4 type; };
template <> struct AccT<1> { typedef i32x4 type; };
template <class Epi, class Src, bool DUP = false, int QM = 0>
DI void gemm_phase(LAS unsigned char* lds, const bf16* Abase, const TileOrder& S, const Src& src, const Epi& E) {
    const int tid = opaque_tid(), wid = __builtin_amdgcn_readfirstlane(tid >> 6), lane = tid & 63, wr = wid >> 2, wc = wid & 3, fr = lane & 15, fq = lane >> 4;
    unsigned voffB[2];
    constexpr unsigned RPB = QM ? 1024u : 2048u;
    constexpr int NT = QM ? 8 : 16;
    typedef typename AccT<QM>::type acc_t;
#pragma unroll
    for (int i = 0; i < 2; ++i) { int R_, C_; stage_rc(tid * 16 + i * 8192, R_, C_); voffB[i] = (unsigned)R_ * RPB + (unsigned)C_ * 2u; }
    constexpr size_t kstep = (size_t)(BK * 2), hstep = (size_t)HALF * RPB;
    const unsigned ldsb = (unsigned)(uintptr_t)lds + (unsigned)wid * 1024u;
    const int aoff = lds_byte(wr * 64 + fr, fq * 8), boff = lds_byte(wc * 32 + fr, fq * 8);
    const LAS unsigned char* ldsA = lds + aoff; const LAS unsigned char* ldsB = lds + 4 * HTB + boff;
    asm volatile("" : "+v"(ldsA), "+v"(ldsB));
#define PG8_SA(b, h) (((b) * 2 + (h)) * HTB)
#define PG8_SB(b, h) ((4 + (b) * 2 + (h)) * HTB)
#define PG8_SBR(b, h) (((b) * 2 + (h)) * HTB)
#define PG8_STAGEB(bufoff, gbase) do { _Pragma("unroll") for (int _i = 0; _i < 2; ++_i) \
        glds_s((const char*)(gbase), voffB[_i], ldsb + (unsigned)((bufoff) + _i * 8192)); } while (0)
#define PG8_STAGEA(bufoff, arr, hf, koff) do { _Pragma("unroll") for (int _i = 0; _i < 2; ++_i) \
        glds_s((const char*)Abase + (koff) + (Src::GATHER ? (size_t)0 : (size_t)(hf) * hstep), (arr)[Src::GATHER ? (hf) : 0][_i], ldsb + (unsigned)((bufoff) + _i * 8192)); } while (0)
#define PG8_LDA(dst, b, h) do { _Pragma("unroll") for (int m = 0; m < 4; ++m) { if constexpr (QM == 2) dst##8[m] = cat8(*(const LAS bf16x8*)(ldsA + PG8_SA(b, h) + m * 2048), *(const LAS bf16x8*)(ldsA + PG8_SA(b, h) + m * 2048 + 1024)); \
        else { _Pragma("unroll") for (int k = 0; k < 2; ++k) dst[m][k] = *(const LAS bf16x8*)(ldsA + PG8_SA(b, h) + m * 2048 + k * 1024); } } } while (0)
#define PG8_LDB(dst, b, h) do { _Pragma("unroll") for (int n = 0; n < 2; ++n) { if constexpr (QM == 2) dst##8[n] = cat8(*(const LAS bf16x8*)(ldsB + PG8_SBR(b, h) + n * 2048), *(const LAS bf16x8*)(ldsB + PG8_SBR(b, h) + n * 2048 + 1024)); \
        else { _Pragma("unroll") for (int k = 0; k < 2; ++k) dst[n][k] = *(const LAS bf16x8*)(ldsB + PG8_SBR(b, h) + n * 2048 + k * 1024); } } } while (0)
#define PG8_MMA(ai, bj, At, Bt) do { __builtin_amdgcn_s_setprio(1); _Pragma("unroll") for (int m = 0; m < 4; ++m) _Pragma("unroll") for (int n = 0; n < 2; ++n) { \
        if constexpr (QM == 2) acc[ai][bj][m][n] = mma_f8(Bt##8[n], At##8[m], acc[ai][bj][m][n]); \
        else { _Pragma("unroll") for (int k = 0; k < 2; ++k) acc[ai][bj][m][n] = mma1(Bt[n][k], At[m][k], acc[ai][bj][m][n]); } } __builtin_amdgcn_s_setprio(0); } while (0)
#define PG8_WAIT_V(n) asm volatile("s_waitcnt vmcnt(" #n ")" ::: "memory")
#define PG8_WAIT_L(n) asm volatile("s_waitcnt lgkmcnt(" #n ")" ::: "memory")
#define PG8_BAR __builtin_amdgcn_s_barrier()
#define PG8_SCHED __builtin_amdgcn_sched_barrier(0)
#define PG8_OFFS(dst, u) do { _Pragma("unroll") for (int _i = 0; _i < 2; ++_i) { int R_, C_; stage_rc(tid * 16 + _i * 8192, R_, C_); _Pragma("unroll") for (int _h = 0; _h < NH; ++_h) \
        dst[_h][_i] = (unsigned)src.arow(u, _h * HALF + R_) * RPB + (unsigned)C_ * 2u; } } while (0)
    Unit cur, nxt; int ui = 0;
    if (!S.next(0, cur)) return;
    LAS unsigned char* xtab = lds + STAGE_BYTES;
    const unsigned xtabb = (unsigned)(uintptr_t)lds + (unsigned)STAGE_BYTES;
#define PG8_IDXDMA(u, buf) do { if (wid == 0) glds_s(src.idx_base(), (unsigned)((u).pm * 1024 + lane * 16), xtabb + (unsigned)(buf) * 1024u); } while (0)
#define PG8_OFFS_LDS(dst, buf) do { _Pragma("unroll") for (int _i = 0; _i < 2; ++_i) { int R_, C_; stage_rc(tid * 16 + _i * 8192, R_, C_); _Pragma("unroll") for (int _h = 0; _h < 2; ++_h) \
        dst[_h][_i] = (unsigned)(*(const LAS int*)(xtab + (buf) * 1024 + (_h * HALF + R_) * 4)) * RPB + (unsigned)C_ * 2u; } } while (0)
#define PG8_EXPERT(u) (Src::EXPERT ? __builtin_amdgcn_readfirstlane((int)*(const LAS unsigned char*)(xtab + 2048 + (u).pm)) : 0)
    if constexpr (Src::EXPERT) {
        if (wid < 2) glds_s(src.rteb_base(), (unsigned)(wid * 1024 + lane * 16), xtabb + 2048u + (unsigned)wid * 1024u);
        if constexpr (Src::GATHER) { PG8_IDXDMA(cur, 0); Unit u1_; if (S.next(1, u1_)) PG8_IDXDMA(u1_, 1); }
        asm volatile("s_waitcnt vmcnt(0)" ::: "memory"); __builtin_amdgcn_s_barrier(); asm volatile("" ::: "memory");
    }
    cur.e = PG8_EXPERT(cur);
    const LAS unsigned char* etab = lds + LDSCTL_OFF + 4096; const unsigned etabb = (unsigned)(uintptr_t)lds + (unsigned)(LDSCTL_OFF + 4096);
#define PG8_ETAB(u, par) do { if constexpr (Epi::NTAB > 0) { if (wid >= 1 && wid <= Epi::NTAB) glds_s(E.tab(wid - 1, u), (unsigned)(lane * 16), etabb + (unsigned)(par) * 3072u + (unsigned)(wid - 1) * 1024u); } } while (0)
    acc_t acc[2][2][4][2];
#pragma unroll
    for (int a = 0; a < 2; ++a)
#pragma unroll
        for (int b = 0; b < 2; ++b)
#pragma unroll
            for (int m = 0; m < 4; ++m)
#pragma unroll
                for (int n = 0; n < 2; ++n) acc[a][b][m][n] = (acc_t){0, 0, 0, 0};
    bf16x8 At[4][2], B0[2][2], B1[2][2]; i32x8 At8[4], B08[2], B18[2];
    constexpr int NH = Src::GATHER ? 2 : 1;
    unsigned oA[NH][2], nO[NH][2];
    if constexpr (Src::GATHER) { PG8_OFFS_LDS(oA, 0); } else { PG8_OFFS(oA, cur); }
    const char* cB = src.bt(cur);
#define PG8_KOF(r, t) ((size_t)((((t) + (r)) & (NT - 1))) * kstep)
    int rc = (cur.pm + cur.pn) & (NT - 1), rn = rc;
    PG8_STAGEB(PG8_SB(0, 0), cB + PG8_KOF(rc, 0)); PG8_STAGEB(PG8_SB(0, 1), cB + hstep + PG8_KOF(rc, 0)); PG8_STAGEA(PG8_SA(0, 0), oA, 0, PG8_KOF(rc, 0)); PG8_STAGEA(PG8_SA(0, 1), oA, 1, PG8_KOF(rc, 0));
    if (wr == 1) PG8_BAR;
    PG8_WAIT_V(2); PG8_BAR;
    PG8_STAGEB(PG8_SB(1, 0), cB + PG8_KOF(rc, 1)); PG8_STAGEA(PG8_SA(1, 0), oA, 0, PG8_KOF(rc, 1)); PG8_STAGEB(PG8_SB(1, 1), cB + hstep + PG8_KOF(rc, 1));
    PG8_WAIT_V(6); PG8_BAR;
    for (;;) {
        const bool has_next = S.next(DUP ? ((ui + 1) >> 1) : (ui + 1), nxt);
        const char* nB = cB; rn = has_next ? ((nxt.pm + nxt.pn) & (NT - 1)) : rc;
        if (has_next) { nxt.e = PG8_EXPERT(nxt); if constexpr (Src::GATHER) { PG8_OFFS_LDS(nO, (ui + 1) & 1); } else { PG8_OFFS(nO, nxt); } nB = src.bt(nxt); }
        else {
#pragma unroll
            for (int h = 0; h < NH; ++h)
#pragma unroll
                for (int i = 0; i < 2; ++i) nO[h][i] = oA[h][i];
        }
        if constexpr (Src::GATHER) { Unit u2_; if (S.next(ui + 2, u2_)) PG8_IDXDMA(u2_, ui & 1); }
        PG8_ETAB(cur, ui & 1);
#pragma unroll 1
        for (int t = 0; t < NT; t += 2) {
            const bool last = (t == NT - 2);
            const size_t k1 = PG8_KOF(rc, t + 1), k2 = last ? PG8_KOF(rn, 0) : PG8_KOF(rc, t + 2), k3 = last ? PG8_KOF(rn, 1) : PG8_KOF(rc, t + 3);
            unsigned sx[NH][2];
#pragma unroll
            for (int h = 0; h < NH; ++h)
#pragma unroll
                for (int i = 0; i < 2; ++i) sx[h][i] = last ? nO[h][i] : oA[h][i];
            const char* b2 = (last ? nB : cB) + k2; const char* b3 = (last ? nB : cB) + k3;
            PG8_LDB(B0, 0, 0); PG8_LDB(B1, 0, 1); PG8_SCHED; PG8_LDA(At, 0, 0); PG8_STAGEA(PG8_SA(1, 1), oA, 1, k1);
            PG8_WAIT_V(8); PG8_WAIT_L(0); PG8_BAR; PG8_MMA(0, 0, At, B0); PG8_MMA(0, 1, At, B1); PG8_BAR; PG8_SCHED;
            PG8_LDA(At, 0, 1); PG8_STAGEB(PG8_SB(0, 0), b2); PG8_STAGEB(PG8_SB(0, 1), b2 + hstep); PG8_STAGEA(PG8_SA(0, 0), sx, 0, k2);
            PG8_WAIT_V(8); PG8_WAIT_L(0); PG8_BAR; PG8_MMA(1, 0, At, B0); PG8_MMA(1, 1, At, B1); PG8_BAR; PG8_SCHED;
            PG8_LDB(B0, 1, 0); PG8_LDB(B1, 1, 1); PG8_SCHED; PG8_LDA(At, 1, 0); PG8_STAGEA(PG8_SA(0, 1), sx, 1, k2);
            PG8_WAIT_V(8); PG8_WAIT_L(0); PG8_BAR; PG8_MMA(0, 0, At, B0); PG8_MMA(0, 1, At, B1); PG8_BAR; PG8_SCHED;
            PG8_LDA(At, 1, 1); PG8_STAGEB(PG8_SB(1, 0), b3); PG8_STAGEB(PG8_SB(1, 1), b3 + hstep); PG8_STAGEA(PG8_SA(1, 0), sx, 0, k3);
            PG8_WAIT_V(8); PG8_WAIT_L(0); PG8_BAR; PG8_MMA(1, 0, At, B0); PG8_MMA(1, 1, At, B1); PG8_BAR; PG8_SCHED;
        }
        if (wr == 0) PG8_BAR;
        if constexpr (QM == 2) asm volatile("s_nop 15\n\ts_nop 15" ::: "memory");
        if (!DUP || (ui & 1)) {
            if (DUP) {
#pragma unroll
                for (int a = 0; a < 2; ++a)
#pragma unroll
                    for (int b = 0; b < 2; ++b)
#pragma unroll
                        for (int m = 0; m < 4; ++m)
#pragma unroll
                            for (int n = 0; n < 2; ++n) acc[a][b][m][n] = acc[a][b][m][n] / 2;
            }
            E(acc, cur, wr, wc, fr, fq, etab + (ui & 1) * 3072);
        }
        if (!has_next) break;
        if (!DUP || (ui & 1)) {
#pragma unroll
        for (int a = 0; a < 2; ++a)
#pragma unroll
            for (int b = 0; b < 2; ++b)
#pragma unroll
                for (int m = 0; m < 4; ++m)
#pragma unroll
                    for (int n = 0; n < 2; ++n) acc[a][b][m][n] = (acc_t){0, 0, 0, 0};
        }
        cur = nxt; cB = nB; rc = rn; ++ui;
#pragma unroll
        for (int h = 0; h < NH; ++h)
#pragma unroll
            for (int i = 0; i < 2; ++i) oA[h][i] = nO[h][i];
        if (wr == 1) PG8_BAR;
    }
    PG8_WAIT_V(0);
    PG8_BAR;
#undef PG8_SA
#undef PG8_SB
#undef PG8_KOF
#undef PG8_SBR
#undef PG8_STAGEA
#undef PG8_STAGEB
#undef PG8_LDA
#undef PG8_LDB
#undef PG8_MMA
#undef PG8_WAIT_V
#undef PG8_WAIT_L
#undef PG8_BAR
#undef PG8_SCHED
#undef PG8_OFFS
#undef PG8_IDXDMA
#undef PG8_ETAB
#undef PG8_OFFS_LDS
#undef PG8_EXPERT
}
}

struct In { const float *x, *c, *ctx, *c_ctx, *w_ada, *b_ada, *w_in, *b_in, *q_norm, *k_norm, *gmlp_norm, *gmlp_ws, *gmlp_b, *mix_norm, *w_out, *router_w, *router_b, *w_gate_up, *b_gate_up, *w_down, *b_down, *final_norm; };
struct Args { In in; float* out; unsigned char* ws; int ph_lo, ph_hi; };
typedef const __attribute__((address_space(4))) Args* KArgP;
DI KArgP kargs() { KArgP p = (KArgP)__builtin_amdgcn_kernarg_segment_ptr(); asm volatile("" : "+s"(p)); return p; }

constexpr size_t TSTEP = (size_t)256 * D * 2;
template <size_t TS> struct SrcPlainT { static constexpr bool GATHER = false, EXPERT = false; const char* Bt;
    DI const char* idx_base() const { return nullptr; } DI const char* rteb_base() const { return nullptr; }
    DI int arow(const pg8::Unit& u, int r) const { return u.pm * 256 + r; }
    DI int expert(const pg8::Unit&) const { return 0; }
    DI const char* bt(const pg8::Unit& u) const { return Bt + (size_t)u.pn * TS; } };
typedef SrcPlainT<TSTEP> SrcPlain; typedef SrcPlainT<TSTEP / 2> SrcPlain8;
struct SrcMoeGather { static constexpr bool GATHER = true, EXPERT = true; unsigned char* ws; int l;
    DI const char* idx_base() const { return (const char*)(ws + WS_SLTOK); } DI const char* rteb_base() const { return (const char*)(ws + WS_RTEB); }
    DI int arow(const pg8::Unit& u, int r) const { return ((const int*)(ws + WS_SLTOK))[u.pm * 256 + r]; }
    DI int expert(const pg8::Unit& u) const { return __builtin_amdgcn_readfirstlane(((const int*)(ws + WS_RTE))[32 + u.pm]); }
    DI const char* bt(const pg8::Unit& u) const { return (const char*)(ws + WS_WGU) + ((size_t)(l * NE + u.e) * 8 + (size_t)u.pn) * (TSTEP / 2); } };
struct SrcMoePlain { static constexpr bool GATHER = false, EXPERT = true; unsigned char* ws; int l;
    DI const char* idx_base() const { return nullptr; } DI const char* rteb_base() const { return (const char*)(ws + WS_RTEB); }
    DI int arow(const pg8::Unit& u, int r) const { return u.pm * 256 + r; }
    DI int expert(const pg8::Unit& u) const { return __builtin_amdgcn_readfirstlane(((const int*)(ws + WS_RTE))[32 + u.pm]); }
    DI const char* bt(const pg8::Unit& u) const { return (const char*)(ws + WS_WDN) + ((size_t)(l * NE + u.e) * 4 + (size_t)u.pn) * (TSTEP / 2); } };

struct EpiInProj {
    unsigned char* ws; int l; const LAS float* rl;
    static constexpr int NTAB = 3;
    DI const char* tab(int k, const pg8::Unit& u) const {
        const char* t0 = (const char*)(kargs()->in.b_in + (size_t)l * DIN + (size_t)u.pn * 256 + (u.pn >= 4 ? 16 : 0));
        const char* t1 = (const char*)((const float*)(ws + WS_CSIN) + (size_t)l * NPROJ + (size_t)u.pn * 256);
        const char* t2 = (const char*)((const float*)(ws + WS_HS) + (size_t)u.pm * 256);
        return k == 0 ? t0 : (k == 1 ? t1 : t2); }
    DI void operator()(const i32x4 (&acc)[2][2][4][2], const pg8::Unit& u, int wr, int wc, int fr, int fq, const LAS unsigned char* et) const {
        const KArgP ka = kargs();
        const LAS float* bias = (const LAS float*)et;
        const LAS float* csp = (const LAS float*)(et + 1024) + 32 * wc + 4 * fq;
        const LAS float* hs = (const LAS float*)(et + 2048);
        f32x4 cs[2][2];
#pragma unroll
        for (int bj = 0; bj < 2; ++bj)
#pragma unroll
            for (int n = 0; n < 2; ++n) cs[bj][n] = *(const LAS f32x4*)(csp + 128 * bj + 16 * n);
        const int hh = u.pn * 4 + wc;
        const int lcol0 = hh * 64 + 8 * fq, ocol0 = lcol0 + (lcol0 >= 1024 ? 16 : 0);
        f32x4 bv[2][2];
#pragma unroll
        for (int bj = 0; bj < 2; ++bj)
#pragma unroll
            for (int n = 0; n < 2; ++n) bv[bj][n] = *(const LAS f32x4*)(bias + 64 * wc + 8 * fq + 32 * bj + 4 * n);
        const bool latent = u.pm >= 16;
        int op; bf16* base; int pitch, colb; bool kv = false;
        if (hh < 24) { const int ty = hh >> 2; op = (ty == 1) ? 1 : (ty == 3) ? 2 : (ty >= 4) ? 3 : 0;
            base = (bf16*)(ws + ((ty == 0) ? WS_MQ : (ty == 1) ? WS_MK : (ty == 2) ? WS_MV : (ty == 3) ? WS_MO : (ty == 4) ? WS_GU : WS_GV)); pitch = 256; colb = (hh & 3) * 64; }
        else if (hh < 32) { op = 4; base = (bf16*)(ws + WS_AQ); pitch = 512; colb = (hh - 24) * 64; }
        else { op = (hh < 34) ? 5 : 0; base = (bf16*)(ws + ((hh < 34) ? WS_AK : WS_AV)); pitch = 64; colb = 0; kv = true; }
        const int kvh = hh & 1;
        float rscs[2][4];
#pragma unroll
        for (int ai = 0; ai < 2; ++ai)
#pragma unroll
            for (int m = 0; m < 4; ++m) rscs[ai][m] = hs[ai * 128 + wr * 64 + m * 16 + fr];
        f32x4 xf[2][2][4][2];
#pragma unroll
        for (int ai = 0; ai < 2; ++ai)
#pragma unroll
            for (int m = 0; m < 4; ++m)
#pragma unroll
                for (int bj = 0; bj < 2; ++bj)
#pragma unroll
                    for (int n = 0; n < 2; ++n)
#pragma unroll
                        for (int j = 0; j < 4; ++j) xf[ai][bj][m][n][j] = (float)acc[ai][bj][m][n][j] * (rscs[ai][m] * cs[bj][n][j]) + bv[bj][n][j];
        asm volatile("" ::: "memory");
        f32x4 gn[2][2];
        if (op >= 4) { const LAS float* g = rl + 2080 + ((op == 4) ? 0 : 64);
#pragma unroll
            for (int bj = 0; bj < 2; ++bj)
#pragma unroll
                for (int n = 0; n < 2; ++n) gn[bj][n] = *(const LAS f32x4*)(g + 32 * bj + 8 * fq + 4 * n); }
#pragma unroll
        for (int ai = 0; ai < 2; ++ai)
#pragma unroll
            for (int m = 0; m < 4; ++m) {
                const int row = u.pm * 256 + ai * 128 + wr * 64 + m * 16 + fr;
                f32x4 v[2][2];
#pragma unroll
                for (int bj = 0; bj < 2; ++bj)
#pragma unroll
                    for (int n = 0; n < 2; ++n) v[bj][n] = xf[ai][bj][m][n];
                if (op == 1) {
#pragma unroll
                    for (int bj = 0; bj < 2; ++bj)
#pragma unroll
                        for (int n = 0; n < 2; ++n) v[bj][n] = v[bj][n] * 0.125f;
                } else if (op == 2) {
#pragma unroll
                    for (int bj = 0; bj < 2; ++bj)
#pragma unroll
                        for (int n = 0; n < 2; ++n)
#pragma unroll
                            for (int j = 0; j < 4; ++j) v[bj][n][j] = fast_sigmoid(v[bj][n][j]);
                } else if (op == 3) {
#pragma unroll
                    for (int bj = 0; bj < 2; ++bj)
#pragma unroll
                        for (int n = 0; n < 2; ++n)
#pragma unroll
                            for (int j = 0; j < 4; ++j) v[bj][n][j] = gelu_tanh(v[bj][n][j]);
                } else if (op >= 4) {
                    float ss = 0.f;
#pragma unroll
                    for (int bj = 0; bj < 2; ++bj)
#pragma unroll
                        for (int n = 0; n < 2; ++n) ss += (v[bj][n][0] * v[bj][n][0] + v[bj][n][1] * v[bj][n][1]) + (v[bj][n][2] * v[bj][n][2] + v[bj][n][3] * v[bj][n][3]);
                    ss = sum_x16x32(ss);
                    const float rs = __builtin_amdgcn_rsqf(ss * (1.0f / 64.0f) + EPS);
#pragma unroll
                    for (int bj = 0; bj < 2; ++bj)
#pragma unroll
                        for (int n = 0; n < 2; ++n) v[bj][n] = v[bj][n] * rs * gn[bj][n];
                    { const int t = (row - NCTX) & (T - 1); const int pos = latent ? ((fq < 2) ? (t >> 6) : (t & 63)) : 64;
                        const LAS float* rp = rl + pos * 16 + 8 * (fq & 1);
#pragma unroll
                        for (int n = 0; n < 2; ++n) { const f32x4 c = *(const LAS f32x4*)(rp + 4 * n), s = *(const LAS f32x4*)(rp + 1040 + 4 * n);
                            const f32x4 x1 = v[0][n], x2 = v[1][n]; v[0][n] = x1 * c - x2 * s; v[1][n] = x2 * c + x1 * s; } }
                    if (op == 4) {
#pragma unroll
                        for (int bj = 0; bj < 2; ++bj)
#pragma unroll
                            for (int n = 0; n < 2; ++n) v[bj][n] = v[bj][n] * C2; }
                }
                size_t drow;
                if (kv) { int b, p; if (latent) { const int r2 = row - NCTX; b = r2 >> 12; p = TC + (r2 & (T - 1)); } else { b = row >> 8; p = row & 255; }
                    drow = (size_t)((b * 2 + kvh) * TKV + p); }
                else drow = (size_t)row;
                if (op >= 4) {
                    unsigned char* dp8 = (unsigned char*)base + drow * pitch + colb + 8 * fq;
#pragma unroll
                    for (int bj = 0; bj < 2; ++bj) { u32x2 w; w.x = pk_fp8x4(v[bj][0][0], v[bj][0][1], v[bj][0][2], v[bj][0][3]); w.y = pk_fp8x4(v[bj][1][0], v[bj][1][1], v[bj][1][2], v[bj][1][3]);
                        *(u32x2*)(dp8 + 32 * bj) = w; }
                } else {
                bf16* dp = base + drow * pitch + colb + 8 * fq;
#pragma unroll
                for (int bj = 0; bj < 2; ++bj) { u32x4 w; w.x = pk2(v[bj][0][0], v[bj][0][1]); w.y = pk2(v[bj][0][2], v[bj][0][3]); w.z = pk2(v[bj][1][0], v[bj][1][1]); w.w = pk2(v[bj][1][2], v[bj][1][3]);
                    *(u32x4*)(dp + 32 * bj) = w; }
                }
                asm volatile("" ::: "memory");
            }
    }
};
struct EpiOutProj {
    unsigned char* ws; int l;
    static constexpr int NTAB = 2;
    DI const char* tab(int k, const pg8::Unit& u) const { const int mrow = u.pm < 16 ? 16 : ((u.pm - 16) >> 4);
        const char* t0 = (const char*)((const float*)(ws + WS_MOD) + (size_t)l * 17 * 6144 + (size_t)mrow * 6 * D + 2 * D + (size_t)u.pn * 256);
        const char* t1 = (const char*)((const float*)(ws + WS_CSOUT) + (size_t)l * D + (size_t)u.pn * 256);
        return k == 0 ? t0 : t1; }
    DI void operator()(const i32x4 (&acc)[2][2][4][2], const pg8::Unit& u, int wr, int wc, int fr, int fq, const LAS unsigned char* et) const {
        GAS signed char* dout = (GAS signed char*)(ws + WS_H); GAS float* dsc = (GAS float*)(ws + WS_DSC);
        const int c0 = u.pn * 256 + 64 * wc + 8 * fq;
        const LAS float* g1 = (const LAS float*)et + 64 * wc + 8 * fq;
        f32x4 gv[2][2];
#pragma unroll
        for (int bj = 0; bj < 2; ++bj)
#pragma unroll
            for (int n = 0; n < 2; ++n) gv[bj][n] = *(const LAS f32x4*)(g1 + 32 * bj + 4 * n) * *(const LAS f32x4*)((const LAS float*)(et + 1024) + 32 * wc + 4 * fq + 128 * bj + 16 * n) * (1.0f / YS);
#pragma unroll
        for (int ai = 0; ai < 2; ++ai)
#pragma unroll
            for (int m = 0; m < 4; ++m) { const size_t row = (size_t)(u.pm * 256 + ai * 128 + wr * 64 + m * 16 + fr);
                f32x4 v[2][2]; float am = 0.f;
#pragma unroll
                for (int bj = 0; bj < 2; ++bj)
#pragma unroll
                    for (int n = 0; n < 2; ++n) { v[bj][n] = gv[bj][n] * (f32x4){(float)acc[ai][bj][m][n][0], (float)acc[ai][bj][m][n][1], (float)acc[ai][bj][m][n][2], (float)acc[ai][bj][m][n][3]};
                        am = fmaxf(am, fmaxf(fmaxf(fabsf(v[bj][n][0]), fabsf(v[bj][n][1])), fmaxf(fabsf(v[bj][n][2]), fabsf(v[bj][n][3])))); }
                am = max_x16x32(am);
                const float qs = 127.0f / fmaxf(am, 1e-30f);
#pragma unroll
                for (int bj = 0; bj < 2; ++bj) { u32x2 w;
#pragma unroll
                    for (int n = 0; n < 2; ++n) { const int q0 = (int)rintf(v[bj][n][0] * qs), q1 = (int)rintf(v[bj][n][1] * qs), q2 = (int)rintf(v[bj][n][2] * qs), q3 = (int)rintf(v[bj][n][3] * qs);
                        w[n] = (unsigned)(q0 & 255) | ((unsigned)(q1 & 255) << 8) | ((unsigned)(q2 & 255) << 16) | ((unsigned)(q3 & 255) << 24); }
                    *(GAS u32x2*)(dout + row * D + c0 + 32 * bj) = w; }
                if (fq == 0) dsc[row * 16 + u.pn * 4 + wc] = am * (1.0f / 127.0f); }
    }
};
struct EpiGateUp {
    unsigned char* ws; int l;
    static constexpr int NTAB = 3;
    DI const char* tab(int k, const pg8::Unit& u) const {
        const char* t0 = (const char*)(kargs()->in.b_gate_up + ((size_t)(l * NE + u.e) * 2 * DFF + (size_t)u.pn * 256));
        const char* t1 = (const char*)((const float*)(ws + WS_CSGU) + ((size_t)(l * NE + u.e) * 2 * DFF + (size_t)u.pn * 256));
        const char* t2 = (const char*)((const float*)(ws + WS_SLS) + (size_t)u.pm * 256);
        return k == 0 ? t0 : (k == 1 ? t1 : t2); }
    DI void operator()(const i32x4 (&acc)[2][2][4][2], const pg8::Unit& u, int wr, int wc, int fr, int fq, const LAS unsigned char* et) const {
        GAS unsigned char* act = (GAS unsigned char*)(ws + WS_ACT);
        const int f0 = u.pn * 128 + 32 * wc + 8 * fq;
        const LAS float* bp = (const LAS float*)et + 2 * (32 * wc + 8 * fq);
        const LAS float* csp = (const LAS float*)(et + 1024) + 32 * wc + 4 * fq;
        const LAS float* sls = (const LAS float*)(et + 2048);
        f32x4 bb[2][2], cs[2][2];
#pragma unroll
        for (int bj = 0; bj < 2; ++bj) { bb[bj][0] = *(const LAS f32x4*)(bp + 8 * bj); bb[bj][1] = *(const LAS f32x4*)(bp + 8 * bj + 4);
            cs[bj][0] = *(const LAS f32x4*)(csp + 128 * bj); cs[bj][1] = *(const LAS f32x4*)(csp + 128 * bj + 16); }
        float rss[2][4];
#pragma unroll
        for (int ai = 0; ai < 2; ++ai)
#pragma unroll
            for (int m = 0; m < 4; ++m) rss[ai][m] = sls[ai * 128 + wr * 64 + m * 16 + fr];
        constexpr float KE = -1.702f * 1.4426950408889634f;
#pragma unroll
        for (int ai = 0; ai < 2; ++ai)
#pragma unroll
            for (int m = 0; m < 4; ++m) { const size_t srow = (size_t)(u.pm * 256 + ai * 128 + wr * 64 + m * 16 + fr); const float rs = rss[ai][m];
                f32x2 av[2][2];
#pragma unroll
                for (int bj = 0; bj < 2; ++bj)
#pragma unroll
                    for (int jp = 0; jp < 2; ++jp) {
                        const f32x2 g = {(float)acc[ai][bj][m][0][2 * jp], (float)acc[ai][bj][m][0][2 * jp + 1]}, lv = {(float)acc[ai][bj][m][1][2 * jp], (float)acc[ai][bj][m][1][2 * jp + 1]};
                        const f32x2 sg = (f32x2){cs[bj][0][2 * jp], cs[bj][0][2 * jp + 1]} * rs, sl = (f32x2){cs[bj][1][2 * jp], cs[bj][1][2 * jp + 1]} * rs;
                        const f32x2 bg = {bb[bj][jp][0], bb[bj][jp][2]}, bl = {bb[bj][jp][1], bb[bj][jp][3]};
                        const f32x2 xg = __builtin_elementwise_min(g * sg + bg, (f32x2){7.0f, 7.0f});
                        const f32x2 xl = __builtin_elementwise_min(__builtin_elementwise_max(lv * sl + bl, (f32x2){-7.0f, -7.0f}), (f32x2){7.0f, 7.0f});
                        const f32x2 z = xg * KE; f32x2 ex; ex.x = __builtin_amdgcn_exp2f(z.x); ex.y = __builtin_amdgcn_exp2f(z.y);
                        const f32x2 dn = ex + 1.0f; f32x2 sig; sig.x = __builtin_amdgcn_rcpf(dn.x); sig.y = __builtin_amdgcn_rcpf(dn.y);
                        av[bj][jp] = (xg * sig) * (xl * 4.0f + 4.0f); }
                u32x2 w; w.x = pk_fp8x4_nc(av[0][0].x, av[0][0].y, av[0][1].x, av[0][1].y); w.y = pk_fp8x4_nc(av[1][0].x, av[1][0].y, av[1][1].x, av[1][1].y);
                *(GAS u32x2*)(act + srow * DFF + f0) = w; }
    }
};
struct EpiDown {
    unsigned char* ws; int l;
    static constexpr int NTAB = 2;
    DI const char* tab(int k, const pg8::Unit& u) const {
        const char* t0 = (const char*)(kargs()->in.b_down + ((size_t)(l * NE + u.e) * D + (size_t)u.pn * 256));
        const char* t1 = (const char*)((const float*)(ws + WS_SLG) + (size_t)u.pm * 256);
        return k == 0 ? t0 : t1; }
    DI void operator()(const f32x4 (&acc)[2][2][4][2], const pg8::Unit& u, int wr, int wc, int fr, int fq, const LAS unsigned char* et) const {
        GAS signed char* mout = (GAS signed char*)(ws + WS_MOUT); GAS float* msc = (GAS float*)(ws + WS_MSC);
        const int c0 = u.pn * 256 + 64 * wc + 8 * fq;
        const LAS float* bp = (const LAS float*)et + 64 * wc + 8 * fq; const LAS float* slg = (const LAS float*)(et + 1024);
        f32x4 bv[2][2];
#pragma unroll
        for (int bj = 0; bj < 2; ++bj)
#pragma unroll
            for (int n = 0; n < 2; ++n) bv[bj][n] = *(const LAS f32x4*)(bp + 32 * bj + 4 * n);
        float gts[2][4];
#pragma unroll
        for (int ai = 0; ai < 2; ++ai)
#pragma unroll
            for (int m = 0; m < 4; ++m) gts[ai][m] = slg[ai * 128 + wr * 64 + m * 16 + fr];
#pragma unroll
        for (int ai = 0; ai < 2; ++ai)
#pragma unroll
            for (int m = 0; m < 4; ++m) { const size_t srow = (size_t)(u.pm * 256 + ai * 128 + wr * 64 + m * 16 + fr); const float gt = gts[ai][m], g256 = gt * (1.0f / 256.0f);
                f32x4 v[2][2]; float am = 0.f;
#pragma unroll
                for (int bj = 0; bj < 2; ++bj)
#pragma unroll
                    for (int n = 0; n < 2; ++n) { v[bj][n] = acc[ai][bj][m][n] * g256 + bv[bj][n] * gt;
                        am = fmaxf(am, fmaxf(fmaxf(fabsf(v[bj][n][0]), fabsf(v[bj][n][1])), fmaxf(fabsf(v[bj][n][2]), fabsf(v[bj][n][3])))); }
                am = max_x16x32(am);
                const float qs = 127.0f / fmaxf(am, 1e-30f);
#pragma unroll
                for (int bj = 0; bj < 2; ++bj) { u32x2 w;
#pragma unroll
                    for (int n = 0; n < 2; ++n) { const int q0 = (int)rintf(v[bj][n][0] * qs), q1 = (int)rintf(v[bj][n][1] * qs), q2 = (int)rintf(v[bj][n][2] * qs), q3 = (int)rintf(v[bj][n][3] * qs);
                        w[n] = (unsigned)(q0 & 255) | ((unsigned)(q1 & 255) << 8) | ((unsigned)(q2 & 255) << 16) | ((unsigned)(q3 & 255) << 24); }
                    *(GAS u32x2*)(mout + srow * D + c0 + 32 * bj) = w; }
                if (fq == 0) msc[srow * 16 + u.pn * 4 + wc] = am * (1.0f / 127.0f); }
    }
};

struct NormArgs {
    const float* xin; const float* x0; const float* ctx0;
    const bf16* delta; const float* dsc;
    const bf16* mout; const float* msc; const int* toks; const float* g2mod;
    const float* mod; int shi, sci;
    float* xout; bf16* hout; signed char* h8; float* hs;
    const bf16* wsm; const float* sbias;
    float* mg;
    int* toke; float* tokg; int* ghist; int* bhist;
    const float* fnorm; float* out;
    int gs;
};
template <int MODE>
DI void norm_phase(LAS unsigned char* lds, const NormArgs& a) {
    constexpr int NS = (MODE == 0) ? 16 : 32, NBK = NS / 16, TP = 2064, RP = 36;
    const int tid = opaque_tid(), wid = __builtin_amdgcn_readfirstlane(tid >> 6), lane = tid & 63, fr = lane & 15, fq = lane >> 4;
    const GAS float* gxin = (const GAS float*)a.xin; const GAS float* gx0 = (const GAS float*)a.x0; const GAS float* gctx0 = (const GAS float*)a.ctx0; const GAS bf16* gdelta = (const GAS bf16*)a.delta;
    const GAS float* gdsc = (const GAS float*)a.dsc; const GAS float* gmsc = (const GAS float*)a.msc; const GAS bf16* gmout = (const GAS bf16*)a.mout; const GAS int* gtoks = (const GAS int*)a.toks; const GAS float* gg2mod = (const GAS float*)a.g2mod; const GAS float* gmod = (const GAS float*)a.mod;
    GAS float* gxout = (GAS float*)a.xout; GAS signed char* gh8 = (GAS signed char*)a.h8; GAS float* ghs = (GAS float*)a.hs; const GAS float* gfnorm = (const GAS float*)a.fnorm; GAS float* gout = (GAS float*)a.out;
    LAS unsigned char* Thi = lds; LAS unsigned char* Tlo = lds + 16 * TP;
    LAS float* red = (LAS float*)(lds + 2 * 16 * TP);
    LAS int* hist = (LAS int*)(lds + 2 * 16 * TP + 8 * 16 * RP * 4);
    const int G = gridDim.x, bid = opaque_bid(), per = (NGRP - a.gs + G - 1) / G, g0 = a.gs + bid * per, g1 = (g0 + per < NGRP) ? g0 + per : NGRP;
    bf16x8 Bh[4][NBK], Bl[4][NBK];
    if (MODE == 1) {
#pragma unroll
        for (int s = 0; s < 4; ++s)
#pragma unroll
            for (int nb = 0; nb < NBK; ++nb) { const size_t o = (size_t)(nb * 16 + fr) * D + 128 * wid + 32 * s + 8 * fq;
                Bh[s][nb] = *(const bf16x8*)(a.wsm + o); Bl[s][nb] = *(const bf16x8*)(a.wsm + (size_t)NS * D + o); }
    }
    int blk = 0;
    if (MODE == 1) { if (tid < 64) hist[tid] = 0; }
    const float sbv = (MODE != 2 && tid < 16 * NS) ? a.sbias[tid % NS] : 0.f;
    f32x4 xv[2][4]; unsigned dv[2][4]; float ds[2][2]; i32x4 tk[2];
#define NCOL(j) (512 * ((j) >> 1) + 8 * lane + 4 * ((j) & 1))
#define NORM_LOAD(gg) do { _Pragma("unroll") for (int rr = 0; rr < 2; ++rr) { const int row_ = 16 * (gg) + 2 * wid + rr; \
        if (a.xin) { const GAS bf16* xr_ = uni((const GAS bf16*)gxin + (size_t)row_ * D); _Pragma("unroll") for (int h_ = 0; h_ < 2; ++h_) { const u32x4 xb_ = __builtin_nontemporal_load((const GAS u32x4*)(xr_ + 512 * h_ + 8 * lane)); \
            xv[rr][2 * h_] = (f32x4){bflo(xb_.x), bfhi(xb_.x), bflo(xb_.y), bfhi(xb_.y)}; xv[rr][2 * h_ + 1] = (f32x4){bflo(xb_.z), bfhi(xb_.z), bflo(xb_.w), bfhi(xb_.w)}; } } \
        else { const GAS float* xp_ = uni(row_ < NCTX ? gctx0 + (size_t)row_ * D : gx0 + (size_t)(row_ - NCTX) * D); \
            _Pragma("unroll") for (int j = 0; j < 4; ++j) xv[rr][j] = __builtin_nontemporal_load((const GAS f32x4*)(xp_ + NCOL(j))); } \
        if (a.delta) { const GAS signed char* dr_ = uni((const GAS signed char*)gdelta + (size_t)row_ * D); const GAS float* sr_ = uni(gdsc + (size_t)row_ * 16); _Pragma("unroll") for (int h_ = 0; h_ < 2; ++h_) { const u32x2 d_ = __builtin_nontemporal_load((const GAS u32x2*)(dr_ + 512 * h_ + 8 * lane)); \
            dv[rr][2 * h_] = d_.x; dv[rr][2 * h_ + 1] = d_.y; ds[rr][h_] = sr_[8 * h_ + (lane >> 3)]; } } } } while (0)
    unsigned mo[2][4][4]; float ms[2][4][2];
#define TK_LOAD(gg) do { _Pragma("unroll") for (int rr = 0; rr < 2; ++rr) tk[rr] = *(const GAS i32x4*)(uni(gtoks + (size_t)(16 * (gg) + 2 * wid + rr) * 4)); } while (0)
#define MOE_LOAD() do { _Pragma("unroll") for (int rr = 0; rr < 2; ++rr) { const int sl_[4] = {__builtin_amdgcn_readfirstlane(tk[rr][0]), __builtin_amdgcn_readfirstlane(tk[rr][1]), __builtin_amdgcn_readfirstlane(tk[rr][2]), __builtin_amdgcn_readfirstlane(tk[rr][3])}; \
        _Pragma("unroll") for (int k = 0; k < 4; ++k) { const GAS signed char* mr_ = (const GAS signed char*)gmout + (size_t)sl_[k] * D; const GAS float* cr_ = gmsc + (size_t)sl_[k] * 16; \
          _Pragma("unroll") for (int h_ = 0; h_ < 2; ++h_) { const u32x2 m_ = __builtin_nontemporal_load((const GAS u32x2*)(mr_ + 512 * h_ + 8 * lane)); \
            mo[rr][k][2 * h_] = m_.x; mo[rr][k][2 * h_ + 1] = m_.y; ms[rr][k][h_] = cr_[8 * h_ + (lane >> 3)]; } } } } while (0)
    if (g0 < g1) { NORM_LOAD(g0); if (a.mout) { TK_LOAD(g0); MOE_LOAD(); if (g0 + 1 < g1) TK_LOAD(g0 + 1); } }
    f32x4 shc[4], scc[4]; int mrow_c = -1;
    for (int g = g0; g < g1; ++g) {
        f32x4 v[2][4];
#pragma unroll
        for (int rr = 0; rr < 2; ++rr) {
#pragma unroll
            for (int j = 0; j < 4; ++j) { v[rr][j] = xv[rr][j];
                if (a.delta) { const int w = (int)dv[rr][j]; const float sc = ds[rr][j >> 1];
                    v[rr][j][0] += (float)((int)((unsigned)w << 24) >> 24) * sc; v[rr][j][1] += (float)((int)((unsigned)w << 16) >> 24) * sc; v[rr][j][2] += (float)((int)((unsigned)w << 8) >> 24) * sc; v[rr][j][3] += (float)(w >> 24) * sc; } }
        }
        if (a.mout) {
#pragma unroll
            for (int rr = 0; rr < 2; ++rr) { const int row = 16 * g + 2 * wid + rr; const GAS float* g2 = gg2mod + (size_t)mod_row(row) * 6 * D + 5 * D;
#pragma unroll
                for (int j = 0; j < 4; ++j) { const f32x4 gg = *(const GAS f32x4*)(g2 + NCOL(j));
                    f32x4 sm = (f32x4){0.f, 0.f, 0.f, 0.f};
#pragma unroll
                    for (int k = 0; k < 4; ++k) { const int w = (int)mo[rr][k][j]; const float sc = ms[rr][k][j >> 1];
                        sm[0] += (float)((int)((unsigned)w << 24) >> 24) * sc; sm[1] += (float)((int)((unsigned)w << 16) >> 24) * sc; sm[2] += (float)((int)((unsigned)w << 8) >> 24) * sc; sm[3] += (float)(w >> 24) * sc; }
                    v[rr][j] = v[rr][j] + gg * sm; } }
        }
        if (g + 1 < g1) { NORM_LOAD(g + 1); if (a.mout) { MOE_LOAD(); if (g + 2 < g1) TK_LOAD(g + 2); } }
#pragma unroll
        for (int rr = 0; rr < 2; ++rr) {
            const int r = 2 * wid + rr, row = 16 * g + r;
            const int mrow = mod_row(row);
            if (MODE == 0) {
#pragma unroll
                for (int h_ = 0; h_ < 2; ++h_) { u32x4 xb; xb.x = pk2(v[rr][2 * h_][0], v[rr][2 * h_][1]); xb.y = pk2(v[rr][2 * h_][2], v[rr][2 * h_][3]); xb.z = pk2(v[rr][2 * h_ + 1][0], v[rr][2 * h_ + 1][1]); xb.w = pk2(v[rr][2 * h_ + 1][2], v[rr][2 * h_ + 1][3]);
                    *(GAS u32x4*)((GAS bf16*)gxout + (size_t)row * D + 512 * h_ + 8 * lane) = xb;
                    v[rr][2 * h_] = (f32x4){bflo(xb.x), bfhi(xb.x), bflo(xb.y), bfhi(xb.y)}; v[rr][2 * h_ + 1] = (f32x4){bflo(xb.z), bfhi(xb.z), bflo(xb.w), bfhi(xb.w)}; }
            }
            float ss = 0.f;
#pragma unroll
            for (int j = 0; j < 4; ++j) ss += (v[rr][j][0] * v[rr][j][0] + v[rr][j][1] * v[rr][j][1]) + (v[rr][j][2] * v[rr][j][2] + v[rr][j][3] * v[rr][j][3]);
            const float rstd = 1.0f / sqrtf(wave_sum(ss) * (1.0f / D) + EPS);
            if (MODE == 2) {
                if (row >= NCTX) {
#pragma unroll
                    for (int j = 0; j < 4; ++j) { const int c = NCOL(j); const f32x4 fn = *(const GAS f32x4*)(gfnorm + c); *(GAS f32x4*)(gout + (size_t)(row - NCTX) * D + c) = v[rr][j] * rstd * fn; }
                }
            } else {
                if (MODE <= 1) {
                    if (mrow != mrow_c) { mrow_c = mrow; const GAS float* shp = gmod + (size_t)mrow * 6 * D + a.shi * D; const GAS float* scp = gmod + (size_t)mrow * 6 * D + a.sci * D;
#pragma unroll
                        for (int j = 0; j < 4; ++j) { shc[j] = *(const GAS f32x4*)(shp + NCOL(j)); scc[j] = *(const GAS f32x4*)(scp + NCOL(j)) + 1.0f; } }
                }
                const GAS float* shp = gmod + (size_t)mrow * 6 * D + a.shi * D; const GAS float* scp = gmod + (size_t)mrow * 6 * D + a.sci * D;
                f32x4 h[4]; float am = 0.f;
#pragma unroll
                for (int j = 0; j < 4; ++j) { const int c = NCOL(j); f32x4 sh, sc1; if (MODE <= 1) { sh = shc[j]; sc1 = scc[j]; } else { sh = *(const GAS f32x4*)(shp + c); sc1 = *(const GAS f32x4*)(scp + c) + 1.0f; }
                    h[j] = v[rr][j] * rstd * sc1 + sh;
                    u32x2 hi; hi.x = pk2(h[j][0], h[j][1]); hi.y = pk2(h[j][2], h[j][3]);
                    u32x2 lo; lo.x = pk2(h[j][0] - bflo(hi.x), h[j][1] - bfhi(hi.x)); lo.y = pk2(h[j][2] - bflo(hi.y), h[j][3] - bfhi(hi.y));
                    am = fmaxf(am, fmaxf(fmaxf(fabsf(h[j][0]), fabsf(h[j][1])), fmaxf(fabsf(h[j][2]), fabsf(h[j][3]))));
                    *(LAS u32x2*)(Thi + r * TP + c * 2) = hi; *(LAS u32x2*)(Tlo + r * TP + c * 2) = lo; }
                {
                    am = wave_max(am);
                    am = fmaxf(am, 1e-20f); const float qs = 127.0f / am;
#pragma unroll
                    for (int h_ = 0; h_ < 2; ++h_) { u32x2 qw;
#pragma unroll
                        for (int q_ = 0; q_ < 2; ++q_) { const int j = 2 * h_ + q_; const int q0 = (int)rintf(h[j][0] * qs), q1 = (int)rintf(h[j][1] * qs), q2 = (int)rintf(h[j][2] * qs), q3 = (int)rintf(h[j][3] * qs);
                            qw[q_] = (unsigned)(q0 & 255) | ((unsigned)(q1 & 255) << 8) | ((unsigned)(q2 & 255) << 16) | ((unsigned)(q3 & 255) << 24); }
                        *(GAS u32x2*)(gh8 + (size_t)row * D + 512 * h_ + 8 * lane) = qw; }
                    if (lane == 0) ghs[row] = am * (1.0f / 127.0f);
                }
            }
        }
        if (MODE == 2) continue;
        if (MODE == 0) {
#pragma unroll
            for (int s = 0; s < 4; ++s)
#pragma unroll
                for (int nb = 0; nb < NBK; ++nb) { const size_t o = (size_t)(nb * 16 + fr) * D + 128 * wid + 32 * s + 8 * fq;
                    Bh[s][nb] = *(const bf16x8*)(a.wsm + o); Bl[s][nb] = *(const bf16x8*)(a.wsm + (size_t)NS * D + o); }
        }
        __syncthreads();
        if (MODE == 1 && g > g0 && tid < 32) { LAS int* hp = hist + 32 * ((g - 1 - g0) & 1); const int h = hp[tid]; a.ghist[(size_t)(g - 1) * 32 + tid] = h; blk += h; hp[tid] = 0; }
        f32x4 pacc[NBK];
#pragma unroll
        for (int nb = 0; nb < NBK; ++nb) pacc[nb] = (f32x4){0.f, 0.f, 0.f, 0.f};
#pragma unroll
        for (int s = 0; s < 4; ++s) { const int ko = (128 * wid + 32 * s + 8 * fq) * 2;
            const bf16x8 ah = *(const LAS bf16x8*)(Thi + fr * TP + ko), al = *(const LAS bf16x8*)(Tlo + fr * TP + ko);
#pragma unroll
            for (int nb = 0; nb < NBK; ++nb) { pacc[nb] = __builtin_amdgcn_mfma_f32_16x16x32_bf16(ah, Bh[s][nb], pacc[nb], 0, 0, 0);
                pacc[nb] = __builtin_amdgcn_mfma_f32_16x16x32_bf16(ah, Bl[s][nb], pacc[nb], 0, 0, 0); pacc[nb] = __builtin_amdgcn_mfma_f32_16x16x32_bf16(al, Bh[s][nb], pacc[nb], 0, 0, 0); } }
#pragma unroll
        for (int nb = 0; nb < NBK; ++nb)
#pragma unroll
            for (int i = 0; i < 4; ++i) red[(wid * 16 + 4 * fq + i) * RP + nb * 16 + fr] = pacc[nb][i];
        __syncthreads();
        if (tid < 16 * NS) {
            const int rw = tid / NS, n = tid % NS;
            float val = sbv;
#pragma unroll
            for (int w = 0; w < 8; ++w) val += red[(w * 16 + rw) * RP + n];
            const int row = 16 * g + rw;
            if (MODE == 0) {
                if ((n >> 2) & 1) val = log_sigmoid(val);
                a.mg[(size_t)row * 16 + n] = val;
            } else {
                float vv = val; int ei[4]; float tv[4];
#pragma unroll
                for (int it = 0; it < 4; ++it) { float bvv = vv; int bi = n;
                    {
#define TOPSTEP(CTRL) { const float ov = dpp_f<CTRL>(bvv); const int oi = dpp_i<CTRL>(bi); if (ov > bvv || (ov == bvv && oi < bi)) { bvv = ov; bi = oi; } }
                        TOPSTEP(0xB1) TOPSTEP(0x4E) TOPSTEP(0x141) TOPSTEP(0x140)
#undef TOPSTEP
                        const auto rv = __builtin_amdgcn_permlane16_swap(__float_as_uint(bvv), __float_as_uint(bvv), false, false); const auto ri = __builtin_amdgcn_permlane16_swap((unsigned)bi, (unsigned)bi, false, false);
                        const float v0 = __uint_as_float(rv[0]), v1 = __uint_as_float(rv[1]); const int i0 = (int)ri[0], i1 = (int)ri[1];
                        if (v0 > v1 || (v0 == v1 && i0 < i1)) { bvv = v0; bi = i0; } else { bvv = v1; bi = i1; } }
                    ei[it] = bi; tv[it] = bvv; if (n == bi) vv = -INFINITY; }
                if (n == 0) {
                    const float e1 = __expf(tv[1] - tv[0]), e2 = __expf(tv[2] - tv[0]), e3 = __expf(tv[3] - tv[0]); const float inv = 1.0f / (1.0f + e1 + e2 + e3);
                    *(int4*)(a.toke + (size_t)row * 4) = make_int4(ei[0], ei[1], ei[2], ei[3]);
                    *(float4*)(a.tokg + (size_t)row * 4) = make_float4(inv, e1 * inv, e2 * inv, e3 * inv);
                    LAS int* hg = hist + 32 * ((g - g0) & 1); atomicAdd((int*)&hg[ei[0]], 1); atomicAdd((int*)&hg[ei[1]], 1); atomicAdd((int*)&hg[ei[2]], 1); atomicAdd((int*)&hg[ei[3]], 1);
                }
            }
        }
    }
    if (MODE == 1) { __syncthreads(); if (g1 > g0 && tid < 32) { LAS int* hp = hist + 32 * ((g1 - 1 - g0) & 1); const int h = hp[tid]; a.ghist[(size_t)(g1 - 1) * 32 + tid] = h; blk += h; }
        if (tid < 32) a.bhist[(size_t)bid * 32 + tid] = blk; }
    __syncthreads();
}

#undef NORM_LOAD
#undef NCOL
#undef TK_LOAD
#undef MOE_LOAD
struct ScatterArgs { const int* toke; const float* tokg; const int* ghist; const int* bhist; int* toks; int* sltok; float* slg; int* rte; const float* hs; float* sls; int gs; unsigned char* rteb; };
DI void scatter_phase(LAS unsigned char* lds, const ScatterArgs& a) {
    const int tid = opaque_tid(), wid = __builtin_amdgcn_readfirstlane(tid >> 6), lane = tid & 63;
    LAS int* ptot = (LAS int*)lds; LAS int* ppre = ptot + 512; LAS int* stt = ppre + 512; LAS int* tot = stt + 32; LAS int* pre = tot + 32; LAS int* padv = pre + 32;
    const int G = gridDim.x, B = opaque_bid(), per = (NGRP - a.gs + G - 1) / G, g0 = a.gs + B * per, g1 = (g0 + per < NGRP) ? g0 + per : NGRP;
    { const int e = tid & 31, seg = tid >> 5; int t = 0, p = 0;
      for (int b = seg; b < G; b += 16) { const int h = a.bhist[(size_t)b * 32 + e]; t += h; if (b < B) p += h; }
      ptot[seg * 32 + e] = t; ppre[seg * 32 + e] = p; }
    __syncthreads();
    if (tid < 32) { int t = 0, p = 0;
#pragma unroll
        for (int s = 0; s < 16; ++s) { t += ptot[s * 32 + tid]; p += ppre[s * 32 + tid]; }
        const int pd = (t + 255) & ~255; int sc = pd;
#pragma unroll
        for (int o = 1; o < 32; o <<= 1) { const int x = __shfl_up(sc, o); if (tid >= o) sc += x; }
        stt[tid] = sc - pd; tot[tid] = t; pre[tid] = p; padv[tid] = pd;
        if (B == 0 && tid == 31) a.rte[0] = sc >> 8; }
    __syncthreads();
    if (B == 0) {
        for (int e = 0; e < 32; ++e) { const int s0 = stt[e], t = tot[e], pd = padv[e];
            for (int s = t + tid; s < pd; s += 512) { a.sltok[s0 + s] = 0; a.slg[s0 + s] = 0.f; a.sls[s0 + s] = 0.f; }
            for (int rt = (s0 >> 8) + tid; rt < ((s0 + pd) >> 8); rt += 512) { a.rte[32 + rt] = e; a.rteb[rt] = (unsigned char)e; } }
    }
    for (int g = g0 + wid; g < g1; g += 8) {
        int base = 0;
        if (lane < 32) { base = stt[lane] + pre[lane]; for (int gg = g0; gg < g; ++gg) base += a.ghist[(size_t)gg * 32 + lane]; }
        const int ti = lane >> 2, tok = 16 * g + ti;
        const int e = a.toke[(size_t)tok * 4 + (lane & 3)]; const float gt = a.tokg[(size_t)tok * 4 + (lane & 3)];
        const unsigned long long below = (ti == 0) ? 0ull : ((1ull << (4 * ti)) - 1ull);
        int rank = 0;
        for (int ee = 0; ee < 32; ++ee) { const unsigned long long m = __ballot(e == ee); if (e == ee) rank = __popcll(m & below); }
        const int slot = __shfl(base, e) + rank;
        a.sltok[slot] = tok; a.slg[slot] = gt; a.sls[slot] = a.hs[tok]; a.toks[(size_t)tok * 4 + (lane & 3)] = slot;
    }
    __syncthreads();
}

namespace attn_body {
using f32x16 = __attribute__((ext_vector_type(16))) float;
using s16x4 = __attribute__((ext_vector_type(4))) short;
constexpr int NW = 8, QBLK = 32, KVBLK = 64;
constexpr int QP = 512, KP = 64, OP = 1024;
DI int crow(int r, int hi) { return (r & 3) + 8 * (r >> 2) + 4 * hi; }
#define SBAR() __builtin_amdgcn_sched_barrier(0)
constexpr int NSLOT = 3, SLOTB = 8192;
constexpr int LDS_K = 0, LDS_V = NSLOT * SLOTB, LDS_WS = 2 * NSLOT * SLOTB, LDS_OST = LDS_WS + NW * 64 * 4, ATT_LDS_BYTES = LDS_OST + NW * 4096;
DI void glds16(const void* gsrc, unsigned lds_dst) { unsigned keep;
    asm volatile("s_mov_b32 %0, m0\n\ts_mov_b32 m0, %2\n\ts_nop 0\n\tglobal_load_lds_dwordx4 %1, off\n\ts_mov_b32 m0, %0" : "=&s"(keep) : "v"(gsrc), "s"(lds_dst) : "memory"); }
DI float max3f(float a, float b, float c) { float r; asm("v_max3_f32 %0, %1, %2, %3" : "=v"(r) : "v"(a), "v"(b), "v"(c)); return r; }
DI float max2f(float a, float b) { float r; asm("v_max_f32_e32 %0, %1, %2" : "=v"(r) : "v"(a), "v"(b)); return r; }
DI float fadd_s(float a, float b) { float r; asm("v_add_f32_e32 %0, %1, %2" : "=v"(r) : "v"(a), "v"(b)); return r; }
DI float fsub_s(float a, float b) { float r; asm("v_sub_f32_e32 %0, %1, %2" : "=v"(r) : "v"(a), "v"(b)); return r; }
DI unsigned cvtpk_s(float lo, float hi) { return pk2(lo, hi); }
#define WAIT_BAR(N) asm volatile("s_waitcnt vmcnt(" #N ") lgkmcnt(0)\n\ts_barrier" ::: "memory")
typedef LAS const char* lds_cptr;
typedef short v4i16_t __attribute__((ext_vector_type(4)));
typedef int i32x8 __attribute__((ext_vector_type(8)));
DI i32x8 cat8i(i32x4 x0, i32x4 x1) { return __builtin_shufflevector(x0, x1, 0, 1, 2, 3, 4, 5, 6, 7); }
DI i32x8 kload1(lds_cptr kp, int kh) { return cat8i(*(const LAS i32x4*)(kp + kh * 512), *(const LAS i32x4*)(kp + 1024 + kh * 512)); }
DI f32x16 mfq(i32x8 a, i32x8 b, f32x16 c) { return __builtin_amdgcn_mfma_scale_f32_32x32x64_f8f6f4(a, b, c, 0, 0, 0, 0, 0, 0); }
DI s16x4 vtr(lds_cptr p) { return __builtin_bit_cast(s16x4, __builtin_amdgcn_ds_read_tr16_b64_v4i16((LAS v4i16_t*)p)); }
DI float rowmax(const f32x16& p0, const f32x16& p1) {
    float a = max3f(p0[0], p0[1], p1[0]), b = max3f(p0[2], p0[3], p1[1]); a = max3f(a, p1[2], p1[3]);
#pragma unroll
    for (int r = 4; r < 16; r += 4) { a = max3f(a, p0[r], p0[r + 1]); b = max3f(b, p0[r + 2], p0[r + 3]); a = max3f(a, p1[r], p1[r + 1]); b = max3f(b, p1[r + 2], p1[r + 3]); }
    const float m = max2f(a, b);
    auto rr = __builtin_amdgcn_permlane32_swap(__float_as_uint(m), __float_as_uint(m), false, false);
    return max2f(__uint_as_float(rr[0]), __uint_as_float(rr[1]));
}
DI void pv(f32x16* o, int vb, bf16x8 pa0, bf16x8 pa1, bf16x8 pa2, bf16x8 pa3) {
#pragma unroll
    for (int d0 = 0; d0 < 2; ++d0) { s16x4 lo[4], hi[4];
#pragma unroll
        for (int ks = 0; ks < 4; ++ks) {
            asm volatile("ds_read_b64_tr_b16 %0,%1 offset:%c2" : "=&v"(lo[ks]) : "v"(vb), "i"(d0 * 4096 + ks * 1024) : "memory");
            asm volatile("ds_read_b64_tr_b16 %0,%1 offset:%c2" : "=&v"(hi[ks]) : "v"(vb), "i"(d0 * 4096 + ks * 1024 + 512) : "memory"); }
        asm volatile("s_waitcnt lgkmcnt(0)" ::: "memory"); SBAR();
#define PK(k) (bf16x8){lo[k][0], lo[k][1], lo[k][2], lo[k][3], hi[k][0], hi[k][1], hi[k][2], hi[k][3]}
        o[d0] = __builtin_amdgcn_mfma_f32_32x32x16_bf16(pa0, PK(0), o[d0], 0, 0, 0);
        o[d0] = __builtin_amdgcn_mfma_f32_32x32x16_bf16(pa1, PK(1), o[d0], 0, 0, 0);
        o[d0] = __builtin_amdgcn_mfma_f32_32x32x16_bf16(pa2, PK(2), o[d0], 0, 0, 0);
        o[d0] = __builtin_amdgcn_mfma_f32_32x32x16_bf16(pa3, PK(3), o[d0], 0, 0, 0);
#undef PK
    }
}
template <int THRL, bool NOMAX> DI void attn_unit(const unsigned char* Qu, const unsigned char* __restrict__ Kh, const bf16* __restrict__ Vh, const int NT, unsigned char* Ou, const float* gain, char* shm) {
    const int tid = opaque_tid(), lane = tid & 63, r32 = lane & 31, hi = lane >> 5; const int wid = __builtin_amdgcn_readfirstlane(tid >> 6);
    const unsigned char* Qw = Qu + (long)(wid * QBLK) * QP;
    const unsigned lds0 = (unsigned)(uintptr_t)shm;
    float* wsf = (float*)(shm + LDS_WS) + wid * 64;
    const unsigned char* ksrc = Kh + (long)lane * KP + (wid & 3) * 16;
    const bf16* vsrc = Vh + (long)(16 * (wid & 3) + (lane >> 2)) * KP + (wid >> 2) * 32 + (lane & 3) * 8;
    const unsigned kdst = lds0 + LDS_K + (wid & 3) * 1024, vdst = lds0 + LDS_V + wid * 1024;
#define DMA_K(t, slot) glds16(ksrc + (long)(t) * KVBLK * KP, (unsigned)__builtin_amdgcn_readfirstlane(kdst + (slot)))
#define DMA_V(t, slot) glds16(vsrc + (long)(t) * KVBLK * KP, (unsigned)__builtin_amdgcn_readfirstlane(vdst + (slot)))
    const int vb0 = (int)(lds0 + LDS_V) + ((lane >> 4) & 1) * 32 + (lane & 3) * 8 + (4 * hi + ((lane & 15) >> 2)) * 64;
    i32x8 kf[2];
    const lds_cptr shm3 = (lds_cptr)shm; const lds_cptr kp0 = shm3 + LDS_K + hi * 2048 + r32 * 16; const lds_cptr vp0 = shm3 + LDS_V + ((lane >> 4) & 1) * 32 + (lane & 3) * 8 + (4 * hi + ((lane & 15) >> 2)) * 64;
    DMA_K(0, 0); DMA_V(0, 0); DMA_K(1, SLOTB);
    const i32x8 qr = cat8i(*reinterpret_cast<const i32x4*>(Qw + (long)r32 * QP + hi * 32), *reinterpret_cast<const i32x4*>(Qw + (long)r32 * QP + hi * 32 + 16));
    float mhat = 0.f, l_reg = 0.f; f32x16 o[2]; o[0] = f32x16{}; o[1] = f32x16{}; f32x16 negm = f32x16{}; asm volatile("" : "+v"(negm));
    bool resc = false;
#define START(P0, P1) do { resc = false; \
    if constexpr (!NOMAX) { const float rm = rowmax(P0, P1); const float dl = rm; mhat = fadd_s(mhat, dl); \
      _Pragma("unroll") for (int r = 0; r < 16; ++r) { P0[r] = fsub_s(P0[r], dl); P1[r] = fsub_s(P1[r], dl); } \
      _Pragma("unroll") for (int r = 0; r < 16; ++r) negm[r] = -mhat; asm volatile("" : "+v"(negm)); } \
    _Pragma("unroll") for (int r = 0; r < 16; ++r) P0[r] = __builtin_amdgcn_exp2f(P0[r]); } while (0)
#define RESC() do { if (resc) { asm volatile("s_waitcnt lgkmcnt(0)" ::: "memory"); \
      _Pragma("unroll") for (int d_ = 0; d_ < 2; ++d_) _Pragma("unroll") for (int r = 0; r < 16; ++r) o[d_][r] *= wsf[crow(r, hi)]; } } while (0)
    f32x16 pA0, pA1, pB0, pB1;
    int sl_prev = 0, sl_cur = 0, sl_next = SLOTB;
#define ROT() do { sl_prev = sl_cur; sl_cur = sl_next; sl_next = (sl_next == (NSLOT - 1) * SLOTB) ? 0 : sl_next + SLOTB; } while (0)
    DMA_K(2, 2 * SLOTB);
    WAIT_BAR(3);
    pA0 = mfq(kload1(kp0, 0), qr, negm); pA1 = mfq(kload1(kp0, 1), qr, negm);
    if constexpr (!NOMAX) asm volatile("s_nop 15\n\ts_nop 15" : "+v"(pA0), "+v"(pA1));
    START(pA0, pA1);
    _Pragma("unroll") for (int r = 0; r < 16; ++r) pA1[r] = __builtin_amdgcn_exp2f(pA1[r]);
    WAIT_BAR(0);
    DMA_K(3, 0); DMA_V(1, SLOTB);
    ROT();
    kf[0] = kload1(kp0 + sl_cur, 0); kf[1] = kload1(kp0 + sl_cur, 1);
    WAIT_BAR(2);
    s16x4 vlo[8], vhi[8]; u32x4 pw0, pw1, pw2, pw3;
#define PKW(P, B) cvtpk_s(P[B], P[B + 1])
#define PAF(k) __builtin_bit_cast(bf16x8, pw##k)
#define VFR(i) (bf16x8){vlo[i][0], vlo[i][1], vlo[i][2], vlo[i][3], vhi[i][0], vhi[i][1], vhi[i][2], vhi[i][3]}
#define PIN(x) asm volatile("" : "+v"(x))
#define MX3(a, b, c) __builtin_fmaxf(__builtin_fmaxf((a), (b)), (c))
#define GAPA(MF, A0, A1, A2, A3, W0, W1, PW) do { MF; sacc += A0; sacc += A1; sacc += A2; sacc += A3; PIN(sacc); W0; W1; PIN(PW); SBAR(); } while (0)
#define EX(v) __builtin_amdgcn_exp2f(v)
#define GAPB(MF, X, B) do { MF; X[B] = EX(X[B]); X[B + 1] = EX(X[B + 1]); X[B + 2] = EX(X[B + 2]); X[B + 3] = EX(X[B + 3]); PIN(X); SBAR(); } while (0)
#define VRD(i) do { vlo[i] = vtr(vp_ + (((i) >> 2) * 4096 + ((i) & 3) * 1024)); vhi[i] = vtr(vp_ + (((i) >> 2) * 4096 + ((i) & 3) * 1024 + 512)); } while (0)
#define KRD(G, j) do { if (G) { kf[j] = kload1(kp0 + sl_next, j); SBAR(); } } while (0)
#define STEP(C0, C1, P0, P1, t, GK, GV, GL) do { SBAR(); \
    const lds_cptr vp_ = vp0 + sl_prev; \
    VRD(0); SBAR(); float sacc = (P0[0] + P0[1]); \
    GAPA(C0 = mfq(kf[0], qr, negm), P0[2], P0[3], P0[4], P0[5],     pw0[0] = PKW(P0, 0), pw0[1] = PKW(P0, 2), pw0); \
    VRD(4); SBAR(); GAPA((void)0, P0[6], P0[7], P0[8], P0[9],     pw0[2] = PKW(P0, 4), pw0[3] = PKW(P0, 6), pw0); \
    VRD(1); SBAR(); GAPA((void)0, P0[10], P0[11], P0[12], P0[13], pw1[0] = PKW(P0, 8), pw1[1] = PKW(P0, 10), pw1); \
    VRD(5); SBAR(); GAPA((void)0, P0[14], P0[15], P1[0], P1[1],   pw1[2] = PKW(P0, 12), pw1[3] = PKW(P0, 14), pw1); \
    VRD(2); SBAR(); GAPA(C1 = mfq(kf[1], qr, negm), P1[2], P1[3], P1[4], P1[5],     pw2[0] = PKW(P1, 0), pw2[1] = PKW(P1, 2), pw2); \
    VRD(6); SBAR(); GAPA((void)0, P1[6], P1[7], P1[8], P1[9],     pw2[2] = PKW(P1, 4), pw2[3] = PKW(P1, 6), pw2); \
    VRD(3); SBAR(); GAPA((void)0, P1[10], P1[11], P1[12], P1[13], pw3[0] = PKW(P1, 8), pw3[1] = PKW(P1, 10), pw3); \
    VRD(7); SBAR(); GAPA((void)0, P1[14], P1[15], 0.f, 0.f,       pw3[2] = PKW(P1, 12), pw3[3] = PKW(P1, 14), pw3); \
    l_reg += sacc; \
    if (GK) { DMA_K((t) + 3, sl_cur); } if (GV) { DMA_V((t) + 1, sl_next); } \
    if constexpr (!NOMAX) { float a = MX3(C0[0], C0[1], C1[0]), b = MX3(C0[2], C0[3], C1[1]); a = MX3(a, C1[2], C1[3]); \
      _Pragma("unroll") for (int r = 4; r < 16; r += 4) { a = MX3(a, C0[r], C0[r + 1]); b = MX3(b, C0[r + 2], C0[r + 3]); a = MX3(a, C1[r], C1[r + 1]); b = MX3(b, C1[r + 2], C1[r + 3]); } \
      float rm = __builtin_fmaxf(a, b); { auto rr = __builtin_amdgcn_permlane32_swap(__float_as_uint(rm), __float_as_uint(rm), false, false); rm = __builtin_fmaxf(__uint_as_float(rr[0]), __uint_as_float(rr[1])); } \
      resc = false; \
      if (__builtin_expect(__any(rm > (float)THRL), 0)) { const float dl = __builtin_fmaxf(rm, 0.f); mhat += dl; \
        _Pragma("unroll") for (int r = 0; r < 16; ++r) { C0[r] -= dl; C1[r] -= dl; } \
        _Pragma("unroll") for (int r = 0; r < 16; ++r) negm[r] = -mhat; asm volatile("" : "+v"(negm)); \
        const float f = __builtin_amdgcn_exp2f(-dl); l_reg *= f; if (hi == 0) wsf[r32] = f; resc = true; } } \
    SBAR(); \
    GAPB(o[0] = __builtin_amdgcn_mfma_f32_32x32x16_bf16(PAF(0), VFR(0), o[0], 0, 0, 0), C0, 0); \
    GAPB(o[1] = __builtin_amdgcn_mfma_f32_32x32x16_bf16(PAF(0), VFR(4), o[1], 0, 0, 0), C0, 4); \
    KRD(GL, 0); GAPB(o[0] = __builtin_amdgcn_mfma_f32_32x32x16_bf16(PAF(1), VFR(1), o[0], 0, 0, 0), C0, 8); \
    GAPB(o[1] = __builtin_amdgcn_mfma_f32_32x32x16_bf16(PAF(1), VFR(5), o[1], 0, 0, 0), C0, 12); \
    KRD(GL, 1); GAPB(o[0] = __builtin_amdgcn_mfma_f32_32x32x16_bf16(PAF(2), VFR(2), o[0], 0, 0, 0), C1, 0); \
    GAPB(o[1] = __builtin_amdgcn_mfma_f32_32x32x16_bf16(PAF(2), VFR(6), o[1], 0, 0, 0), C1, 4); \
    GAPB(o[0] = __builtin_amdgcn_mfma_f32_32x32x16_bf16(PAF(3), VFR(3), o[0], 0, 0, 0), C1, 8); \
    GAPB(o[1] = __builtin_amdgcn_mfma_f32_32x32x16_bf16(PAF(3), VFR(7), o[1], 0, 0, 0), C1, 12); \
    } while (0)
    int t = 1;
    for (; t + 5 < NT; t += 2) {
        STEP(pB0, pB1, pA0, pA1, t, true, true, true);     WAIT_BAR(2); RESC(); ROT();
        STEP(pA0, pA1, pB0, pB1, t + 1, true, true, true); WAIT_BAR(2); RESC(); ROT();
    }
#define ENDW(tt) do { if ((tt) + 3 < NT) { WAIT_BAR(2); } else if ((tt) + 2 < NT) { WAIT_BAR(1); } else { WAIT_BAR(0); } } while (0)
    for (; t + 1 < NT; t += 2) {
        STEP(pB0, pB1, pA0, pA1, t, (t + 3 < NT), (t + 1 < NT), (t + 1 < NT));         ENDW(t);     RESC(); ROT();
        STEP(pA0, pA1, pB0, pB1, t + 1, (t + 4 < NT), (t + 2 < NT), (t + 2 < NT));     ENDW(t + 1); RESC(); ROT();
    }
    STEP(pB0, pB1, pA0, pA1, NT - 1, false, false, false); RESC();
    { float sacc = pB0[0] + pB0[1]; _Pragma("unroll") for (int r = 2; r < 16; ++r) sacc += pB0[r]; _Pragma("unroll") for (int r = 0; r < 16; ++r) sacc += pB1[r]; l_reg += sacc;
      pw0 = (u32x4){PKW(pB0, 0), PKW(pB0, 2), PKW(pB0, 4), PKW(pB0, 6)}; pw1 = (u32x4){PKW(pB0, 8), PKW(pB0, 10), PKW(pB0, 12), PKW(pB0, 14)}; pw2 = (u32x4){PKW(pB1, 0), PKW(pB1, 2), PKW(pB1, 4), PKW(pB1, 6)}; pw3 = (u32x4){PKW(pB1, 8), PKW(pB1, 10), PKW(pB1, 12), PKW(pB1, 14)};
      SBAR(); pv(o, vb0 + sl_cur, PAF(0), PAF(1), PAF(2), PAF(3)); }
#undef PKW
#undef PAF
#undef VFR
#undef PIN
#undef MX3
#undef GAPA
#undef GAPB
#undef EX
#undef VRD
#undef KRD
#undef STEP
#undef ENDW
    { auto rr = __builtin_amdgcn_permlane32_swap(__float_as_uint(l_reg), __float_as_uint(l_reg), false, false); l_reg = __uint_as_float(rr[0]) + __uint_as_float(rr[1]); }
    if (hi == 0) wsf[32 + r32] = l_reg; asm volatile("s_waitcnt lgkmcnt(0)" ::: "memory");
    float rli[16];
#pragma unroll
    for (int r = 0; r < 16; ++r) rli[r] = __builtin_amdgcn_rcpf(wsf[32 + crow(r, hi)]);
    unsigned char* Ow = Ou + (long)(wid * QBLK) * OP;
    { bf16* stg = (bf16*)(shm + LDS_OST) + wid * 2048;
#pragma unroll
      for (int r = 0; r < 16; ++r) { const int orow = crow(r, hi);
#pragma unroll
          for (int d0 = 0; d0 < 2; ++d0) stg[orow * 64 + d0 * 32 + r32] = f2bf(o[d0][r] * rli[r]); }
      asm volatile("s_waitcnt lgkmcnt(0)" ::: "memory");
      const int ch = lane & 7;
#pragma unroll
      for (int i = 0; i < 4; ++i) { const int row = i * 8 + (lane >> 3); const u32x4 v = *(const u32x4*)(stg + row * 64 + ch * 8);
          float x[8] = {bflo(v.x), bfhi(v.x), bflo(v.y), bfhi(v.y), bflo(v.z), bfhi(v.z), bflo(v.w), bfhi(v.w)};
          float ss = 0.f;
#pragma unroll
          for (int k = 0; k < 8; ++k) ss += x[k] * x[k];
          ss = sum_oct(ss);
          const float rs = __builtin_amdgcn_rsqf(ss * (1.0f / 64.0f) + EPS);
          const float rq = rs * YS; u32x2 w; w.x = pk_i8x4(x[0] * rq, x[1] * rq, x[2] * rq, x[3] * rq); w.y = pk_i8x4(x[4] * rq, x[5] * rq, x[6] * rq, x[7] * rq);
          *(u32x2*)(Ow + (long)row * OP + ch * 8) = w; } }
    asm volatile("s_waitcnt lgkmcnt(0)\n\ts_barrier" ::: "memory");
#undef DMA_K
#undef DMA_V
#undef START
#undef RESC
#undef ROT
}
#undef SBAR
#undef WAIT_BAR
}

namespace mlstm {
constexpr int P2 = 144;
constexpr int TILE = 64 * P2;
constexpr int O_Q = 0, O_K = TILE, O_KT = 2 * TILE, O_VT = 3 * TILE, O_P = 4 * TILE, O_CT = 5 * TILE  , O_N = 7 * TILE  , O_SC = O_N + 512  , DIRB = O_SC + 2048;
static_assert(2 * DIRB <= SCR_BYTES, "mLSTM LDS");
struct Args { const bf16 *MQ, *MK, *MV, *MO; const float* MG; float* HFB; bf16* Y; const float* mixn; };
DI int chunk_mc(int dir, int j) { return dir == 0 ? j : (j < 4 ? 3 - j : 71 - j); }
DI int tok_row(int b, int p) { return p < TC ? b * TC + p : NCTX + b * T + (p - TC); }
DI void item(LAS unsigned char* lds, const Args& a, int b, int h) {
    const int tid = opaque_tid(), wid = __builtin_amdgcn_readfirstlane(tid >> 6), lane = tid & 63, fr = lane & 15, fq = lane >> 4;
    const int dir = wid >> 2, w4 = wid & 3;
    LAS unsigned char* L = lds + dir * DIRB;
    LAS float* sa = (LAS float*)(L + O_SC + w4 * 512); LAS float* sg = sa + 64;
    for (int i = (tid & 255); i < TILE / 4; i += 256) ((LAS unsigned*)(L + O_CT))[i] = 0u;
    if ((tid & 255) < 64) ((LAS float*)(L + O_N))[tid & 255] = 0.f;
    f32x4 Cacc[4];
#pragma unroll
    for (int c = 0; c < 4; ++c) Cacc[c] = (f32x4){0.f, 0.f, 0.f, 0.f};
    float n_reg = 0.f, m_prev = 0.f;
    const GAS bf16* gMQ = (const GAS bf16*)a.MQ; const GAS bf16* gMK = (const GAS bf16*)a.MK; const GAS bf16* gMV = (const GAS bf16*)a.MV; const GAS float* gMG = (const GAS float*)a.MG;
    GAS float* HF = (GAS float*)a.HFB + ((size_t)((b * 4 + h) * 2 + dir)) * TKV * 64;
    u32x4 qA[2], kA[2], vA[2]; float li, lf;
    const unsigned psel = (lane & 1) ? 0x07060302u : 0x01000504u; const int tb = (lane & 1) ? (P2 + 2 * (lane - 1)) : 2 * lane;
#define MLOAD(j) do { const int mc_ = chunk_mc(dir, (j)); const int p_ = 64 * mc_ + (dir == 0 ? lane : 63 - lane); const size_t row_ = (size_t)tok_row(b, p_); \
        li = gMG[row_ * 16 + dir * 8 + h]; lf = gMG[row_ * 16 + dir * 8 + 4 + h]; \
        _Pragma("unroll") for (int m_ = 0; m_ < 2; ++m_) { const int tr_ = 16 * w4 + 8 * m_ + (lane >> 3); const size_t o_ = (size_t)tok_row(b, 64 * mc_ + (dir == 0 ? tr_ : 63 - tr_)) * 256 + h * 64 + 8 * (lane & 7); \
            qA[m_] = *(const GAS u32x4*)(gMQ + o_); kA[m_] = *(const GAS u32x4*)(gMK + o_); vA[m_] = *(const GAS u32x4*)(gMV + o_); } } while (0)
    MLOAD(0);
    __syncthreads();
    for (int j = 0; j < 68; ++j) {
        const int cb = j & 1;
        const float bcs = scan_sum64(lf);
        const float av = li - bcs;
        const float pmx = scan_max64(av);
        const float gv = fmaxf(m_prev, pmx);
        const float G63 = __builtin_bit_cast(float, __builtin_amdgcn_readlane(__builtin_bit_cast(int, gv), 63)), bend = __builtin_bit_cast(float, __builtin_amdgcn_readlane(__builtin_bit_cast(int, bcs), 63));
        const float wsv = __expf(av - G63), w_prev = __expf(m_prev - G63);
        const float w_int = __expf(m_prev - gv), emt = __expf(-(bcs + gv));
#pragma unroll
        for (int m = 0; m < 2; ++m) { const int tr = 16 * w4 + 8 * m + (lane >> 3), po = tr * P2 + 16 * (lane & 7);
            *(LAS u32x4*)(L + O_Q + po) = qA[m]; *(LAS u32x4*)(L + O_K + po) = kA[m]; *(LAS u32x4*)(L + O_P + po) = vA[m]; }
        if (j + 1 < 68) MLOAD(j + 1);
        __syncthreads();
        const u32x4 k0 = *(const LAS u32x4*)(L + O_K + lane * P2 + 16 * w4), k1 = *(const LAS u32x4*)(L + O_K + lane * P2 + 16 * w4 + 64), v0 = *(const LAS u32x4*)(L + O_P + lane * P2 + 16 * w4), v1 = *(const LAS u32x4*)(L + O_P + lane * P2 + 16 * w4 + 64);
        {
            const unsigned kw[8] = {k0.x, k0.y, k0.z, k0.w, k1.x, k1.y, k1.z, k1.w}, vw[8] = {v0.x, v0.y, v0.z, v0.w, v1.x, v1.y, v1.z, v1.w};
#pragma unroll
            for (int pp = 0; pp < 2; ++pp)
#pragma unroll
                for (int i = 0; i < 4; ++i) { const int d = 8 * w4 + 32 * pp + 2 * i;
                    const unsigned kk = pk2(bflo(kw[pp * 4 + i]) * wsv, bfhi(kw[pp * 4 + i]) * wsv), vv = vw[pp * 4 + i];
                    const unsigned kn = (unsigned)dpp_i<0xB1>((int)kk), vn = (unsigned)dpp_i<0xB1>((int)vv);
                    *(LAS unsigned*)(L + O_KT + d * P2 + tb) = __builtin_amdgcn_perm(kk, kn, psel); *(LAS unsigned*)(L + O_VT + d * P2 + tb) = __builtin_amdgcn_perm(vv, vn, psel); }
        }
        sa[lane] = av; sg[lane] = gv;
        __syncthreads();
        bf16x8 qf[2];
#pragma unroll
        for (int ks = 0; ks < 2; ++ks) qf[ks] = *(const LAS bf16x8*)(L + O_Q + (16 * w4 + fr) * P2 + (32 * ks + 8 * fq) * 2);
        const int tt = 16 * w4 + fr;
        const float g_t = sg[tt];
        float rsum = 0.f;
#pragma unroll
        for (int c = 0; c < 4; ++c) {
            f32x4 s = (f32x4){0.f, 0.f, 0.f, 0.f};
#pragma unroll
            for (int ks = 0; ks < 2; ++ks) { const bf16x8 kf = *(const LAS bf16x8*)(L + O_K + (16 * c + fr) * P2 + (32 * ks + 8 * fq) * 2); s = __builtin_amdgcn_mfma_f32_16x16x32_bf16(kf, qf[ks], s, 0, 0, 0); }
            const f32x4 as4 = *(const LAS f32x4*)(sa + 16 * c + 4 * fq);
            float p[4];
#pragma unroll
            for (int i = 0; i < 4; ++i) { const int ss = 16 * c + 4 * fq + i; p[i] = (ss <= tt) ? s[i] * __expf(as4[i] - g_t) : 0.f; rsum += p[i]; }
            u32x2 pw; pw.x = pk2(p[0], p[1]); pw.y = pk2(p[2], p[3]);
            *(LAS u32x2*)(L + O_P + tt * P2 + (16 * c + 4 * fq) * 2) = pw;
        }
        rsum = sum_x16x32(rsum);
        float qn = 0.f;
        { const u32x4 qa = *(const LAS u32x4*)(L + O_Q + tt * P2 + (16 * fq) * 2), qb = *(const LAS u32x4*)(L + O_Q + tt * P2 + (16 * fq + 8) * 2);
          const LAS float* nv = (const LAS float*)(L + O_N + cb * 256) + 16 * fq;
          const f32x4 n0 = *(const LAS f32x4*)(nv), n1 = *(const LAS f32x4*)(nv + 4), n2 = *(const LAS f32x4*)(nv + 8), n3 = *(const LAS f32x4*)(nv + 12);
          qn = bflo(qa.x) * n0[0] + bfhi(qa.x) * n0[1] + bflo(qa.y) * n0[2] + bfhi(qa.y) * n0[3] + bflo(qa.z) * n1[0] + bfhi(qa.z) * n1[1] + bflo(qa.w) * n1[2] + bfhi(qa.w) * n1[3]
             + bflo(qb.x) * n2[0] + bfhi(qb.x) * n2[1] + bflo(qb.y) * n2[2] + bfhi(qb.y) * n2[3] + bflo(qb.z) * n3[0] + bfhi(qb.z) * n3[1] + bflo(qb.w) * n3[2] + bfhi(qb.w) * n3[3];
          qn = sum_x16x32(qn); }
        const float wi_t = __shfl(w_int, tt), em_t = __shfl(emt, tt);
        const float den = rsum + wi_t * qn;
        const float rden = 1.0f / fmaxf(fabsf(den), em_t);
        LDS_WAIT();
        bf16x8 pf[2];
#pragma unroll
        for (int ks = 0; ks < 2; ++ks) pf[ks] = *(const LAS bf16x8*)(L + O_P + tt * P2 + (32 * ks + 8 * fq) * 2);
        const int pos = 64 * chunk_mc(dir, j) + (dir == 0 ? tt : 63 - tt);
#pragma unroll
        for (int c = 0; c < 4; ++c) {
            f32x4 qc = (f32x4){0.f, 0.f, 0.f, 0.f}, pvv = (f32x4){0.f, 0.f, 0.f, 0.f};
#pragma unroll
            for (int ks = 0; ks < 2; ++ks) { const bf16x8 cf = *(const LAS bf16x8*)(L + O_CT + cb * TILE + (16 * c + fr) * P2 + (32 * ks + 8 * fq) * 2); qc = __builtin_amdgcn_mfma_f32_16x16x32_bf16(cf, qf[ks], qc, 0, 0, 0);
                const bf16x8 vf = *(const LAS bf16x8*)(L + O_VT + (16 * c + fr) * P2 + (32 * ks + 8 * fq) * 2); pvv = __builtin_amdgcn_mfma_f32_16x16x32_bf16(vf, pf[ks], pvv, 0, 0, 0); }
            const f32x4 hv = (pvv + qc * wi_t) * rden;
            *(GAS f32x4*)(HF + (size_t)pos * 64 + 16 * c + 4 * fq) = hv;
        }
        { bf16x8 vf[2];
#pragma unroll
          for (int ks = 0; ks < 2; ++ks) vf[ks] = *(const LAS bf16x8*)(L + O_VT + (16 * w4 + fr) * P2 + (32 * ks + 8 * fq) * 2);
#pragma unroll
          for (int c = 0; c < 4; ++c) { Cacc[c] = Cacc[c] * w_prev;
#pragma unroll
              for (int ks = 0; ks < 2; ++ks) { const bf16x8 kt = *(const LAS bf16x8*)(L + O_KT + (16 * c + fr) * P2 + (32 * ks + 8 * fq) * 2); Cacc[c] = __builtin_amdgcn_mfma_f32_16x16x32_bf16(kt, vf[ks], Cacc[c], 0, 0, 0); }
              u32x2 cw; cw.x = pk2(Cacc[c][0], Cacc[c][1]); cw.y = pk2(Cacc[c][2], Cacc[c][3]);
              *(LAS u32x2*)(L + O_CT + (cb ^ 1) * TILE + (16 * w4 + fr) * P2 + (16 * c + 4 * fq) * 2) = cw; }
          const u32x4 ka = *(const LAS u32x4*)(L + O_KT + (16 * w4 + fr) * P2 + (16 * fq) * 2), kb = *(const LAS u32x4*)(L + O_KT + (16 * w4 + fr) * P2 + (16 * fq + 8) * 2);
          float ksum = ((bflo(ka.x) + bfhi(ka.x)) + (bflo(ka.y) + bfhi(ka.y))) + ((bflo(ka.z) + bfhi(ka.z)) + (bflo(ka.w) + bfhi(ka.w)))
                     + ((bflo(kb.x) + bfhi(kb.x)) + (bflo(kb.y) + bfhi(kb.y))) + ((bflo(kb.z) + bfhi(kb.z)) + (bflo(kb.w) + bfhi(kb.w)));
          ksum = sum_x16x32(ksum);
          n_reg = w_prev * n_reg + ksum;
          if (fq == 0) ((LAS float*)(L + O_N + (cb ^ 1) * 256))[16 * w4 + fr] = n_reg; }
        m_prev = bend + G63;
        __syncthreads();
    }
#undef MLOAD
    VM_WAIT(); __threadfence_block(); __syncthreads();
    const GAS float* HF0 = (const GAS float*)a.HFB + ((size_t)((b * 4 + h) * 2)) * TKV * 64; const GAS float* HF1 = HF0 + (size_t)TKV * 64; const GAS bf16* gMO = (const GAS bf16*)a.MO; GAS unsigned char* gY = (GAS unsigned char*)a.Y;
    const int ch = tid & 7;
    for (int it0 = 0; it0 < TKV * 8 / 512; it0 += 4) {
        f32x4 a0[4], a1[4], b0[4], b1[4]; u32x4 ov[4];
#pragma unroll
        for (int u = 0; u < 4; ++u) { const int p = ((it0 + u) * 512 + tid) >> 3; const size_t row = (size_t)tok_row(b, p);
            a0[u] = *(const GAS f32x4*)(HF0 + (size_t)p * 64 + ch * 8); a1[u] = *(const GAS f32x4*)(HF0 + (size_t)p * 64 + ch * 8 + 4); b0[u] = *(const GAS f32x4*)(HF1 + (size_t)p * 64 + ch * 8); b1[u] = *(const GAS f32x4*)(HF1 + (size_t)p * 64 + ch * 8 + 4);
            ov[u] = *(const GAS u32x4*)(gMO + row * 256 + h * 64 + ch * 8); }
#pragma unroll
        for (int u = 0; u < 4; ++u) { const int p = ((it0 + u) * 512 + tid) >> 3; const size_t row = (size_t)tok_row(b, p);
            float y[8] = {bflo(ov[u].x) * (a0[u][0] + b0[u][0]), bfhi(ov[u].x) * (a0[u][1] + b0[u][1]), bflo(ov[u].y) * (a0[u][2] + b0[u][2]), bfhi(ov[u].y) * (a0[u][3] + b0[u][3]),
                          bflo(ov[u].z) * (a1[u][0] + b1[u][0]), bfhi(ov[u].z) * (a1[u][1] + b1[u][1]), bflo(ov[u].w) * (a1[u][2] + b1[u][2]), bfhi(ov[u].w) * (a1[u][3] + b1[u][3])};
            float ss = 0.f;
#pragma unroll
            for (int k = 0; k < 8; ++k) ss += y[k] * y[k];
            ss = sum_oct(ss);
            const float rs = __builtin_amdgcn_rsqf(ss * (1.0f / 64.0f) + EPS);
            const float rq = rs * YS; u32x2 w; w.x = pk_i8x4(y[0] * rq, y[1] * rq, y[2] * rq, y[3] * rq); w.y = pk_i8x4(y[4] * rq, y[5] * rq, y[6] * rq, y[7] * rq);
            *(GAS u32x2*)(gY + row * D + h * 64 + ch * 8) = w; }
    }
    __syncthreads();
}
}

namespace gmlp {
constexpr int VP = 272;
struct Args { const bf16* GU; const bf16* GV; const bf16* W; const float* gb; const float* gnorm; const float* mixn; bf16* Y; };
DI void item(LAS unsigned char* lds, const Args& a, size_t row0) {
    const int tid = opaque_tid(), wid = __builtin_amdgcn_readfirstlane(tid >> 6), lane = tid & 63, fr = lane & 15, fq = lane >> 4;
    { const int p = tid >> 2, part = tid & 3;
      const bf16* src = a.GV + (row0 + p) * 256 + 64 * part;
      u32x4 v[8]; float ss = 0.f;
#pragma unroll
      for (int i = 0; i < 8; ++i) { v[i] = *(const u32x4*)(src + 8 * i);
          ss += bflo(v[i].x) * bflo(v[i].x) + bfhi(v[i].x) * bfhi(v[i].x) + bflo(v[i].y) * bflo(v[i].y) + bfhi(v[i].y) * bfhi(v[i].y)
              + bflo(v[i].z) * bflo(v[i].z) + bfhi(v[i].z) * bfhi(v[i].z) + bflo(v[i].w) * bflo(v[i].w) + bfhi(v[i].w) * bfhi(v[i].w); }
      ss = sum_quad(ss);
      const float rs = __builtin_amdgcn_rsqf(ss * (1.0f / 256.0f) + EPS);
#pragma unroll
      for (int i = 0; i < 8; ++i) { const unsigned w[4] = {v[i].x, v[i].y, v[i].z, v[i].w};
#pragma unroll
          for (int k = 0; k < 4; ++k) { const int ch = 64 * part + 8 * i + 2 * k;
              const unsigned o = pk2(bflo(w[k]) * rs * a.gnorm[ch], bfhi(w[k]) * rs * a.gnorm[ch + 1]);
              *(LAS bf16*)(lds + ch * VP + 2 * p) = (bf16)(o & 0xffffu); *(LAS bf16*)(lds + (ch + 1) * VP + 2 * p) = (bf16)(o >> 16); } }
    }
    __syncthreads();
    const size_t row = row0 + 16 * wid + fr;
#pragma unroll 1
    for (int g = 0; g < 4; ++g) {
        bf16x8 wf[4];
#pragma unroll
        for (int ks = 0; ks < 4; ++ks) wf[ks] = *(const bf16x8*)(a.W + ((size_t)(g * 128 + 16 * wid + fr)) * 128 + 32 * ks + 8 * fq);
        const float bias = a.gb[g * 128 + 16 * wid + fr];
        f32x4 y[4]; float ss = 0.f;
#pragma unroll
        for (int ct = 0; ct < 4; ++ct) {
            f32x4 acc = (f32x4){0.f, 0.f, 0.f, 0.f};
#pragma unroll
            for (int ks = 0; ks < 4; ++ks) { const bf16x8 vf = *(const LAS bf16x8*)(lds + (64 * g + 16 * ct + fr) * VP + (32 * ks + 8 * fq) * 2); acc = __builtin_amdgcn_mfma_f32_16x16x32_bf16(vf, wf[ks], acc, 0, 0, 0); }
            const u32x2 uu = *(const u32x2*)(a.GU + row * 256 + 64 * g + 16 * ct + 4 * fq);
            y[ct][0] = bflo(uu.x) * (acc[0] + bias); y[ct][1] = bfhi(uu.x) * (acc[1] + bias); y[ct][2] = bflo(uu.y) * (acc[2] + bias); y[ct][3] = bfhi(uu.y) * (acc[3] + bias);
            ss += (y[ct][0] * y[ct][0] + y[ct][1] * y[ct][1]) + (y[ct][2] * y[ct][2] + y[ct][3] * y[ct][3]);
        }
        ss = sum_x16x32(ss);
        const float rs = __builtin_amdgcn_rsqf(ss * (1.0f / 64.0f) + EPS);
#pragma unroll
        for (int ct = 0; ct < 4; ++ct) { const float rq = rs * YS;
            *(unsigned*)((unsigned char*)a.Y + row * D + 256 + 64 * g + 16 * ct + 4 * fq) = pk_i8x4(y[ct][0] * rq, y[ct][1] * rq, y[ct][2] * rq, y[ct][3] * rq); }
    }
    __syncthreads();
}
}

DI int phys_head(int l) { return 128 * ((l >> 5) & 1) + 32 * (l >> 6) + 16 * ((l >> 2) & 1) + 4 * ((l >> 3) & 3) + (l & 3); }
DI int phys_glu(int c) { return 128 * ((c >> 3) & 1) + 32 * (c >> 6) + 16 * (c & 1) + 4 * ((c >> 4) & 3) + ((c >> 1) & 3); }
DI void tr_item_f8(const float* W, size_t ldw, int k0, size_t c0, unsigned char* WT8tile, int l0, LAS bf16* scr, int lane) {
    { const int kr = lane >> 4, c4 = lane & 15; const GAS float* Wg = (const GAS float*)W;
#pragma unroll 8
      for (int it = 0; it < 16; ++it) { const int kk = 4 * it + kr; const f32x4 v = *(const GAS f32x4*)(Wg + (size_t)(k0 + kk) * ldw + c0 + 4 * c4) * 64.0f;
          *(LAS unsigned*)(scr + kk * 66 + 4 * c4) = pk2(v[0], v[1]); *(LAS unsigned*)(scr + kk * 66 + 4 * c4 + 2) = pk2(v[2], v[3]); } }
    LDS_WAIT(); asm volatile("" ::: "memory");
    const int c = lane & 7;
#pragma unroll
    for (int jj = 0; jj < 8; ++jj) { const int o = (lane >> 3) + 8 * jj; const LAS bf16* s = scr + (8 * c) * 66 + o;
        u32x2 w; w.x = pk_fp8x4(bf2f(s[0]), bf2f(s[66]), bf2f(s[2 * 66]), bf2f(s[3 * 66])); w.y = pk_fp8x4(bf2f(s[4 * 66]), bf2f(s[5 * 66]), bf2f(s[6 * 66]), bf2f(s[7 * 66]));
        *(GAS u32x2*)((GAS unsigned char*)WT8tile + (size_t)phys_head(l0 + o) * 1024 + k0 + 8 * c) = w; }
    LDS_WAIT(); asm volatile("" ::: "memory");
}
DI void tr_item(const float* W, size_t ldw, int k0, size_t c0, bf16* WTtile, int l0, bool glu, LAS bf16* scr, int lane) {
#pragma unroll 8
    for (int kk = 0; kk < 64; ++kk) scr[kk * 66 + lane] = f2bf(W[(size_t)(k0 + kk) * ldw + c0 + lane]);
    LDS_WAIT(); asm volatile("" ::: "memory");
    const int c = lane & 7;
#pragma unroll
    for (int jj = 0; jj < 8; ++jj) { const int o = (lane >> 3) + 8 * jj; const LAS bf16* s = scr + (8 * c) * 66 + o;
        u32x4 w; w.x = (unsigned)s[0] | ((unsigned)s[66] << 16); w.y = (unsigned)s[2 * 66] | ((unsigned)s[3 * 66] << 16); w.z = (unsigned)s[4 * 66] | ((unsigned)s[5 * 66] << 16); w.w = (unsigned)s[6 * 66] | ((unsigned)s[7 * 66] << 16);
        const int pr = glu ? phys_glu(l0 + o) : phys_head(l0 + o);
        *(u32x4*)(WTtile + (size_t)pr * D + k0 + 8 * c) = w; }
    LDS_WAIT(); asm volatile("" ::: "memory");
}
DI void gu_item_i8(LAS unsigned char* lds, const float* W, size_t ldw, size_t c0, int cbk, bool glu, signed char* W8, float* CS, int tid, int wid, int lane, const float* rg = nullptr) {
    LAS bf16* scr = (LAS bf16*)lds; LAS float* cmx = (LAS float*)(lds + LDSCTL_OFF + 1024);
    { const int kr = lane >> 4, c4 = lane & 15; const GAS float* Wg = (const GAS float*)W;
      f32x4 mx = (f32x4){0.f, 0.f, 0.f, 0.f};
#pragma unroll 8
      for (int it = 0; it < 32; ++it) { const int k = 128 * wid + 4 * it + kr; f32x4 v = *(const GAS f32x4*)(Wg + (size_t)k * ldw + c0 + 4 * c4); if (rg) v = v * rg[k];
          mx[0] = fmaxf(mx[0], fabsf(v[0])); mx[1] = fmaxf(mx[1], fabsf(v[1])); mx[2] = fmaxf(mx[2], fabsf(v[2])); mx[3] = fmaxf(mx[3], fabsf(v[3]));
          *(LAS unsigned*)(scr + k * 66 + 4 * c4) = pk2(v[0], v[1]); *(LAS unsigned*)(scr + k * 66 + 4 * c4 + 2) = pk2(v[2], v[3]); }
#pragma unroll
      for (int j = 0; j < 4; ++j) mx[j] = max_x16x32(mx[j]);
      if (kr == 0) *(LAS f32x4*)(cmx + wid * 64 + 4 * c4) = mx; }
    __syncthreads();
    if (tid < 64) { float m = cmx[tid];
#pragma unroll
        for (int w = 1; w < 8; ++w) m = fmaxf(m, cmx[w * 64 + tid]);
        m = fmaxf(m, 1e-30f); cmx[512 + tid] = m; CS[(cbk >> 2) * 256 + (glu ? phys_glu((cbk & 3) * 64 + tid) : phys_head((cbk & 3) * 64 + tid))] = m * (1.0f / 127.0f); }
    __syncthreads();
#pragma unroll 2
    for (int it = 0; it < 8; ++it) { const int r = (it * 512 + tid) >> 6, o = 16 * (r & 3) + ((tid >> 2) & 15), kc = 4 * (r >> 2) + (tid & 3);
        const float qs = 127.0f / cmx[512 + o]; const LAS bf16* sp = scr + (16 * kc) * 66 + o;
        unsigned w[4];
#pragma unroll
        for (int g = 0; g < 4; ++g) { unsigned acc = 0;
#pragma unroll
            for (int i = 0; i < 4; ++i) { int q = (int)rintf(bf2f(sp[(4 * g + i) * 66]) * qs); q = q > 127 ? 127 : (q < -127 ? -127 : q); acc |= (unsigned)(q & 255) << (8 * i); }
            w[g] = acc; }
        *(GAS u32x4*)((GAS signed char*)W8 + ((size_t)((cbk >> 2) * 256 + (glu ? phys_glu((cbk & 3) * 64 + o) : phys_head((cbk & 3) * 64 + o)))) * 1024 + 16 * kc) = (u32x4){w[0], w[1], w[2], w[3]}; }
    __syncthreads();
}
DI void prologue(LAS unsigned char* lds, unsigned char* ws) {
    const KArgP ka = kargs();
#define in (ka->in)
    const int tid = opaque_tid(), wid = __builtin_amdgcn_readfirstlane(tid >> 6), lane = tid & 63;
    const int G = gridDim.x, B = opaque_bid();
    float* MOD = (float*)(ws + WS_MOD);
    if (B < 192) {
        LAS float* sl = (LAS float*)lds;
        LAS float* red = (LAS float*)(lds + 17 * 1024 * 4);
        for (int i = tid; i < 17 * 1024; i += 512) { const int r = i >> 10, k = i & 1023; const float v = r < 16 ? in.c[r * 1024 + k] : in.c_ctx[k]; sl[i] = v / (1.0f + __expf(-v)); }
        __syncthreads();
        for (int it = B; it < 192; it += G) {
            const int l = it / 48, cb = it % 48; const float* wp = in.w_ada + ((size_t)l * 1024 + 128 * wid) * 6144 + 128 * cb + 2 * lane;
            f32x2 acc[17];
#pragma unroll
            for (int r = 0; r < 17; ++r) acc[r] = (f32x2){0.f, 0.f};
#pragma unroll 4
            for (int k = 0; k < 128; ++k) { const f32x2 w = *(const f32x2*)(wp + (size_t)k * 6144);
#pragma unroll
                for (int r = 0; r < 17; ++r) { const float s = sl[r * 1024 + 128 * wid + k]; acc[r] = acc[r] + w * s; } }
            if (wid > 0) {
#pragma unroll
                for (int r = 0; r < 17; ++r) *(LAS f32x2*)(red + ((wid - 1) * 17 + r) * 128 + 2 * lane) = acc[r]; }
            __syncthreads();
            if (wid == 0) {
#pragma unroll
                for (int r = 0; r < 17; ++r) { f32x2 s = acc[r];
#pragma unroll
                    for (int w = 0; w < 7; ++w) s = s + *(const LAS f32x2*)(red + (w * 17 + r) * 128 + 2 * lane);
                    const f32x2 bb = *(const f32x2*)(in.b_ada + (size_t)l * 6144 + 128 * cb + 2 * lane);
                    *(f32x2*)(MOD + ((size_t)l * 17 + r) * 6144 + 128 * cb + 2 * lane) = s + bb; } }
            __syncthreads();
        }
    }
    __syncthreads();
    const size_t gt = (size_t)B * 512 + tid, gs = (size_t)G * 512;
    { float* rc = (float*)(ws + WS_ROPE); float* rs = rc + 65 * 16;
      if (gt < 16) { rc[64 * 16 + gt] = 1.0f; rs[64 * 16 + gt] = 0.0f; }
      for (size_t i = gt; i < (size_t)64 * 16; i += gs) { const int pos = (int)(i >> 4), k = (int)(i & 15); const float invf = powf(10000.0f, -(float)k / 16.0f);
          const float ang = (float)pos * invf; rc[i] = cosf(ang); rs[i] = sinf(ang); } }
    { bf16* WG = (bf16*)(ws + WS_WG);
      for (size_t i = gt; i < (size_t)DEPTH * 16 * 1024; i += gs) { const int l = (int)(i >> 14), n = (int)((i >> 10) & 15), k = (int)(i & 1023);
          const float v = in.w_in[((size_t)l * 1024 + k) * DIN + 1024 + n]; const bf16 hi = f2bf(v); WG[((size_t)(l * 2) * 16 + n) * 1024 + k] = hi; WG[((size_t)(l * 2 + 1) * 16 + n) * 1024 + k] = f2bf(v - bf2f(hi)); } }
    { bf16* WR = (bf16*)(ws + WS_WR);
      for (size_t i = gt; i < (size_t)DEPTH * 32 * 1024; i += gs) { const int l = (int)(i >> 15), n = (int)((i >> 10) & 31), k = (int)(i & 1023);
          const float v = in.router_w[((size_t)l * 1024 + k) * 32 + n]; const bf16 hi = f2bf(v); WR[((size_t)(l * 2) * 32 + n) * 1024 + k] = hi; WR[((size_t)(l * 2 + 1) * 32 + n) * 1024 + k] = f2bf(v - bf2f(hi)); } }
    { bf16* GW = (bf16*)(ws + WS_GWS);
      for (size_t i = gt; i < (size_t)DEPTH * 4 * 128 * 128; i += gs) GW[i] = f2bf(in.gmlp_ws[i]); }
    __syncthreads();
    for (int it = B; it < DEPTH * NE * 32; it += G) { const int le = it >> 5, cbk = it & 31;
        gu_item_i8(lds, in.w_gate_up + (size_t)le * 1024 * 2048, 2048, (size_t)cbk * 64, cbk, true, (signed char*)(ws + WS_WGU) + (size_t)le * 2048 * 1024, (float*)(ws + WS_CSGU) + (size_t)le * 2048, tid, wid, lane); }
    for (int it = B; it < DEPTH * 36; it += G) { const int l = it / 36, cbk = it % 36;
        gu_item_i8(lds, in.w_in + (size_t)l * 1024 * DIN, DIN, (size_t)cbk * 64 + (cbk >= 16 ? 16 : 0), cbk, false, (signed char*)(ws + WS_WIN) + (size_t)l * NPROJ * 1024, (float*)(ws + WS_CSIN) + (size_t)l * NPROJ, tid, wid, lane); }
    for (int it = B; it < DEPTH * 16; it += G) { const int l = it >> 4, cbk = it & 15;
        gu_item_i8(lds, in.w_out + (size_t)l * 1024 * 1024, 1024, (size_t)cbk * 64, cbk, false, (signed char*)(ws + WS_WOUT) + (size_t)l * 1024 * 1024, (float*)(ws + WS_CSOUT) + (size_t)l * 1024, tid, wid, lane, in.mix_norm + (size_t)l * 1024); }
    {
        LAS bf16* scr = (LAS bf16*)(lds + wid * (64 * 66 * 2));
        const int vcu = (G % 8 == 0) ? (B % 8) * (G / 8) + B / 8 : B;
        const long gw = (long)vcu * 8 + wid, NGW = (long)G * 8;
        constexpr long I_IN = 0, I_OUT = 0, I_GU = 0, I_DN = (long)DEPTH * NE * 16 * 16;
        for (long it = gw; it < I_IN + I_OUT + I_GU + I_DN; it += NGW) {
            long r = it;
            if (r < I_IN) { const int l = (int)(r / (36 * 16)), q = (int)(r % (36 * 16)), cbk = q >> 4, kb = q & 15;
                const size_t c0 = (size_t)cbk * 64 + (cbk >= 16 ? 16 : 0);
                tr_item(in.w_in + (size_t)l * 1024 * DIN, DIN, 64 * kb, c0, (bf16*)(ws + WS_WIN) + ((size_t)l * NPROJ + (size_t)(cbk >> 2) * 256) * D, (cbk & 3) * 64, false, scr, lane); continue; }
            r -= I_IN;
            if (r < I_OUT) { const int l = (int)(r >> 8), q = (int)(r & 255), cbk = q >> 4, kb = q & 15;
                tr_item_f8(in.w_out + (size_t)l * 1024 * 1024, 1024, 64 * kb, (size_t)cbk * 64, (unsigned char*)(ws + WS_WOUT) + ((size_t)l * 1024 + (size_t)(cbk >> 2) * 256) * D, (cbk & 3) * 64, scr, lane); continue; }
            r -= I_OUT;
            if (r < I_GU) { const int le = (int)(r >> 9), q = (int)(r & 511), cbk = q >> 4, kb = q & 15;
                tr_item(in.w_gate_up + (size_t)le * 1024 * 2048, 2048, 64 * kb, (size_t)cbk * 64, (bf16*)(ws + WS_WGU) + ((size_t)le * 2048 + (size_t)(cbk >> 2) * 256) * D, (cbk & 3) * 64, true, scr, lane); continue; }
            r -= I_GU;
            { const int le = (int)(r >> 8), q = (int)(r & 255), cbk = q >> 4, kb = q & 15;
                tr_item_f8(in.w_down + (size_t)le * 1024 * 1024, 1024, 64 * kb, (size_t)cbk * 64, (unsigned char*)(ws + WS_WDN) + ((size_t)le * 1024 + (size_t)(cbk >> 2) * 256) * D, (cbk & 3) * 64, scr, lane); }
        }
    }
    __syncthreads();
#undef in
}

DI void moe_convert_item(LAS unsigned char* lds, unsigned char* ws, int l, int it) {
    const int tid = opaque_tid(), wid = __builtin_amdgcn_readfirstlane(tid >> 6), lane = tid & 63;
    const KArgP ka = kargs();
    if (it < 1024) { const int le = l * NE + (it >> 5), cbk = it & 31;
        gu_item_i8(lds, (const float*)ka->in.w_gate_up + (size_t)le * 1024 * 2048, 2048, (size_t)cbk * 64, cbk, true, (signed char*)(ws + WS_WGU) + (size_t)le * 2048 * 1024, (float*)(ws + WS_CSGU) + (size_t)le * 2048, tid, wid, lane); }
    else { const int r = it - 1024, le = l * NE + (r >> 5), q = r & 31, cbk = q >> 1, kb = (q & 1) * 8 + wid;
        tr_item_f8((const float*)ka->in.w_down + (size_t)le * 1024 * 1024, 1024, 64 * kb, (size_t)cbk * 64, (unsigned char*)(ws + WS_WDN) + ((size_t)le * 1024 + (size_t)(cbk >> 2) * 256) * D, (cbk & 3) * 64, (LAS bf16*)(lds + wid * (64 * 66 * 2)), lane); }
}

constexpr int N_PHASES = 2 + 8 * DEPTH;
DI int q_next(unsigned* head, LAS int* bc) {
    if (opaque_tid() == 0) bc[0] = (int)__hip_atomic_fetch_add(head, 1u, RLX_AGENT);
    __syncthreads(); const int v = bc[0]; __syncthreads(); return v;
}
__global__ void __launch_bounds__(512, 2) mega_fwd(Args args) {
    extern __shared__ __attribute__((aligned(16))) unsigned char lds_raw[];
    LAS unsigned char* lds = (LAS unsigned char*)lds_raw;
    const int tid = threadIdx.x;
    volatile LAS unsigned* MISC = (volatile LAS unsigned*)(lds + LDSCTL_OFF);
    for (int u = tid; u < 64; u += 512) MISC[u] = 0u;
    __syncthreads();
    unsigned char* ws = kargs()->ws;
    unsigned* ctl = (unsigned*)(ws + WS_CTL);
    const int lo = kargs()->ph_lo, hi = kargs()->ph_hi;
    XcdBarrier bar; bar.bar = ctl + CW_BAR; bar.x = 0; bar.st = nullptr;
    if (hi - lo > 1) bar = xcd_barrier_post(ctl + CW_BAR, MISC + 8);
    LAS int* qbc = (LAS int*)(lds + LDSCTL_OFF + 128);
    const int G = gridDim.x;
#define IN(k) (lo <= (k) && (k) < hi)
#define SEAM(k) do { if (IN(k) && IN((k) + 1)) xcd_barrier(bar); } while (0)

#ifndef EN_MASK
#define EN_MASK 0xFFFF
#endif
#define EN(b) ((EN_MASK >> (b)) & 1)
#ifndef REP_MASK
#define REP_MASK 0
#endif
#ifndef DUP_MASK
#define DUP_MASK 0
#endif
#define NREP(b) (((REP_MASK >> (b)) & 1) ? 2 : 1)
    if (EN(0) && IN(0)) { for (int rep = 0; rep < NREP(0); ++rep) { prologue(lds, ws); SEAM(0); } }

    for (int l = 0; l < DEPTH; ++l) {
        const int pb = 1 + 8 * l;
        ws = opaque_ptr(ws);
        const float* modl = (const float*)(ws + WS_MOD) + (size_t)l * 17 * 6144;
        if (EN(1) && IN(pb)) {
            NormArgs a{}; const KArgP ka = kargs();
            a.xin = l == 0 ? nullptr : (const float*)(ws + WS_XLA + (size_t)((l - 1) & 1) * XL_BYTES); a.delta = l == 0 ? nullptr : (const bf16*)(ws + WS_H); a.dsc = (const float*)(ws + WS_DSC); a.x0 = ka->in.x; a.ctx0 = ka->in.ctx;
            a.mout = l == 0 ? nullptr : (const bf16*)(ws + WS_MOUT); a.msc = (const float*)(ws + WS_MSC); a.toks = (const int*)(ws + WS_TOKS); a.g2mod = modl - 17 * 6144;
            a.mod = modl; a.shi = 0; a.sci = 1; a.xout = (float*)(ws + WS_XLA + (size_t)(l & 1) * XL_BYTES); a.hout = nullptr; a.h8 = (signed char*)(ws + WS_H8); a.hs = (float*)(ws + WS_HS);
            a.wsm = (const bf16*)(ws + WS_WG) + (size_t)l * 2 * 16 * 1024; a.sbias = ka->in.b_in + (size_t)l * DIN + 1024; a.mg = (float*)(ws + WS_MG);
            for (int rep = 0; rep < NREP(1); ++rep) { norm_phase<0>(lds, a); SEAM(pb); }
        }
        if (EN(2) && IN(pb + 1)) {
            pg8::TileOrder S; S.init(NRT, NPROJ / 256, G, opaque_bid());
            SrcPlain8 src{(const char*)(ws + WS_WIN) + (size_t)l * NPROJ * D};
            { LAS float* rl_ = (LAS float*)(lds + ROPE_LDS_OFF); const float* rg_ = (const float*)(ws + WS_ROPE); const int t_ = opaque_tid();
              for (int i = t_; i < 2080; i += 512) rl_[i] = rg_[i];
              if (t_ < 128) rl_[2080 + t_] = (t_ < 64) ? kargs()->in.q_norm[l * 64 + t_] : kargs()->in.k_norm[l * 64 + t_ - 64];
              __syncthreads(); }
            EpiInProj E{ws, l, (const LAS float*)(lds + ROPE_LDS_OFF)};
            for (int rep = 0; rep < NREP(2); ++rep) { pg8::gemm_phase<EpiInProj, SrcPlain8, false, 1>(lds, (const bf16*)(ws + WS_H8), S, src, E); SEAM(pb + 1); }
        }
        if (IN(pb + 2)) {
            const float* mixn = kargs()->in.mix_norm + (size_t)l * D;
            if (EN(3)) for (int rep = 0; rep < NREP(3); ++rep) { mlstm::Args ma{(const bf16*)(ws + WS_MQ), (const bf16*)(ws + WS_MK), (const bf16*)(ws + WS_MV), (const bf16*)(ws + WS_MO), (const float*)(ws + WS_MG), (float*)(ws + WS_HFB), (bf16*)(ws + WS_Y), mixn};
              for (;;) { const int idx = q_next(ctl + CW_Q + 64 * ((rep * 4 + l) * 3 + 0), qbc); if (idx >= NB * 4) break; mlstm::item(lds, ma, idx >> 2, idx & 3); } }
            if (EN(4)) for (int rep = 0; rep < NREP(4); ++rep) { const int nlat = NB * 8 * 16, ntot = nlat + (l < DEPTH - 1 ? NB * 8 : 0);
              const unsigned char* AQ = (const unsigned char*)(ws + WS_AQ); const unsigned char* AK = (const unsigned char*)(ws + WS_AK); const bf16* AV = (const bf16*)(ws + WS_AV); unsigned char* Y = (unsigned char*)(ws + WS_Y);
              float gq = 0.f, gk = 0.f; { const int ln = opaque_tid() & 63; gq = fabsf(((const float*)kargs()->in.q_norm)[l * 64 + ln]); gk = fabsf(((const float*)kargs()->in.k_norm)[l * 64 + ln]); }
              const float sbound = 8.0f * wave_max(gq) * wave_max(gk) * 1.4426950408889634f * 1.13f;
#define ATT_LOOP(NM) for (;;) { const int idx = q_next(ctl + CW_Q + 64 * ((rep * 4 + l) * 3 + 1), qbc); if (idx >= ntot) break; \
                  int b, h, nt; size_t qrow; \
                  if (idx < nlat) { const int qb = idx & 15, hq = (idx >> 4) & 3, kvh = (idx >> 6) & 1; b = idx >> 7; h = kvh * 4 + hq; nt = TKV / 64; qrow = (size_t)NCTX + (size_t)b * T + (size_t)qb * 256; } \
                  else { const int i2 = idx - nlat; b = i2 >> 3; h = i2 & 7; nt = TC / 64; qrow = (size_t)b * TC; } \
                  const size_t kvo = (size_t)(b * 2 + (h >> 2)) * TKV * 64; \
                  attn_body::attn_unit<8, NM>(AQ + qrow * 512 + h * 64, AK + kvo, AV + kvo, nt, Y + qrow * D + 512 + h * 64, mixn + 512 + h * 64, (char*)lds_raw); }
              if (__builtin_amdgcn_readfirstlane(sbound < 100.0f ? 1 : 0)) { ATT_LOOP(true) } else { ATT_LOOP(false) }
#undef ATT_LOOP
              }
            if (EN(5)) for (int rep = 0; rep < NREP(5); ++rep) { gmlp::Args ga{(const bf16*)(ws + WS_GU), (const bf16*)(ws + WS_GV), (const bf16*)(ws + WS_GWS) + (size_t)l * 4 * 128 * 128, kargs()->in.gmlp_b + (size_t)l * 4 * 128, kargs()->in.gmlp_norm + (size_t)l * 256, mixn, (bf16*)(ws + WS_Y)};
              const int nlat = NB * 32, ntot = nlat + (l < DEPTH - 1 ? NB * 2 : 0);
              for (;;) { const int idx = q_next(ctl + CW_Q + 64 * ((rep * 4 + l) * 3 + 2), qbc); if (idx >= ntot) break;
                  const size_t row0 = idx < nlat ? (size_t)NCTX + (size_t)(idx >> 5) * T + (size_t)(idx & 31) * 128 : (size_t)((idx - nlat) >> 1) * TC + (size_t)((idx - nlat) & 1) * 128;
                  gmlp::item(lds, ga, row0); } }
            SEAM(pb + 2);
        }
        if (EN(6) && IN(pb + 3)) {
            pg8::TileOrder S; S.init(NRT, D / 256, G, opaque_bid());
            SrcPlain8 src{(const char*)(ws + WS_WOUT) + (size_t)l * D * D};
            EpiOutProj E{ws, l};
            for (int rep = 0; rep < NREP(6); ++rep) { pg8::gemm_phase<EpiOutProj, SrcPlain8, false, 1>(lds, (const bf16*)(ws + WS_Y), S, src, E); SEAM(pb + 3); }
        }
        if (EN(7) && IN(pb + 4)) {
            NormArgs a{};
            a.xin = (const float*)(ws + WS_XLA + (size_t)(l & 1) * XL_BYTES); a.delta = (const bf16*)(ws + WS_H); a.dsc = (const float*)(ws + WS_DSC); a.mout = nullptr; a.mod = modl; a.shi = 3; a.sci = 4; a.xout = nullptr; a.hout = nullptr; a.h8 = (signed char*)(ws + WS_H8); a.hs = (float*)(ws + WS_HS);
            a.wsm = (const bf16*)(ws + WS_WR) + (size_t)l * 2 * 32 * 1024; a.sbias = kargs()->in.router_b + (size_t)l * 32;
            a.toke = (int*)(ws + WS_TOKE); a.tokg = (float*)(ws + WS_TOKG); a.ghist = (int*)(ws + WS_GHIST); a.bhist = (int*)(ws + WS_BHIST); a.gs = (l == DEPTH - 1) ? NCTX / 16 : 0;
            for (int rep = 0; rep < NREP(7); ++rep) { norm_phase<1>(lds, a); SEAM(pb + 4); }
        }
        if (EN(8) && IN(pb + 5)) {
            ScatterArgs a{(const int*)(ws + WS_TOKE), (const float*)(ws + WS_TOKG), (const int*)(ws + WS_GHIST), (const int*)(ws + WS_BHIST), (int*)(ws + WS_TOKS), (int*)(ws + WS_SLTOK), (float*)(ws + WS_SLG), (int*)(ws + WS_RTE), (const float*)(ws + WS_HS), (float*)(ws + WS_SLS), (l == DEPTH - 1) ? NCTX / 16 : 0, (unsigned char*)(ws + WS_RTEB)};
            for (int rep = 0; rep < NREP(8); ++rep) { scatter_phase(lds, a); SEAM(pb + 5); }
        }
        if (EN(9) && IN(pb + 6)) {
            const int* rte = (const int*)(ws + WS_RTE);
            pg8::TileOrder S; S.init(__builtin_amdgcn_readfirstlane(rte[0]), 2 * DFF / 256, G, opaque_bid());
            SrcMoeGather src{ws, l};
            EpiGateUp E{ws, l};
            for (int rep = 0; rep < NREP(9); ++rep) { pg8::gemm_phase<EpiGateUp, SrcMoeGather, false, 1>(lds, (const bf16*)(ws + WS_H8), S, src, E); SEAM(pb + 6); }
        }
        if (EN(10) && IN(pb + 7)) {
            const int* rte = (const int*)(ws + WS_RTE);
            pg8::TileOrder S; S.init(__builtin_amdgcn_readfirstlane(rte[0]), D / 256, G, opaque_bid());
            SrcMoePlain src{ws, l};
            EpiDown E{ws, l};
            for (int rep = 0; rep < NREP(10); ++rep) { pg8::gemm_phase<EpiDown, SrcMoePlain, false, 2>(lds, (const bf16*)(ws + WS_ACT), S, src, E); SEAM(pb + 7); }
        }
    }
    if (EN(11) && IN(N_PHASES - 1)) {
        NormArgs a{};
        a.xin = (const float*)(ws + WS_XLA + (size_t)((DEPTH - 1) & 1) * XL_BYTES); a.delta = (const bf16*)(ws + WS_H); a.dsc = (const float*)(ws + WS_DSC); a.mout = (const bf16*)(ws + WS_MOUT); a.msc = (const float*)(ws + WS_MSC); a.toks = (const int*)(ws + WS_TOKS); a.g2mod = (const float*)(ws + WS_MOD) + (size_t)(DEPTH - 1) * 17 * 6144;
        a.fnorm = kargs()->in.final_norm; a.out = kargs()->out;
        norm_phase<2>(lds, a);
    }
#undef IN
#undef SEAM
}

extern "C" void kernel_launch(void* const* d_in, const int* in_sizes, int n_in, void* d_out, int out_size, void* d_ws, size_t ws_size, hipStream_t stream) {
    static int grid = 0;
    if (grid == 0) {
        if (n_in != 22 || out_size != NLAT * D || ws_size < WS_END) { fprintf(stderr, "kernel_launch: unexpected shapes (n_in %d, out %d, ws %zu, need %zu)\n", n_in, out_size, ws_size, (size_t)WS_END); grid = -1; return; }
        int dev = 0, cus = 0, per_cu = 0;
        if (hipGetDevice(&dev) != hipSuccess || hipDeviceGetAttribute(&cus, hipDeviceAttributeMultiprocessorCount, dev) != hipSuccess) { grid = -1; return; }
        if (hipFuncSetAttribute((const void*)mega_fwd, hipFuncAttributeMaxDynamicSharedMemorySize, LDS_BYTES) != hipSuccess) { fprintf(stderr, "kernel_launch: hipFuncSetAttribute failed\n"); grid = -1; return; }
        if (hipOccupancyMaxActiveBlocksPerMultiprocessor(&per_cu, (const void*)mega_fwd, 512, LDS_BYTES) != hipSuccess || per_cu < 1) { fprintf(stderr, "kernel_launch: occupancy query says %d\n", per_cu); per_cu = 1; }
        (void)hipGetLastError();
        grid = cus;
    }
    if (grid < 0) return;
    if (hipMemsetAsync((char*)d_ws + WS_CTL, 0, CTL_ZERO_BYTES, stream) != hipSuccess) return;
    Args a{};
    const float** ip = (const float**)&a.in;
    for (int i = 0; i < 22; ++i) ip[i] = (const float*)d_in[i];
    a.out = (float*)d_out; a.ws = (unsigned char*)d_ws;
#if MK_N_LAUNCHES == 1
    a.ph_lo = 0; a.ph_hi = N_PHASES;
    hipLaunchKernelGGL(mega_fwd, dim3(grid), dim3(512), LDS_BYTES, stream, a);
#else
    for (int p = 0; p < N_PHASES; ++p) { a.ph_lo = p; a.ph_hi = p + 1; hipLaunchKernelGGL(mega_fwd, dim3(grid), dim3(512), LDS_BYTES, stream, a); }
#endif
}
```
